# Optimizing an MI355X kernel written in HIP

```python
import math
import jax
import jax.numpy as jnp
from jax import lax
import numpy as np

D_MODEL = 1024
BATCH = 8
SEQ = 8192
DEPTH = 2
DEC_BATCH = 8
DEC_SEQ = 2048
PAST_LEN = 128

N_MIXERS = 2
N_A_LAYERS = (DEPTH + N_MIXERS - 1) // N_MIXERS
N_B_LAYERS = DEPTH // N_MIXERS

A_WINDOWS = (128, 512, 2048)
A_DILATIONS = (1, 4, 16)
A_GROUPS = len(A_WINDOWS)
A_HEADS = 8
A_HEAD_DIM = D_MODEL // A_HEADS
A_WIDTH = A_HEADS * A_HEAD_DIM

NUM_BUCKETS = 32
MAX_DISTANCE = max(A_WINDOWS) // 2

B_HEADS = 16
Q_LORA = 384
KV_LORA = 256
QK_NOPE = 64
QK_ROPE = 32
V_HEAD = 64
ROPE_THETA = 10000.0
Q_BLOCK = 128

D_FF = 2816
CONV_W = 3

ALPHA = (2.0 * DEPTH) ** 0.25
BETA = (8.0 * DEPTH) ** -0.25

LN_EPS = 1e-5
RMS_EPS = 1e-6
NEG_INF = -1e30

kernel_name = "hybrid_dilated_mla_encoder"


def layer_norm(x, g, b):
    xf = x.astype(jnp.float32)
    mu = jnp.mean(xf, axis=-1, keepdims=True)
    xc = xf - mu
    var = jnp.mean(xc * xc, axis=-1, keepdims=True)
    return (xc * lax.rsqrt(var + LN_EPS) * g.astype(jnp.float32) + b.astype(jnp.float32)).astype(x.dtype)


def rms_norm(x, g):
    xf = x.astype(jnp.float32)
    ms = jnp.mean(xf * xf, axis=-1, keepdims=True)
    return (xf * lax.rsqrt(ms + RMS_EPS) * g.astype(jnp.float32)).astype(x.dtype)


def t5_bucket(rel):
    nb = NUM_BUCKETS // 2
    max_exact = nb // 2
    ret = jnp.where(rel > 0, nb, 0)
    n = jnp.abs(rel)
    large = max_exact + (jnp.log(jnp.maximum(n, 1).astype(jnp.float32) / max_exact)
                         / math.log(MAX_DISTANCE / max_exact) * (nb - max_exact)).astype(jnp.int32)
    large = jnp.minimum(large, nb - 1)
    return ret + jnp.where(n < max_exact, n, large)


def dilated_group_attention(q, k, v, bias_tab, dilation, half):
    B, S, H, C = q.shape
    L = S // dilation
    nblk = -(-L // half)
    Lp = nblk * half

    def to_sub(t):
        t = t.reshape(B, L, dilation, H, C).transpose(0, 2, 1, 3, 4)
        return jnp.pad(t, ((0, 0), (0, 0), (0, Lp - L), (0, 0), (0, 0)))

    def neighbours(t):
        t = jnp.pad(to_sub(t), ((0, 0), (0, 0), (half, half), (0, 0), (0, 0)))
        t = t.reshape(B, dilation, nblk + 2, half, H, C)
        return jnp.concatenate([t[:, :, :-2], t[:, :, 1:-1], t[:, :, 2:]], axis=3)

    qs = to_sub(q).reshape(B, dilation, nblk, half, H, C)
    ks = neighbours(k)
    vs = neighbours(v)

    qi = jnp.arange(half)[:, None]
    kj = jnp.arange(3 * half)[None, :]
    rel = kj - half - qi
    bias = bias_tab[t5_bucket(rel * dilation)].transpose(2, 0, 1).astype(jnp.float32)
    key_pos = (jnp.arange(nblk)[:, None] - 1) * half + kj
    valid = (jnp.abs(rel) <= half)[None] & ((key_pos >= 0) & (key_pos < L))[:, None, :]

    s = jnp.einsum('brnqhc,brnkhc->brnhqk', qs, ks).astype(jnp.float32) * (C ** -0.5) + bias
    s = jnp.where(valid[:, None], s, NEG_INF)
    m = jnp.max(s, axis=-1, keepdims=True)
    p = jnp.exp(s - m)
    den = jnp.sum(p, axis=-1, keepdims=True)
    lse = (m + jnp.log(den))[..., 0]
    o = jnp.einsum('brnhqk,brnkhc->brnqhc', (p / den).astype(v.dtype), vs)

    def from_sub(t):
        t = t.reshape((B, dilation, Lp) + t.shape[4:])[:, :, :L]
        t = jnp.moveaxis(t, 1, 2)
        return t.reshape((B, S) + t.shape[3:])

    return from_sub(o), from_sub(lse.transpose(0, 1, 2, 4, 3))


def dilated_mixer(x, w_qkv, w_o, rel_bias):
    B, S, _ = x.shape
    qkv = (x @ w_qkv).reshape(B, S, A_GROUPS, 3, A_HEADS, A_HEAD_DIM)
    outs, lses = [], []
    for g in range(A_GROUPS):
        dil = A_DILATIONS[g]
        half = A_WINDOWS[g] // (2 * dil)
        o, lse = dilated_group_attention(qkv[:, :, g, 0], qkv[:, :, g, 1], qkv[:, :, g, 2],
                                         rel_bias[:, g * A_HEADS:(g + 1) * A_HEADS], dil, half)
        outs.append(o)
        lses.append(lse)
    wts = jax.nn.softmax(jnp.stack(lses, axis=0), axis=0)
    o = jnp.einsum('gbsh,gbshc->bshc', wts.astype(x.dtype), jnp.stack(outs, axis=0))
    return o.reshape(B, S, A_WIDTH) @ w_o


def rope_tables(S):
    inv = 1.0 / (ROPE_THETA ** (jnp.arange(0, QK_ROPE, 2, dtype=jnp.float32) / QK_ROPE))
    ang = jnp.arange(S, dtype=jnp.float32)[:, None] * inv[None, :]
    return jnp.cos(ang), jnp.sin(ang)


def apply_rope(t, cos, sin):
    t1, t2 = jnp.split(t, 2, axis=-1)
    cos = cos.astype(t.dtype)
    sin = sin.astype(t.dtype)
    return jnp.concatenate([t1 * cos - t2 * sin, t1 * sin + t2 * cos], axis=-1)


def mla_mixer(x, w_dkv, g_q, g_kv, w_uq, w_ukv, w_o):
    B, S, _ = x.shape
    c = x @ w_dkv
    cq = c[..., :Q_LORA]
    ckv = c[..., Q_LORA:Q_LORA + KV_LORA]
    kr = c[..., Q_LORA + KV_LORA:]
    q = (rms_norm(cq, g_q) @ w_uq).reshape(B, S, B_HEADS, QK_NOPE + QK_ROPE)
    kv = (rms_norm(ckv, g_kv) @ w_ukv).reshape(B, S, B_HEADS, QK_NOPE + V_HEAD)
    qn, qr = q[..., :QK_NOPE], q[..., QK_NOPE:]
    kn, v = kv[..., :QK_NOPE], kv[..., QK_NOPE:]
    cos, sin = rope_tables(S)
    qr = apply_rope(qr, cos[:, None], sin[:, None])
    kr = apply_rope(kr, cos, sin)
    scale = (QK_NOPE + QK_ROPE) ** -0.5
    nqb = S // Q_BLOCK
    qn_b = qn.reshape(B, nqb, Q_BLOCK, B_HEADS, QK_NOPE).transpose(1, 0, 2, 3, 4)
    qr_b = qr.reshape(B, nqb, Q_BLOCK, B_HEADS, QK_ROPE).transpose(1, 0, 2, 3, 4)

    def attend(blk):
        qn_i, qr_i = blk
        s = (jnp.einsum('bqhc,bkhc->bhqk', qn_i, kn)
             + jnp.einsum('bqhr,bkr->bhqk', qr_i, kr)).astype(jnp.float32) * scale
        p = jax.nn.softmax(s, axis=-1)
        return jnp.einsum('bhqk,bkhc->bqhc', p.astype(v.dtype), v)

    o = lax.map(attend, (qn_b, qr_b))
    o = o.transpose(1, 0, 2, 3, 4).reshape(B, S, B_HEADS * V_HEAD)
    return o @ w_o


def conv_ffn(x, w_in, conv_w, conv_b, w_out):
    h = x @ w_in
    hp = jnp.pad(h, ((0, 0), (1, 1), (0, 0)))
    h = hp[:, :-2] * conv_w[0] + hp[:, 1:-1] * conv_w[1] + hp[:, 2:] * conv_w[2] + conv_b
    a, g = jnp.split(h, 2, axis=-1)
    return (a * jax.nn.gelu(g, approximate=False)) @ w_out


def encoder(x, rel_bias, w_qkv_a, w_o_a, w_dkv_b, g_q_b, g_kv_b, w_uq_b, w_ukv_b, w_o_b,
            ffn_w_in, ffn_conv_w, ffn_conv_b, ffn_w_out, ln_g, ln_b):
    for i in range(DEPTH):
        j = i // N_MIXERS
        if i % N_MIXERS == 0:
            mix = dilated_mixer(x, w_qkv_a[j], w_o_a[j], rel_bias)
        else:
            mix = mla_mixer(x, w_dkv_b[j], g_q_b[j], g_kv_b[j], w_uq_b[j], w_ukv_b[j], w_o_b[j])
        x = layer_norm(ALPHA * x + mix, ln_g[i, 0], ln_b[i, 0])
        x = layer_norm(ALPHA * x + conv_ffn(x, ffn_w_in[i], ffn_conv_w[i], ffn_conv_b[i], ffn_w_out[i]),
                       ln_g[i, 1], ln_b[i, 1])
    return x


def setup_inputs(seed: int = 0) -> dict:
    key = jax.random.key(seed)
    ks = jax.random.split(key, 20)
    f32 = jnp.float32

    def nrm(k, shape, fan_in, gain=1.0):
        return jax.random.normal(k, shape, f32) * (gain * fan_in ** -0.5)

    x_prompt = jax.random.normal(ks[0], (BATCH, SEQ, D_MODEL), f32)
    x_sample = jax.random.normal(ks[1], (DEC_BATCH, DEC_SEQ, D_MODEL), f32)
    rel_bias = jax.random.normal(ks[2], (NUM_BUCKETS, A_GROUPS * A_HEADS), f32) * 0.5
    w_qkv_a = nrm(ks[3], (N_A_LAYERS, D_MODEL, A_GROUPS * 3 * A_HEADS * A_HEAD_DIM), D_MODEL)
    w_o_a = nrm(ks[4], (N_A_LAYERS, A_WIDTH, D_MODEL), A_WIDTH, BETA)
    w_dkv_b = nrm(ks[5], (N_B_LAYERS, D_MODEL, Q_LORA + KV_LORA + QK_ROPE), D_MODEL)
    g_q_b = 1.0 + 0.05 * jax.random.normal(ks[6], (N_B_LAYERS, Q_LORA), f32)
    g_kv_b = 1.0 + 0.05 * jax.random.normal(ks[7], (N_B_LAYERS, KV_LORA), f32)
    w_uq_b = nrm(ks[8], (N_B_LAYERS, Q_LORA, B_HEADS * (QK_NOPE + QK_ROPE)), Q_LORA)
    w_ukv_b = nrm(ks[9], (N_B_LAYERS, KV_LORA, B_HEADS * (QK_NOPE + V_HEAD)), KV_LORA)
    w_o_b = nrm(ks[10], (N_B_LAYERS, B_HEADS * V_HEAD, D_MODEL), B_HEADS * V_HEAD, BETA)
    ffn_w_in = nrm(ks[11], (DEPTH, D_MODEL, 2 * D_FF), D_MODEL)
    ffn_conv_w = nrm(ks[12], (DEPTH, CONV_W, 2 * D_FF), CONV_W)
    ffn_conv_b = 0.02 * jax.random.normal(ks[13], (DEPTH, 2 * D_FF), f32)
    ffn_w_out = nrm(ks[14], (DEPTH, D_FF, D_MODEL), D_FF, BETA)
    ln_g = 1.0 + 0.05 * jax.random.normal(ks[15], (DEPTH, 2, D_MODEL), f32)
    ln_b = 0.02 * jax.random.normal(ks[16], (DEPTH, 2, D_MODEL), f32)
    return {"x_prompt": x_prompt, "x_sample": x_sample, "rel_bias": rel_bias,
            "w_qkv_a": w_qkv_a, "w_o_a": w_o_a, "w_dkv_b": w_dkv_b, "g_q_b": g_q_b,
            "g_kv_b": g_kv_b, "w_uq_b": w_uq_b, "w_ukv_b": w_ukv_b, "w_o_b": w_o_b,
            "ffn_w_in": ffn_w_in, "ffn_conv_w": ffn_conv_w, "ffn_conv_b": ffn_conv_b,
            "ffn_w_out": ffn_w_out, "ln_g": ln_g, "ln_b": ln_b}


def reference(x_prompt, x_sample, rel_bias, w_qkv_a, w_o_a, w_dkv_b, g_q_b, g_kv_b, w_uq_b,
              w_ukv_b, w_o_b, ffn_w_in, ffn_conv_w, ffn_conv_b, ffn_w_out, ln_g, ln_b):
    y_prompt = encoder(x_prompt, rel_bias, w_qkv_a, w_o_a, w_dkv_b, g_q_b, g_kv_b, w_uq_b, w_ukv_b,
                       w_o_b, ffn_w_in, ffn_conv_w, ffn_conv_b, ffn_w_out, ln_g, ln_b)
    y_sample = encoder(x_sample, rel_bias, w_qkv_a, w_o_a, w_dkv_b, g_q_b, g_kv_b, w_uq_b, w_ukv_b,
                       w_o_b, ffn_w_in, ffn_conv_w, ffn_conv_b, ffn_w_out, ln_g, ln_b)
    return (y_prompt, y_sample)
```

```cpp
#include <hip/hip_runtime.h>
#include <hip/hip_cooperative_groups.h>
#include <cstdio>
#include <cstdint>
namespace cg = cooperative_groups;

#ifndef MK_MULTI
#define MK_MULTI 0
#endif

#define LAS __attribute__((address_space(3)))
typedef unsigned short bf16_t;
typedef short bf16x8 __attribute__((ext_vector_type(8)));
typedef short s16x4 __attribute__((ext_vector_type(4)));
typedef float f32x4 __attribute__((ext_vector_type(4)));
typedef float f32x2 __attribute__((ext_vector_type(2)));
typedef float f32x16 __attribute__((ext_vector_type(16)));
typedef unsigned u32x4 __attribute__((ext_vector_type(4)));
typedef unsigned u32x2 __attribute__((ext_vector_type(2)));

constexpr int DM = 1024, TP = 65536, TS = 16384, T = TP + TS;
constexpr int NQKV = 9216, DFF = 2816, NFF = 2 * DFF;
constexpr int CW = 768, NCQ = 384, NCKV = 256, NQ = 1536, NKV = 2048;
constexpr int CHUNK = 16384, NCHUNK = 5;
constexpr float ALPHA = 1.4142135623730951f;
constexpr float LOG2E = 1.4426950408889634f;
constexpr float LN_EPS = 1e-5f, RMS_EPS = 1e-6f;

constexpr size_t MiB = 1u << 20;
constexpr size_t WS_COS = 0, WS_SIN = 512 * 1024, WS_BT = 1 * MiB, WS_RQ = 1 * MiB + 256 * 1024, WS_RKV = 1 * MiB + 640 * 1024;
constexpr size_t WS_WQKV = 2 * MiB, WS_WOA = 20 * MiB, WS_WDKV = 22 * MiB, WS_WUQ = 24 * MiB, WS_WUKV = 25 * MiB + 512 * 1024, WS_WOB = 27 * MiB;
constexpr size_t WS_WIN = 29 * MiB, WS_WOUT = 51 * MiB;
constexpr size_t WS_XB = 62 * MiB, WS_O = 222 * MiB, WS_C = 222 * MiB, WS_S = 382 * MiB;
constexpr size_t WS_QKV = WS_S, WS_OG = WS_S + 288 * MiB, WS_LSE = WS_S + 384 * MiB;
constexpr size_t WS_U = WS_O, WS_H = WS_O + 440 * MiB, WS_Y2 = WS_H;
constexpr size_t WS_QB = WS_S, WS_KV = WS_S + 240 * MiB, WS_KRR = WS_S + 560 * MiB;
constexpr size_t WS_CTL = 1016 * MiB, CTL_BYTES = 65536;
constexpr size_t WS_END = WS_CTL + CTL_BYTES;
constexpr int LDS_BYTES = 147456;

__device__ __forceinline__ unsigned cvt_pk_bf16(float lo, float hi) { unsigned r; asm("v_cvt_pk_bf16_f32 %0, %1, %2" : "=v"(r) : "v"(lo), "v"(hi)); return r; }
__device__ __forceinline__ u32x4 pack8(f32x4 v0, f32x4 v1) { u32x4 w; w.x = cvt_pk_bf16(v0[0], v0[1]); w.y = cvt_pk_bf16(v0[2], v0[3]); w.z = cvt_pk_bf16(v1[0], v1[1]); w.w = cvt_pk_bf16(v1[2], v1[3]); return w; }
__device__ __forceinline__ float bf2f(unsigned short b) { return __uint_as_float((unsigned)b << 16); }
__device__ __forceinline__ float wave_sum(float v, int lane) {
#pragma unroll
    for (int o = 1; o < 32; o <<= 1) v += __int_as_float(__builtin_amdgcn_ds_bpermute((lane ^ o) << 2, __float_as_int(v)));
    auto rr = __builtin_amdgcn_permlane32_swap(__float_as_uint(v), __float_as_uint(v), false, false);
    return __uint_as_float(rr[0]) + __uint_as_float(rr[1]);
}

namespace pg8 {
constexpr int BM = 256, BK = 64, HALF = 128, HTB = HALF * BK * 2, STAGE_BYTES = 8 * HTB, NXCD = 8, WGM = 8;
__host__ __device__ __forceinline__ int lds_byte(int r, int c) { const int st = (r >> 4) * 2 + (c >> 5), rr = r & 15, cc = c & 31, ob = rr * 64 + cc * 2; return st * 1024 + (ob ^ (((ob >> 9) & 1) << 5)); }
__host__ __device__ __forceinline__ void stage_rc(int b, int& R, int& C) { const int st = b / 1024, sb = b % 1024, swz = sb ^ (((sb >> 9) & 1) << 5); R = (st >> 1) * 16 + swz / 64; C = (st & 1) * 32 + (swz % 64) / 2; }
__host__ __device__ __forceinline__ int perm32(int rho) { const int n = rho >> 4, i = rho & 15; return 8 * (i >> 2) + 4 * n + (i & 3); }

struct Unit { int pm, pn; };
struct Gemm { const bf16_t* A; const bf16_t* Bt; int M, N, K, lda; };

struct StaticOrder {
    int nM, nN, nwg, G, c;
    __device__ void init(int M, int N, int G_, int c_) { nM = M / BM; nN = N / BM; nwg = nM * nN; G = G_; c = c_; }
    __device__ bool next(int i, Unit& u) const {
        const long L = (long)i * G + c; if (L >= nwg) return false;
        int wgid = (int)L; { const int q = nwg / NXCD, r = nwg % NXCD, xcd = wgid % NXCD, off = wgid / NXCD; wgid = (xcd < r ? xcd * (q + 1) : r * (q + 1) + (xcd - r) * q) + off; }
        const int nig = WGM * nN, gid = wgid / nig, fm = gid * WGM, gsz = (nM - fm) < WGM ? (nM - fm) : WGM;
        u.pm = fm + ((wgid % nig) % gsz); u.pn = (wgid % nig) / gsz; return true;
    }
};

struct EpiStore {
    static constexpr bool PERM = true;
    bf16_t* O; int ldc; const float* rscale; float cscale;
    __device__ __forceinline__ void operator()(const f32x4 (&acc)[2][2][4][2], const Unit& u, int wr, int wc, int fr, int fq) const {
        const int row0 = u.pm * BM + wr * 64 + fr, col0 = u.pn * BM + wc * 32 + 8 * fq;
#pragma unroll
        for (int ai = 0; ai < 2; ++ai)
#pragma unroll
            for (int m = 0; m < 4; ++m) {
                const int row = row0 + ai * HALF + m * 16;
                const float s = rscale ? rscale[row] * cscale : cscale;
                bf16_t* rowp = O + (size_t)row * ldc + col0;
#pragma unroll
                for (int bj = 0; bj < 2; ++bj) *(u32x4*)(rowp + bj * HALF) = pack8(acc[ai][bj][m][0] * s, acc[ai][bj][m][1] * s);
            }
    }
};
struct EpiQRope {
    static constexpr bool PERM = true;
    bf16_t* O; const float* rscale; float cscale; const float* cosT; const float* sinT;
    __device__ __forceinline__ void operator()(const f32x4 (&acc)[2][2][4][2], const Unit& u, int wr, int wc, int fr, int fq) const {
        const int row0 = u.pm * BM + wr * 64 + fr, col0 = u.pn * BM + wc * 32 + 8 * fq;
        int rj[2];
#pragma unroll
        for (int bj = 0; bj < 2; ++bj) { const int w = (col0 + bj * HALF) % 96; rj[bj] = (w >= 64) ? ((w - 64) >> 3) : -1; }
#pragma unroll
        for (int ai = 0; ai < 2; ++ai)
#pragma unroll
            for (int m = 0; m < 4; ++m) {
                const int row = row0 + ai * HALF + m * 16;
                const float s = rscale[row] * cscale;
                const int pos = row < TP ? (row & 8191) : (row & 2047);
                bf16_t* rowp = O + (size_t)row * NQ + col0;
#pragma unroll
                for (int bj = 0; bj < 2; ++bj) {
                    f32x4 v0 = acc[ai][bj][m][0] * s, v1 = acc[ai][bj][m][1] * s;
                    if (rj[bj] >= 0) {
                        const f32x4 cs = *(const f32x4*)(cosT + pos * 16 + 4 * rj[bj]), sn = *(const f32x4*)(sinT + pos * 16 + 4 * rj[bj]);
                        const f32x4 t1 = v0, t2 = v1; v0 = t1 * cs - t2 * sn; v1 = t1 * sn + t2 * cs;
                    }
                    *(u32x4*)(rowp + bj * HALF) = pack8(v0, v1);
                }
            }
    }
};
struct EpiQKV {
    static constexpr bool PERM = true;
    bf16_t* O; int log2S; float qscale;
    __device__ __forceinline__ void operator()(const f32x4 (&acc)[2][2][4][2], const Unit& u, int wr, int wc, int fr, int fq) const {
        const int colt = u.pn * BM, g = colt / 3072, which = (colt - g * 3072) >> 10, sh = 2 * g, log2L = log2S - sh, S = 1 << log2S;
        const float sc = (which == 0) ? qscale : 1.f;
        const int row0 = u.pm * BM + wr * 64 + fr, col0 = colt + wc * 32 + 8 * fq;
#pragma unroll
        for (int ai = 0; ai < 2; ++ai)
#pragma unroll
            for (int m = 0; m < 4; ++m) {
                const int rl = row0 + ai * HALF + m * 16, seq = rl >> log2S, s = rl & (S - 1);
                const int f = ((s & ((1 << sh) - 1)) << log2L) + (s >> sh), drow = (seq << log2S) + f;
                bf16_t* rowp = O + (size_t)drow * NQKV + col0;
#pragma unroll
                for (int bj = 0; bj < 2; ++bj) *(u32x4*)(rowp + bj * HALF) = pack8(acc[ai][bj][m][0] * sc, acc[ai][bj][m][1] * sc);
            }
    }
};
struct EpiRes {
    static constexpr bool PERM = true;
    float* X; float alpha;
    __device__ __forceinline__ void operator()(const f32x4 (&acc)[2][2][4][2], const Unit& u, int wr, int wc, int fr, int fq) const {
        const int row0 = u.pm * BM + wr * 64 + fr, col0 = u.pn * BM + wc * 32 + 8 * fq;
#pragma unroll
        for (int ai = 0; ai < 2; ++ai)
#pragma unroll
            for (int m = 0; m < 4; ++m) {
                float* rowp = X + (size_t)(row0 + ai * HALF + m * 16) * DM + col0;
#pragma unroll
                for (int bj = 0; bj < 2; ++bj) {
                    float* p = rowp + bj * HALF; const f32x4 a = *(const f32x4*)p, b = *(const f32x4*)(p + 4);
                    *(f32x4*)p = a * alpha + acc[ai][bj][m][0]; *(f32x4*)(p + 4) = b * alpha + acc[ai][bj][m][1];
                }
            }
    }
};

template <class Epi, class Sched, bool ALIGN_EPI = true, bool SP2 = true>
__device__ __forceinline__ void gemm_phase(LAS unsigned char* lds, const Gemm g, const Sched& S, const Epi& E) {
    int tid_ = threadIdx.x; asm volatile("" : "+v"(tid_));
    const int tid = tid_, wid = __builtin_amdgcn_readfirstlane(tid >> 6), lane = tid & 63, wr = wid >> 2, wc = wid & 3, fr = lane & 15, fq = lane >> 4;
    const int K = g.K, nt = K / BK, lda = g.lda;
    unsigned voffA[2], voffB[2];
#pragma unroll
    for (int i = 0; i < 2; ++i) { int R, C; stage_rc(tid * 16 + i * 8192, R, C); const int Rb = Epi::PERM ? ((R & ~31) + perm32(R & 31)) : R;
        voffA[i] = (unsigned)(R * lda + C) * 2u; voffB[i] = (unsigned)(Rb * K + C) * 2u; }
    const size_t kstep = (size_t)(BK * 2);
    const size_t hstepA = (size_t)HALF * lda * 2, hstepB = (size_t)HALF * K * 2;
    const size_t tstepA = 2 * hstepA, tstepB = 2 * hstepB;
    const unsigned ldsw = (unsigned)wid * 1024u;
    const int aoff = lds_byte(wr * 64 + fr, fq * 8), boff = lds_byte(wc * 32 + fr, fq * 8);
#define PG8_SA(b, h) (((b) * 2 + (h)) * HTB)
#define PG8_SB(b, h) ((4 + (b) * 2 + (h)) * HTB)
#define PG8_STAGE(bufoff, gbase, voff) do { _Pragma("unroll") for (int _i = 0; _i < 2; ++_i) \
        __builtin_amdgcn_global_load_lds((const unsigned*)((const char*)(gbase) + (voff)[_i]), (LAS unsigned*)(lds + (bufoff) + ldsw + _i * 8192), 16, 0, 0); } while (0)
#define PG8_LDA(dst, b, h) do { _Pragma("unroll") for (int m = 0; m < 4; ++m) _Pragma("unroll") for (int k = 0; k < 2; ++k) dst[m][k] = *(const LAS bf16x8*)(lds + PG8_SA(b, h) + aoff + m * 2048 + k * 1024); } while (0)
#define PG8_LDB(dst, b, h) do { _Pragma("unroll") for (int n = 0; n < 2; ++n) _Pragma("unroll") for (int k = 0; k < 2; ++k) dst[n][k] = *(const LAS bf16x8*)(lds + PG8_SB(b, h) + boff + n * 2048 + k * 1024); } while (0)
#define PG8_MMA(ai, bj, At, Bt) do { __builtin_amdgcn_s_setprio(1); _Pragma("unroll") for (int m = 0; m < 4; ++m) _Pragma("unroll") for (int n = 0; n < 2; ++n) _Pragma("unroll") for (int k = 0; k < 2; ++k) \
        acc[ai][bj][m][n] = __builtin_amdgcn_mfma_f32_16x16x32_bf16(Bt[n][k], At[m][k], acc[ai][bj][m][n], 0, 0, 0); __builtin_amdgcn_s_setprio(0); } while (0)
#define PG8_WAIT_V(n) asm volatile("s_waitcnt vmcnt(" #n ")" ::: "memory")
#define PG8_WAIT_L(n) asm volatile("s_waitcnt lgkmcnt(" #n ")" ::: "memory")
#define PG8_BAR __builtin_amdgcn_s_barrier()
#define PG8_SCHED __builtin_amdgcn_sched_barrier(0)
    Unit cur, nxt; int ui = 0;
    if (!S.next(0, cur)) return;
    f32x4 acc[2][2][4][2];
#pragma unroll
    for (int a = 0; a < 2; ++a)
#pragma unroll
        for (int b = 0; b < 2; ++b)
#pragma unroll
            for (int m = 0; m < 4; ++m)
#pragma unroll
                for (int n = 0; n < 2; ++n) acc[a][b][m][n] = (f32x4){0.f, 0.f, 0.f, 0.f};
    bf16x8 At[4][2], B0[2][2], B1[2][2];
    const char* cA = (const char*)g.A + (size_t)cur.pm * tstepA; const char* cB = (const char*)g.Bt + (size_t)cur.pn * tstepB;
    if constexpr (SP2) {
        PG8_STAGE(PG8_SB(0, 0), cB, voffB); PG8_STAGE(PG8_SB(0, 1), cB + hstepB, voffB); PG8_STAGE(PG8_SA(0, 0), cA, voffA); PG8_STAGE(PG8_SA(0, 1), cA + hstepA, voffA);
        if (wr == 1) PG8_BAR;
        PG8_WAIT_V(2); PG8_BAR;
        PG8_STAGE(PG8_SB(1, 0), cB + kstep, voffB); PG8_STAGE(PG8_SA(1, 0), cA + kstep, voffA); PG8_STAGE(PG8_SB(1, 1), cB + hstepB + kstep, voffB);
        PG8_WAIT_V(6); PG8_BAR;
    }
    for (;;) {
        const bool has_next = S.next(ui + 1, nxt);
        const char* nA = has_next ? (const char*)g.A + (size_t)nxt.pm * tstepA : cA; const char* nB = has_next ? (const char*)g.Bt + (size_t)nxt.pn * tstepB : cB;
        for (int t = 0; t < nt; t += 2) {
            const bool last = (t == nt - 2);
            const char* a1 = cA + (size_t)(t + 1) * kstep;
            const char* a2 = last ? nA : cA + (size_t)(t + 2) * kstep; const char* b2 = last ? nB : cB + (size_t)(t + 2) * kstep;
            const char* a3 = a2 + kstep; const char* b3 = b2 + kstep;
            PG8_LDB(B0, 0, 0); PG8_LDB(B1, 0, 1); PG8_SCHED; PG8_LDA(At, 0, 0); PG8_STAGE(PG8_SA(1, 1), a1 + hstepA, voffA);
            PG8_WAIT_V(8); PG8_WAIT_L(0); PG8_BAR; PG8_MMA(0, 0, At, B0); PG8_MMA(0, 1, At, B1); PG8_BAR; PG8_SCHED;
            PG8_LDA(At, 0, 1); PG8_STAGE(PG8_SB(0, 0), b2, voffB); PG8_STAGE(PG8_SB(0, 1), b2 + hstepB, voffB); PG8_STAGE(PG8_SA(0, 0), a2, voffA);
            PG8_WAIT_V(8); PG8_WAIT_L(0); PG8_BAR; PG8_MMA(1, 0, At, B0); PG8_MMA(1, 1, At, B1); PG8_BAR; PG8_SCHED;
            PG8_LDB(B0, 1, 0); PG8_LDB(B1, 1, 1); PG8_SCHED; PG8_LDA(At, 1, 0); PG8_STAGE(PG8_SA(0, 1), a2 + hstepA, voffA);
            PG8_WAIT_V(8); PG8_WAIT_L(0); PG8_BAR; PG8_MMA(0, 0, At, B0); PG8_MMA(0, 1, At, B1); PG8_BAR; PG8_SCHED;
            PG8_LDA(At, 1, 1); PG8_STAGE(PG8_SB(1, 0), b3, voffB); PG8_STAGE(PG8_SB(1, 1), b3 + hstepB, voffB); PG8_STAGE(PG8_SA(1, 0), a3, voffA);
            PG8_WAIT_V(8); PG8_WAIT_L(0); PG8_BAR; PG8_MMA(1, 0, At, B0); PG8_MMA(1, 1, At, B1); PG8_BAR; PG8_SCHED;
        }
        if constexpr (ALIGN_EPI) { if (wr == 0) PG8_BAR; }
        { int l2 = threadIdx.x; asm volatile("" : "+v"(l2)); l2 &= 63; E(acc, cur, wr, wc, l2 & 15, l2 >> 4); }
        if (!has_next) break;
#pragma unroll
        for (int a = 0; a < 2; ++a)
#pragma unroll
            for (int b = 0; b < 2; ++b)
#pragma unroll
                for (int m = 0; m < 4; ++m)
#pragma unroll
                    for (int n = 0; n < 2; ++n) acc[a][b][m][n] = (f32x4){0.f, 0.f, 0.f, 0.f};
        cur = nxt; cA = nA; cB = nB; ++ui;
        if constexpr (ALIGN_EPI) { if (wr == 1) PG8_BAR; }
    }
    PG8_WAIT_V(0);
    if constexpr (!ALIGN_EPI) { if (wr == 0) PG8_BAR; }
    PG8_BAR;
#undef PG8_SA
#undef PG8_SB
#undef PG8_STAGE
#undef PG8_LDA
#undef PG8_LDB
#undef PG8_MMA
#undef PG8_WAIT_V
#undef PG8_WAIT_L
#undef PG8_BAR
#undef PG8_SCHED
}
}

struct Params {
    const float *x_prompt, *x_sample, *rel_bias, *w_qkv_a, *w_o_a, *w_dkv_b, *g_q_b, *g_kv_b, *w_uq_b, *w_ukv_b, *w_o_b, *ffn_w_in, *ffn_conv_w, *ffn_conv_b, *ffn_w_out, *ln_g, *ln_b;
    float* out; unsigned char* ws;
    int ph_lo, ph_hi;
};

__device__ __forceinline__ int rope_perm32(int i) { const int t = i >> 4, ii = i & 15; return 8 * (ii >> 2) + 4 * t + (ii & 3); }
__device__ __forceinline__ int rowmap(int mode, int n) {
    if (mode == 1) { const int h = n / 96, w = n - h * 96; return w < 64 ? n : h * 96 + 64 + rope_perm32(w - 64); }
    if (mode == 2) { return n < 640 ? n : 640 + rope_perm32(n - 640); }
    return n;
}
__device__ __forceinline__ void transpose_item(const float* W, int K, int N, bf16_t* WT, int mode, const float* kscale, LAS float* scr, int item, int lane) {
    const int nblk = N / 32, kb = item / nblk, nb = item % nblk, k0 = 64 * kb, n0 = 32 * nb;
    const int kr = lane >> 3, c4 = (lane & 7) * 4;
#pragma unroll
    for (int i = 0; i < 8; ++i) { const int kk = kr + 8 * i; f32x4 v = *(const f32x4*)(W + (size_t)(k0 + kk) * N + n0 + c4); if (kscale) v = v * kscale[k0 + kk];
        scr[kk * 33 + c4] = v.x; scr[kk * 33 + c4 + 1] = v.y; scr[kk * 33 + c4 + 2] = v.z; scr[kk * 33 + c4 + 3] = v.w; }
    asm volatile("s_waitcnt lgkmcnt(0)" ::: "memory");
    const int c = lane & 7;
#pragma unroll
    for (int j = 0; j < 4; ++j) { const int n = (lane >> 3) + 8 * j; const LAS float* s = scr + (8 * c) * 33 + n;
        u32x4 o; o.x = cvt_pk_bf16(s[0 * 33], s[1 * 33]); o.y = cvt_pk_bf16(s[2 * 33], s[3 * 33]); o.z = cvt_pk_bf16(s[4 * 33], s[5 * 33]); o.w = cvt_pk_bf16(s[6 * 33], s[7 * 33]);
        *(u32x4*)(WT + (size_t)rowmap(mode, n0 + n) * K + k0 + 8 * c) = o; }
    asm volatile("s_waitcnt lgkmcnt(0)" ::: "memory");
}
__device__ __forceinline__ int t5_bucket(int rel) {
    const int n = rel < 0 ? -rel : rel; const int ret = rel > 0 ? 16 : 0;
    if (n < 8) return ret + n;
    int large = 8 + (int)(__log2f((float)n * 0.125f) * (8.0f / 7.0f));
    if (large > 15) large = 15;
    return ret + large;
}
__device__ __forceinline__ void rope_entry(int pos, int i, float& c, float& s) {
    const double x = -(double)i * (13.287712379549449 / 16.0);
    const double fl = __builtin_floor(x), fr = (x - fl) * 0.6931471805599453;
    double e = 1.0, term = 1.0;
#pragma unroll 1
    for (int k = 1; k < 22; ++k) { term *= fr / (double)k; e += term; }
    const long long bits = (long long)(1023 + (int)fl) << 52;
    const double inv = e * __builtin_bit_cast(double, bits);
    const double ang = (double)pos * inv;
    const double kq = __builtin_rint(ang * 0.6366197723675814);
    double r = __builtin_fma(-kq, 1.5707963267948966, ang); r = __builtin_fma(-kq, 6.123233995736766e-17, r);
    const double r2 = r * r;
    double sp = r * (1.0 + r2 * (-1.0 / 6 + r2 * (1.0 / 120 + r2 * (-1.0 / 5040 + r2 * (1.0 / 362880 + r2 * (-1.0 / 39916800 + r2 * (1.0 / 6227020800.0)))))));
    double cp = 1.0 + r2 * (-0.5 + r2 * (1.0 / 24 + r2 * (-1.0 / 720 + r2 * (1.0 / 40320 + r2 * (-1.0 / 3628800 + r2 * (1.0 / 479001600.0))))));
    const int q = (int)((long long)kq & 3);
    double sv = (q == 0) ? sp : (q == 1) ? cp : (q == 2) ? -sp : -cp;
    double cv = (q == 0) ? cp : (q == 1) ? -sp : (q == 2) ? -cp : sp;
    c = (float)cv; s = (float)sv;
}

__device__ __forceinline__ float gelu_erf(float v) {
    const float av = __builtin_fabsf(v), d = av * 0.2316418882f + 1.0f, t = __builtin_amdgcn_rcpf(d);
    float q = t * 0.5307027145f + (-0.7265760135f); q = q * t + 0.7107068705f; q = q * t + (-0.142248368f); q = q * t + 0.127414796f; q = q * t;
    const float e = __builtin_amdgcn_exp2f((v * v) * (-0.72134752044f));
    const float m = v * (q * e), r = v - m;
    return v < 0.f ? m : r;
}

__device__ __forceinline__ void ln_phase(const float* x0, const float* x1, const bf16_t* Y, float* Xo, bf16_t* XBo, const float* g, const float* b, int gw, int NGW, int lane, bool wb = true) {
    f32x4 gg[4], bb[4];
#pragma unroll
    for (int j = 0; j < 4; ++j) { gg[j] = *((const f32x4*)g + lane + 64 * j); bb[j] = *((const f32x4*)b + lane + 64 * j); }
    f32x4 cx[4]; u32x2 cy[4];
#define LN_LOAD(r, vx, vy) do { const float* src_ = (r) < TP ? x0 + (size_t)(r) * DM : x1 + (size_t)((r) - TP) * DM; \
        _Pragma("unroll") for (int j = 0; j < 4; ++j) { vx[j] = *((const f32x4*)src_ + lane + 64 * j); vy[j] = *((const u32x2*)(Y + (size_t)(r) * DM) + lane + 64 * j); } } while (0)
    if (gw < T) LN_LOAD(gw, cx, cy);
    for (int r = gw; r < T; r += NGW) {
        f32x4 nx[4] = {}; u32x2 ny[4] = {};
        const int rn = r + NGW;
        if (rn < T) LN_LOAD(rn, nx, ny);
        f32x4 v[4]; float s = 0.f;
#pragma unroll
        for (int j = 0; j < 4; ++j) {
            const f32x4 yf = {__uint_as_float(cy[j].x << 16), __uint_as_float(cy[j].x & 0xffff0000u), __uint_as_float(cy[j].y << 16), __uint_as_float(cy[j].y & 0xffff0000u)};
            v[j] = cx[j] * ALPHA + yf; s += (v[j].x + v[j].y) + (v[j].z + v[j].w);
        }
        const float mean = wave_sum(s, lane) * (1.f / DM); float s2 = 0.f;
#pragma unroll
        for (int j = 0; j < 4; ++j) { v[j] = v[j] - mean; s2 += (v[j].x * v[j].x + v[j].y * v[j].y) + (v[j].z * v[j].z + v[j].w * v[j].w); }
        const float rstd = 1.f / sqrtf(wave_sum(s2, lane) * (1.f / DM) + LN_EPS);
#pragma unroll
        for (int j = 0; j < 4; ++j) {
            const f32x4 o = v[j] * rstd * gg[j] + bb[j];
            *((f32x4*)(Xo + (size_t)r * DM) + lane + 64 * j) = o;
            if (wb) { u32x2 w; w.x = cvt_pk_bf16(o.x, o.y); w.y = cvt_pk_bf16(o.z, o.w); *((u32x2*)(XBo + (size_t)r * DM) + lane + 64 * j) = w; }
        }
#pragma unroll
        for (int j = 0; j < 4; ++j) { cx[j] = nx[j]; cy[j] = ny[j]; }
    }
#undef LN_LOAD
}

__device__ __forceinline__ s16x4 tr_read(unsigned addr) { s16x4 r; asm volatile("ds_read_b64_tr_b16 %0, %1" : "=&v"(r) : "v"(addr) : "memory"); return r; }
#define MFMA32(a, b, c) __builtin_amdgcn_mfma_f32_32x32x16_bf16(a, b, c, 0, 0, 0)
__device__ __forceinline__ float xhalf_max(float v) { auto rr = __builtin_amdgcn_permlane32_swap(__float_as_uint(v), __float_as_uint(v), false, false); return fmaxf(__uint_as_float(rr[0]), __uint_as_float(rr[1])); }
__device__ __forceinline__ float xhalf_sum(float v) { auto rr = __builtin_amdgcn_permlane32_swap(__float_as_uint(v), __float_as_uint(v), false, false); return __uint_as_float(rr[0]) + __uint_as_float(rr[1]); }
__device__ __forceinline__ float max3(float a, float b, float c) { float r; asm("v_max3_f32 %0, %1, %2, %3" : "=v"(r) : "v"(a), "v"(b), "v"(c)); return r; }
__device__ __forceinline__ bf16x8 pack_p(const f32x16& p, int j2) {
    u32x4 w; w.x = cvt_pk_bf16(p[8 * j2 + 0], p[8 * j2 + 1]); w.y = cvt_pk_bf16(p[8 * j2 + 2], p[8 * j2 + 3]); w.z = cvt_pk_bf16(p[8 * j2 + 4], p[8 * j2 + 5]); w.w = cvt_pk_bf16(p[8 * j2 + 6], p[8 * j2 + 7]);
    return __builtin_bit_cast(bf16x8, w);
}
__device__ __forceinline__ void pv_tile(f32x16& o, unsigned vaddr, const bf16x8 (&pb)[4]) {
    s16x4 lo[4], hi[4];
#pragma unroll
    for (int k = 0; k < 4; ++k) { lo[k] = tr_read(vaddr + (16 * k) * 64); hi[k] = tr_read(vaddr + (16 * k + 8) * 64); }
    asm volatile("s_waitcnt lgkmcnt(0)" ::: "memory"); __builtin_amdgcn_sched_barrier(0);
#pragma unroll
    for (int k = 0; k < 4; ++k) { const bf16x8 a = (bf16x8){lo[k][0], lo[k][1], lo[k][2], lo[k][3], hi[k][0], hi[k][1], hi[k][2], hi[k][3]}; o = MFMA32(a, pb[k], o); }
}

__device__ __forceinline__ void pv_issue(unsigned vaddr, s16x4 (&lo)[4], s16x4 (&hi)[4]) {
#pragma unroll
    for (int k = 0; k < 4; ++k) { lo[k] = tr_read(vaddr + (16 * k) * 64); hi[k] = tr_read(vaddr + (16 * k + 8) * 64); }
}
__device__ __forceinline__ void pv_mma(f32x16& o, const s16x4 (&lo)[4], const s16x4 (&hi)[4], const bf16x8 (&pb)[4]) {
#pragma unroll
    for (int k = 0; k < 4; ++k) { const bf16x8 a = (bf16x8){lo[k][0], lo[k][1], lo[k][2], lo[k][3], hi[k][0], hi[k][1], hi[k][2], hi[k][3]}; o = MFMA32(a, pb[k], o); }
}
__device__ __forceinline__ void pv_mma2(f32x16& o0, f32x16& o1, const s16x4 (&l0)[4], const s16x4 (&h0)[4], const s16x4 (&l1)[4], const s16x4 (&h1)[4], const bf16x8 (&pb)[4]) {
#pragma unroll
    for (int k = 0; k < 4; ++k) {
        const bf16x8 a0 = (bf16x8){l0[k][0], l0[k][1], l0[k][2], l0[k][3], h0[k][0], h0[k][1], h0[k][2], h0[k][3]};
        const bf16x8 a1 = (bf16x8){l1[k][0], l1[k][1], l1[k][2], l1[k][3], h1[k][0], h1[k][1], h1[k][2], h1[k][3]};
        o0 = MFMA32(a0, pb[k], o0); o1 = MFMA32(a1, pb[k], o1);
    }
}
#define MLA_COMPUTE(cur) { \
            const LAS unsigned char* Kb = lds + cur * KBUF; \
            f32x16 s0 = {}, s1 = {}; \
            _Pragma("unroll") \
            for (int ks = 0; ks < 6; ++ks) { \
                const bf16x8 a0 = *(const LAS bf16x8*)(Kb + r32 * 208 + ks * 32 + hi * 16), a1 = *(const LAS bf16x8*)(Kb + (32 + r32) * 208 + ks * 32 + hi * 16); \
                s0 = MFMA32(a0, qf[ks], s0); s1 = MFMA32(a1, qf[ks], s1); \
            } \
            const unsigned va = trb + cur * VBUF; \
            s16x4 vl0[4], vh0[4], vl1[4], vh1[4]; \
            pv_issue(va, vl0, vh0); pv_issue(va + 4096, vl1, vh1);    \
            float pa = max3(s0[0], s0[1], s0[2]), pc = max3(s1[0], s1[1], s1[2]); \
            _Pragma("unroll") \
            for (int r = 3; r < 15; r += 2) { pa = max3(pa, s0[r], s0[r + 1]); pc = max3(pc, s1[r], s1[r + 1]); } \
            float pmax = max3(pa, pc, fmaxf(s0[15], s1[15])); \
            pmax = xhalf_max(pmax); \
              \
            if (__any(pmax - m > (slow ? 8.f : 64.f)) || (j == 0 && __any(pmax < -32.f))) { \
                const float mn = (j == 0) ? pmax : fmaxf(m, pmax), alpha = (j == 0) ? 1.f : __builtin_amdgcn_exp2f(m - mn); \
                m = mn; l *= alpha; slow = true; \
            _Pragma("unroll") \
                for (int r = 0; r < 16; ++r) { o0[r] *= alpha; o1[r] *= alpha; } \
            } \
            if (slow) { \
            _Pragma("unroll") \
                for (int r = 0; r < 16; ++r) { s0[r] -= m; s1[r] -= m; } \
            } \
            f32x2 ps2 = {0.f, 0.f}; \
            _Pragma("unroll") \
            for (int r = 0; r < 16; ++r) { s0[r] = __builtin_amdgcn_exp2f(s0[r]); s1[r] = __builtin_amdgcn_exp2f(s1[r]); } \
            _Pragma("unroll") \
            for (int r = 0; r < 16; r += 2) { ps2 += (f32x2){s0[r], s0[r + 1]}; ps2 += (f32x2){s1[r], s1[r + 1]}; } \
            l += ps2.x + ps2.y; \
            bf16x8 pb[4]; \
            pb[0] = pack_p(s0, 0); pb[1] = pack_p(s0, 1); pb[2] = pack_p(s1, 0); pb[3] = pack_p(s1, 1); \
            asm volatile("s_waitcnt lgkmcnt(0)" ::: "memory"); __builtin_amdgcn_sched_barrier(0); \
            pv_mma2(o0, o1, vl0, vh0, vl1, vh1, pb); \
            }
__device__ __forceinline__ void attn_mla_phase(LAS unsigned char* lds, const bf16_t* QB, const bf16_t* KV, const bf16_t* KRR, bf16_t* O, int G, int bx) {
    constexpr int KBUF = 64 * 208, VBUF = 8192, VOFF = 2 * KBUF;
    int tid_ = threadIdx.x; asm volatile("" : "+v"(tid_));
    const int tid = tid_, wid = __builtin_amdgcn_readfirstlane(tid >> 6), lane = tid & 63, r32 = lane & 31, hi = lane >> 5;
    const bool xs = (G % 8) == 0;
    const int nslots = xs ? G / 8 : G, slot = xs ? bx / 8 : bx, xcd = xs ? bx % 8 : 0, npx = xs ? 16 : 128;
    const int nent = npx * 40;
    const int skey = tid >> 3, sch = tid & 7, rkey = tid >> 2, rch = tid & 3;
    const int kdst = skey * 208 + sch * 16, rdst = rkey * 208 + 128 + rch * 16, vdst = (sch >> 2) * 4096 + skey * 64 + (sch & 3) * 16;
    const unsigned trb = (unsigned)(size_t)(lds + VOFF) + (unsigned)((4 * hi + ((lane & 15) >> 2)) * 64 + 32 * ((lane >> 4) & 1) + 8 * (lane & 3));
#define MLA_DEC(LI, P) int P##pair, P##qb, P##base, P##S; \
        if ((LI) < npx * 32) { P##pair = xs ? ((LI) >> 5) * 8 + xcd : ((LI) >> 5); P##qb = (LI) & 31; P##base = (P##pair >> 4) * 8192; P##S = 8192; } \
        else { const int l2_ = (LI) - npx * 32; P##pair = xs ? (l2_ >> 3) * 8 + xcd : (l2_ >> 3); P##qb = l2_ & 7; P##base = TP + (P##pair >> 4) * 2048; P##S = 2048; } \
        const int P##h = P##pair & 15; \
        const size_t P##qrow = (size_t)P##base + P##qb * 256 + wid * 32 + r32; \
        const bf16_t* P##qsrc = QB + P##qrow * NQ + P##h * 96 + hi * 8; \
        const bf16_t* P##kn = KV + (size_t)(P##base + skey) * NKV + P##h * 128 + sch * 8; \
        const bf16_t* P##kr = KRR + (size_t)(P##base + rkey) * 32 + rch * 8
    int li = slot;
    if (li >= nent) return;
    bf16x8 qf[6]; bf16x8 ska, sva, sra = {}, skb, svb, srb = {};
    {
        MLA_DEC(li, f_);
#pragma unroll
        for (int ks = 0; ks < 6; ++ks) qf[ks] = *(const bf16x8*)(f_qsrc + ks * 16);
        ska = *(const bf16x8*)f_kn; sva = *(const bf16x8*)(f_kn + 64); if (tid < 256) sra = *(const bf16x8*)f_kr;
        *(LAS bf16x8*)(lds + kdst) = ska; *(LAS bf16x8*)(lds + VOFF + vdst) = sva; if (tid < 256) *(LAS bf16x8*)(lds + rdst) = sra;
        ska = *(const bf16x8*)(f_kn + (size_t)64 * NKV); sva = *(const bf16x8*)(f_kn + (size_t)64 * NKV + 64); if (tid < 256) sra = *(const bf16x8*)(f_kr + 64 * 32);
    }
    __syncthreads();
    for (;;) {
        MLA_DEC(li, c_);
        const int lin = li + nslots; const bool hasn = lin < nent;
        MLA_DEC(hasn ? lin : li, n_);
        const int h = c_h; const size_t qrow = c_qrow;
        f32x16 o0 = {}, o1 = {}; float m = 0.f, l = 0.f; bool slow = false;
        const int NT = c_S / 64;
        const bf16_t* kn_src = c_kn; const bf16_t* kr_src = c_kr;
#define MLA_STEP(cur, SKL, SVL, SRL, SKW, SVW, SRW) { \
            { const bool own_ = j + 2 < NT; const size_t off = (size_t)(own_ ? j + 2 : j + 2 - NT) * 64; const bf16_t* kn_ = own_ ? kn_src : n_kn; const bf16_t* kr_ = own_ ? kr_src : n_kr; \
              SKL = *(const bf16x8*)(kn_ + off * NKV); SVL = *(const bf16x8*)(kn_ + off * NKV + 64); if (tid < 256) SRL = *(const bf16x8*)(kr_ + off * 32); } \
            MLA_COMPUTE(cur) \
            *(LAS bf16x8*)(lds + ((cur) ^ 1) * KBUF + kdst) = SKW; *(LAS bf16x8*)(lds + VOFF + ((cur) ^ 1) * VBUF + vdst) = SVW; if (tid < 256) *(LAS bf16x8*)(lds + ((cur) ^ 1) * KBUF + rdst) = SRW; \
            __syncthreads(); ++j; }
        for (int j = 0; j < NT;) {
            MLA_STEP(0, skb, svb, srb, ska, sva, sra)
            MLA_STEP(1, ska, sva, sra, skb, svb, srb)
        }
#undef MLA_STEP
        if (hasn) {
#pragma unroll
            for (int ks = 0; ks < 6; ++ks) qf[ks] = *(const bf16x8*)(n_qsrc + ks * 16);
        }
        l = xhalf_sum(l);
        const float inv = 1.f / l;
        bf16_t* orow = O + qrow * DM + h * 64 + 4 * hi;
#pragma unroll
        for (int g4 = 0; g4 < 4; ++g4) {
            u32x2 w0, w1;
            w0.x = cvt_pk_bf16(o0[4 * g4] * inv, o0[4 * g4 + 1] * inv); w0.y = cvt_pk_bf16(o0[4 * g4 + 2] * inv, o0[4 * g4 + 3] * inv);
            w1.x = cvt_pk_bf16(o1[4 * g4] * inv, o1[4 * g4 + 1] * inv); w1.y = cvt_pk_bf16(o1[4 * g4 + 2] * inv, o1[4 * g4 + 3] * inv);
            *(u32x2*)(orow + 8 * g4) = w0; *(u32x2*)(orow + 32 + 8 * g4) = w1;
        }
        if (!hasn) break;
        li = lin;
    }
#undef MLA_DEC
}

#undef MLA_COMPUTE
__device__ __forceinline__ void attn_dil_phase(LAS unsigned char* lds, const bf16_t* QKV, const float* BT, bf16_t* OG, float* LSE, int nseq, int log2S, int G, int bx) {
    constexpr int KBUF = 64 * 272, VBUF = 16384, VOFF = 2 * KBUF, TOFF = VOFF + 2 * VBUF;
    int tid_ = threadIdx.x; asm volatile("" : "+v"(tid_));
    const int tid = tid_, wid = __builtin_amdgcn_readfirstlane(tid >> 6), lane = tid & 63, r32 = lane & 31, hi = lane >> 5;
    const int S = 1 << log2S, nqb = S >> 8, nunits = nseq * 24 * nqb;
    const int key0 = tid >> 4, ch0 = tid & 15;
    const int kdst = key0 * 272 + ch0 * 16, vdst = (ch0 >> 2) * 4096 + key0 * 64 + (ch0 & 3) * 16;
    const unsigned trb = (unsigned)(size_t)(lds + VOFF) + (unsigned)((4 * hi + ((lane & 15) >> 2)) * 64 + 32 * ((lane >> 4) & 1) + 8 * (lane & 3));
    LAS float* tab = (LAS float*)(lds + TOFF);
#define DIL_DEC(uu, P) const int P##qb = (uu) % nqb; int P##rest = (uu) / nqb; const int P##h = P##rest & 7; P##rest >>= 3; const int P##g = P##rest % 3, P##seq = P##rest / 3; \
        const int P##f0 = P##qb * 256, P##rowbase = P##seq << log2S, P##tlo = (P##f0 == 0) ? 1 : 0; \
        const bf16_t* P##qsrc = QKV + ((size_t)P##rowbase + P##f0 + wid * 32 + r32) * NQKV + P##g * 3072 + P##h * 128 + hi * 8; \
        const bf16_t* P##ksrc = QKV + (long)(P##rowbase + P##f0 - 64 + key0) * NQKV + P##g * 3072 + 1024 + P##h * 128 + ch0 * 8; \
        const float* P##tsrc = BT + (P##g * 8 + P##h) * 384 + (tid < 384 ? tid : 0)
#define DIL_TILE(src, t) do { const bf16_t* p_ = (src) + (size_t)((t) * 64) * NQKV; k0r = *(const bf16x8*)p_; v0r = *(const bf16x8*)(p_ + 1024); k1r = *(const bf16x8*)(p_ + (size_t)32 * NQKV); v1r = *(const bf16x8*)(p_ + (size_t)32 * NQKV + 1024); } while (0)
    bf16x8 qn[8] = {}, k0r = {}, k1r = {}, v0r = {}, v1r = {}; float tabv = 0.f;
    if (bx < nunits) {
        DIL_DEC(bx, a_);
#pragma unroll
        for (int ks = 0; ks < 8; ++ks) qn[ks] = *(const bf16x8*)(a_qsrc + ks * 16);
        DIL_TILE(a_ksrc, a_tlo); tabv = *a_tsrc;
    }
    for (int u = bx; u < nunits; u += G) {
        DIL_DEC(u, c_);
        const int h = c_h, g = c_g, f0 = c_f0, rowbase = c_rowbase, tlo = c_tlo;
        const int sh = 2 * g, log2L = log2S - sh;
        bf16x8 qf[8];
#pragma unroll
        for (int ks = 0; ks < 8; ++ks) qf[ks] = qn[ks];
        if (tid < 384) tab[tid] = tabv;
        f32x16 o[4] = {}; float m = -1e30f, l = 0.f;
        const int thi = (f0 + 256 >= S) ? 4 : 5;
        const int wt0 = wid >> 1, myblk = (f0 + 32 * wid) >> log2L;
        const bf16_t* ksrc = c_ksrc;
        const int tbase = 128 - 32 * wid - r32 + 4 * hi;
        *(LAS bf16x8*)(lds + kdst) = k0r; *(LAS bf16x8*)(lds + kdst + 32 * 272) = k1r; *(LAS bf16x8*)(lds + VOFF + vdst) = v0r; *(LAS bf16x8*)(lds + VOFF + vdst + 32 * 64) = v1r;
        const int un = u + G; const bool hasn = un < nunits;
        DIL_DEC(hasn ? un : u, n_);
        if (hasn) {
#pragma unroll
            for (int ks = 0; ks < 8; ++ks) qn[ks] = *(const bf16x8*)(n_qsrc + ks * 16);
            tabv = *n_tsrc;
        }
        __syncthreads();
        for (int t = tlo; t <= thi; ++t) {
            const int cur = (t - tlo) & 1;
            if (t < thi) DIL_TILE(ksrc, t + 1); else if (hasn) DIL_TILE(n_ksrc, n_tlo);
            const int fk0 = f0 - 64 + 64 * t;
            if (t >= wt0 && t <= wt0 + 2 && (fk0 >> log2L) == myblk) {
                const LAS unsigned char* Kb = lds + cur * KBUF;
                f32x16 s0 = {}, s1 = {};
#pragma unroll
                for (int ks = 0; ks < 8; ++ks) {
                    const bf16x8 a0 = *(const LAS bf16x8*)(Kb + r32 * 272 + ks * 32 + hi * 16), a1 = *(const LAS bf16x8*)(Kb + (32 + r32) * 272 + ks * 32 + hi * 16);
                    s0 = MFMA32(a0, qf[ks], s0); s1 = MFMA32(a1, qf[ks], s1);
                }
                const LAS float* tb = tab + tbase + 64 * t;
#pragma unroll
                for (int r = 0; r < 16; ++r) { s0[r] += tb[(r & 3) + 8 * (r >> 2)]; s1[r] += tb[32 + (r & 3) + 8 * (r >> 2)]; }
                float pmax = s0[0];
#pragma unroll
                for (int r = 1; r < 16; ++r) pmax = fmaxf(pmax, s0[r]);
#pragma unroll
                for (int r = 0; r < 16; ++r) pmax = fmaxf(pmax, s1[r]);
                pmax = xhalf_max(pmax);
                if (__any(pmax > m + 8.f)) {
                    const float mn = fmaxf(m, pmax), alpha = __builtin_amdgcn_exp2f(m - mn);
                    m = mn; l *= alpha;
#pragma unroll
                    for (int d = 0; d < 4; ++d)
#pragma unroll
                        for (int r = 0; r < 16; ++r) o[d][r] *= alpha;
                }
                float ps = 0.f;
#pragma unroll
                for (int r = 0; r < 16; ++r) { s0[r] = __builtin_amdgcn_exp2f(s0[r] - m); s1[r] = __builtin_amdgcn_exp2f(s1[r] - m); ps += s0[r] + s1[r]; }
                l += ps;
                bf16x8 pb[4];
                pb[0] = pack_p(s0, 0); pb[1] = pack_p(s0, 1); pb[2] = pack_p(s1, 0); pb[3] = pack_p(s1, 1);
                const unsigned va = trb + cur * VBUF;
                pv_tile(o[0], va, pb); pv_tile(o[1], va + 4096, pb); pv_tile(o[2], va + 8192, pb); pv_tile(o[3], va + 12288, pb);
            }
            if (t < thi) {
                const int nb = cur ^ 1;
                *(LAS bf16x8*)(lds + nb * KBUF + kdst) = k0r; *(LAS bf16x8*)(lds + nb * KBUF + kdst + 32 * 272) = k1r;
                *(LAS bf16x8*)(lds + VOFF + nb * VBUF + vdst) = v0r; *(LAS bf16x8*)(lds + VOFF + nb * VBUF + vdst + 32 * 64) = v1r;
            }
            __syncthreads();
        }
        l = xhalf_sum(l);
        const float inv = 1.f / l;
        const int f = f0 + wid * 32 + r32, stok = ((f & ((1 << log2L) - 1)) << sh) + (f >> log2L);
        const size_t orow = (size_t)rowbase + stok;
        bf16_t* op = OG + ((size_t)g * CHUNK + orow) * DM + h * 128 + 4 * hi;
#pragma unroll
        for (int d = 0; d < 4; ++d)
#pragma unroll
            for (int g4 = 0; g4 < 4; ++g4) {
                u32x2 w; w.x = cvt_pk_bf16(o[d][4 * g4] * inv, o[d][4 * g4 + 1] * inv); w.y = cvt_pk_bf16(o[d][4 * g4 + 2] * inv, o[d][4 * g4 + 3] * inv);
                *(u32x2*)(op + 32 * d + 8 * g4) = w;
            }
        if (hi == 0) LSE[((size_t)g * CHUNK + orow) * 8 + h] = m + __log2f(l);
    }
}
#undef DIL_DEC
#undef DIL_TILE

#define XB_TMO      128
#define XB_XCNT(j)  (256  + 64 * (j))
#define XB_XSUB(j)  (1280 + 64 * (j))
#define XB_XGEN(j)  (2304 + 64 * (j))
#define XB_TOP      3328
#define XB_TOPGEN   3392
#define XCD_BAR_WORDS 3456
#define XB_SPIN_CAP (1u << 18)

__device__ __forceinline__ unsigned xb_ld(unsigned* p)              { return __hip_atomic_load(p, __ATOMIC_RELAXED, __HIP_MEMORY_SCOPE_AGENT); }
__device__ __forceinline__ unsigned xb_add(unsigned* p, unsigned v) { return __hip_atomic_fetch_add(p, v, __ATOMIC_RELAXED, __HIP_MEMORY_SCOPE_AGENT); }
__device__ __forceinline__ unsigned xb_xcc_id() { return (unsigned)__builtin_amdgcn_s_getreg((3 << 11) | 20) & 0xFu; }
#define XB_SPIN(cond, bar) do { unsigned _sp = 0; while (cond) { __builtin_amdgcn_s_sleep(1); \
    if ((++_sp & 255u) == 0u) { if (xb_ld(&(bar)[XB_TMO])) break; if (_sp > XB_SPIN_CAP) { atomicAdd(&(bar)[XB_TMO], 1u); break; } } } } while (0)

struct XcdBarrier {
    unsigned* bar; unsigned x;
    volatile LAS unsigned* st;
};

__device__ __forceinline__ XcdBarrier xcd_barrier_post(unsigned* bar, volatile LAS unsigned* st) {
    XcdBarrier b; b.bar = bar; b.x = xb_xcc_id(); b.st = st;
    if (threadIdx.x == 0) (void)xb_add(&bar[XB_XCNT(b.x)], 1u);
    return b;
}
__device__ __forceinline__ void xcd_barrier_complete(unsigned* bar, unsigned x, unsigned& nloc, unsigned& nx) {
    const unsigned G = gridDim.x * gridDim.y * gridDim.z;
    unsigned sum, cnt, mine, sp = 0u;
    for (;;) {
        sum = 0u; cnt = 0u; mine = 0u;
#pragma unroll
        for (unsigned j = 0; j < 16; ++j) { const unsigned c = xb_ld(&bar[XB_XCNT(j)]); sum += c; cnt += (c > 0u) ? 1u : 0u; mine = (j == x) ? c : mine; }
        if (sum == G) break;
        __builtin_amdgcn_s_sleep(1);
        if ((++sp & 255u) == 0u) { if (xb_ld(&bar[XB_TMO])) break; if (sp > XB_SPIN_CAP) { atomicAdd(&bar[XB_TMO], 1u); break; } }
    }
    nloc = mine > 0u ? mine : 1u; nx = cnt > 0u ? cnt : 1u;
}

__device__ __forceinline__ void xcd_barrier(const XcdBarrier& b) {
    asm volatile("s_waitcnt vmcnt(0)" ::: "memory");
    __syncthreads();
    if (threadIdx.x == 0) {
        unsigned* bar = b.bar;
        __builtin_amdgcn_s_waitcnt(0);
        unsigned nloc = b.st[0], nx = b.st[1];
        if (nloc == 0u) { xcd_barrier_complete(bar, b.x, nloc, nx); b.st[0] = nloc; b.st[1] = nx; }
        const unsigned old = xb_add(&bar[XB_XSUB(b.x)], 1u);
        const unsigned gen = old / nloc;
        if (old + 1u == (gen + 1u) * nloc) {
            __builtin_amdgcn_fence(__ATOMIC_RELEASE, "agent");
            asm volatile("s_waitcnt vmcnt(0)" ::: "memory");
            const unsigned og = xb_add(&bar[XB_TOP], 1u);
            const unsigned tg = og / nx;
            if (og + 1u == (tg + 1u) * nx) xb_add(&bar[XB_TOPGEN], 1u);
            else XB_SPIN(xb_ld(&bar[XB_TOPGEN]) == tg, bar);
            __builtin_amdgcn_fence(__ATOMIC_ACQUIRE, "agent");
            xb_add(&bar[XB_XGEN(b.x)], 1u);
            asm volatile("s_waitcnt vmcnt(0)" ::: "memory");
        } else {
            XB_SPIN(xb_ld(&bar[XB_XGEN(b.x)]) == gen, bar);
            __builtin_amdgcn_fence(__ATOMIC_ACQUIRE, "agent");
            asm volatile("s_waitcnt vmcnt(0)" ::: "memory");
        }
    }
    __syncthreads();
}

__global__ void __launch_bounds__(512, 2) mega_fwd(Params p) {
    extern __shared__ __attribute__((aligned(16))) unsigned char lds_raw[];
    LAS unsigned char* lds = (LAS unsigned char*)lds_raw;
    const int G0 = gridDim.x, bx0 = blockIdx.x;
#define PH_LOCALS PH_WS; int tid = threadIdx.x; asm volatile("" : "+v"(tid)); const int lane = tid & 63, wave = __builtin_amdgcn_readfirstlane(tid >> 6), gw = bx * 8 + wave; (void)lane; (void)gw
#define PH_WS const __attribute__((address_space(4))) Params* kp = (const __attribute__((address_space(4))) Params*)__builtin_amdgcn_kernarg_segment_ptr(); asm volatile("" : "+s"(kp)); \
        unsigned char* ws = kp->ws; float* X = kp->out; (void)X; int G = G0, bx = bx0; asm volatile("" : "+s"(G), "+s"(bx)); const int NGW = G * 8; (void)NGW
#define XB ((bf16_t*)(ws + WS_XB))
#define OB ((bf16_t*)(ws + WS_O))
#define cosT ((float*)(ws + WS_COS))
#define sinT ((float*)(ws + WS_SIN))
#define BT ((float*)(ws + WS_BT))
#define RQ ((float*)(ws + WS_RQ))
#define RKV ((float*)(ws + WS_RKV))
#define WQKV ((bf16_t*)(ws + WS_WQKV))
#define WOA ((bf16_t*)(ws + WS_WOA))
#define WDKV ((bf16_t*)(ws + WS_WDKV))
#define WUQ ((bf16_t*)(ws + WS_WUQ))
#define WUKV ((bf16_t*)(ws + WS_WUKV))
#define WOB ((bf16_t*)(ws + WS_WOB))
#define WIN ((bf16_t*)(ws + WS_WIN))
#define WOUT ((bf16_t*)(ws + WS_WOUT))
#define QKV ((bf16_t*)(ws + WS_QKV))
#define OG ((bf16_t*)(ws + WS_OG))
#define LSE ((float*)(ws + WS_LSE))
#define CB ((bf16_t*)(ws + WS_C))
#define QB ((bf16_t*)(ws + WS_QB))
#define KVB ((bf16_t*)(ws + WS_KV))
#define KRR ((bf16_t*)(ws + WS_KRR))
#define UB ((bf16_t*)(ws + WS_U))
#define Y1B ((bf16_t*)(ws + WS_S))
#define Y2B ((bf16_t*)(ws + WS_Y2))
#define HB ((bf16_t*)(ws + WS_H))
    cg::grid_group grid = cg::this_grid();
    volatile LAS unsigned* bst = (volatile LAS unsigned*)(lds + LDS_BYTES - 64);
    if (threadIdx.x == 0) { bst[0] = 0u; bst[1] = 0u; }
    __syncthreads();
    const XcdBarrier xbar = xcd_barrier_post((unsigned*)(p.ws + WS_CTL), bst);
    int ph = 0;
    const int lo = p.ph_lo, hi = p.ph_hi;
#define PH_ON (ph >= lo && ph < hi)
#ifndef MK_EN
#define MK_EN 0xffffffffu
#endif
#define EN(k) (((MK_EN) >> (k)) & 1u)
#ifndef MK_REP
#define MK_REP 0u
#endif
#define REPN(k) ((((MK_REP) >> (k)) & 1u) != 0)
#define REPN(k) ((((MK_REP) >> (k)) & 1u) != 0)
#define REP(k) for (int rep_ = 0; rep_ < ((((MK_REP) >> (k)) & 1u) ? 2 : 1); ++rep_)
#define PH_END do { if (ph >= lo && ph + 1 < hi) { if (lo < 0) grid.sync(); else xcd_barrier(xbar); } ++ph; } while (0)

    if (EN(0) && PH_ON) REP(0) {
        PH_LOCALS;
        LAS float* scr = (LAS float*)(lds + wave * 16384);
        constexpr int I_QKV = (DM / 64) * (NQKV / 32), I_O = (DM / 64) * (DM / 32), I_DKV = (DM / 64) * (672 / 32), I_UQ = (NCQ / 64) * (NQ / 32), I_UKV = (NCKV / 64) * (NKV / 32);
        constexpr int I_IN = (DM / 64) * (NFF / 32), I_OUT = (DFF / 64) * (DM / 32);
        constexpr int NITEMS = I_QKV + 2 * I_O + I_DKV + I_UQ + I_UKV + 2 * I_IN + 2 * I_OUT;
        for (int it = gw; it < NITEMS; it += NGW) {
            int r = it;
            if (r < I_QKV) { transpose_item(kp->w_qkv_a, DM, NQKV, WQKV, 0, nullptr, scr, r, lane); continue; } r -= I_QKV;
            if (r < I_O) { transpose_item(kp->w_o_a, DM, DM, WOA, 0, nullptr, scr, r, lane); continue; } r -= I_O;
            if (r < I_O) { transpose_item(kp->w_o_b, DM, DM, WOB, 0, nullptr, scr, r, lane); continue; } r -= I_O;
            if (r < I_DKV) { transpose_item(kp->w_dkv_b, DM, 672, WDKV, 2, nullptr, scr, r, lane); continue; } r -= I_DKV;
            if (r < I_UQ) { transpose_item(kp->w_uq_b, NCQ, NQ, WUQ, 1, kp->g_q_b, scr, r, lane); continue; } r -= I_UQ;
            if (r < I_UKV) { transpose_item(kp->w_ukv_b, NCKV, NKV, WUKV, 0, kp->g_kv_b, scr, r, lane); continue; } r -= I_UKV;
            if (r < 2 * I_IN) { const int ly = r / I_IN; transpose_item(kp->ffn_w_in + (size_t)ly * DM * NFF, DM, NFF, WIN + (size_t)ly * NFF * DM, 0, nullptr, scr, r - ly * I_IN, lane); continue; } r -= 2 * I_IN;
            { const int ly = r / I_OUT; transpose_item(kp->ffn_w_out + (size_t)ly * DFF * DM, DFF, DM, WOUT + (size_t)ly * DM * DFF, 0, nullptr, scr, r - ly * I_OUT, lane); }
        }
        for (int i = bx * 512 + tid; i < 96 * DM / 8; i += G * 512) *((u32x4*)(WDKV + (size_t)672 * DM) + i) = (u32x4){0u, 0u, 0u, 0u};
        for (int r = gw; r < T; r += 2 * NGW) {
            const int r2 = r + NGW; const bool h2 = r2 < T;
            const float* src = r < TP ? kp->x_prompt + (size_t)r * DM : kp->x_sample + (size_t)(r - TP) * DM;
            const float* src2 = r2 < TP ? kp->x_prompt + (size_t)r2 * DM : kp->x_sample + (size_t)((h2 ? r2 : r) - TP) * DM;
            f32x4 va[4], vb[4] = {};
#pragma unroll
            for (int j = 0; j < 4; ++j) { va[j] = *((const f32x4*)src + lane + 64 * j); if (h2) vb[j] = *((const f32x4*)src2 + lane + 64 * j); }
#pragma unroll
            for (int j = 0; j < 4; ++j) {
                u32x2 w; w.x = cvt_pk_bf16(va[j].x, va[j].y); w.y = cvt_pk_bf16(va[j].z, va[j].w);
                *((u32x2*)(XB + (size_t)r * DM) + lane + 64 * j) = w;
                if (h2) { u32x2 w2; w2.x = cvt_pk_bf16(vb[j].x, vb[j].y); w2.y = cvt_pk_bf16(vb[j].z, vb[j].w); *((u32x2*)(XB + (size_t)r2 * DM) + lane + 64 * j) = w2; }
            }
        }
        for (int i = bx * 512 + tid; i < 8192 * 16; i += G * 512) { float c, s; rope_entry(i >> 4, i & 15, c, s); cosT[i] = c; sinT[i] = s; }
        for (int i = bx * 512 + tid; i < 24 * 384; i += G * 512) {
            const int gh = i / 384, d = i % 384 - 192, g = gh >> 3;
            float v = -1e30f;
            if (d >= -64 && d <= 64) v = kp->rel_bias[t5_bucket(d * (1 << (2 * g))) * 24 + gh] * LOG2E;
            BT[i] = v;
        }
    }
    PH_END;

    {
        for (int c = 0; c < NCHUNK; ++c) {
            const int row0 = c * CHUNK, log2S = c < 4 ? 13 : 11, nseq = c < 4 ? 2 : 8;
            if (EN(1) && PH_ON) REP(1) {
                PH_WS;
                pg8::Gemm g{XB + (size_t)row0 * DM, WQKV, CHUNK, NQKV, DM, DM}; pg8::StaticOrder S; S.init(CHUNK, NQKV, G, bx);
                pg8::EpiQKV E{QKV, log2S, 0.08838834764831845f * LOG2E};
                pg8::gemm_phase<pg8::EpiQKV, pg8::StaticOrder>(lds, g, S, E);
            }
            PH_END;
            if (EN(2) && PH_ON) REP(2) { PH_WS; attn_dil_phase(lds, QKV, BT, OG, LSE, nseq, log2S, G, bx); }
            PH_END;
            if (EN(3) && PH_ON) REP(3) {   PH_LOCALS;
                for (int r = gw; r < CHUNK; r += NGW) {
                    const int h = lane >> 3;
                    const float l0 = LSE[((size_t)0 * CHUNK + r) * 8 + h], l1 = LSE[((size_t)1 * CHUNK + r) * 8 + h], l2 = LSE[((size_t)2 * CHUNK + r) * 8 + h];
                    const float mx = fmaxf(l0, fmaxf(l1, l2));
                    float w0 = __builtin_amdgcn_exp2f(l0 - mx), w1 = __builtin_amdgcn_exp2f(l1 - mx), w2 = __builtin_amdgcn_exp2f(l2 - mx);
                    const float inv = 1.f / (w0 + w1 + w2); w0 *= inv; w1 *= inv; w2 *= inv;
#pragma unroll
                    for (int j = 0; j < 2; ++j) {
                        const bf16x8 a = *((const bf16x8*)(OG + ((size_t)0 * CHUNK + r) * DM) + lane * 2 + j), b = *((const bf16x8*)(OG + ((size_t)1 * CHUNK + r) * DM) + lane * 2 + j),
                                     cc = *((const bf16x8*)(OG + ((size_t)2 * CHUNK + r) * DM) + lane * 2 + j);
                        float v[8];
#pragma unroll
                        for (int e = 0; e < 8; ++e) v[e] = w0 * bf2f((unsigned short)a[e]) + w1 * bf2f((unsigned short)b[e]) + w2 * bf2f((unsigned short)cc[e]);
                        u32x4 w; w.x = cvt_pk_bf16(v[0], v[1]); w.y = cvt_pk_bf16(v[2], v[3]); w.z = cvt_pk_bf16(v[4], v[5]); w.w = cvt_pk_bf16(v[6], v[7]);
                        *((u32x4*)(OB + (size_t)(row0 + r) * DM) + lane * 2 + j) = w;
                    }
                }
            }
            if (c + 1 < NCHUNK && MK_MULTI == 0) ++ph; else PH_END;
        }
    }
    for (int layer = 0; layer < 2; ++layer) {
        if (layer == 1) {
            if (EN(4) && PH_ON) REP(4) {
                PH_WS;
                pg8::Gemm g{XB, WDKV, T, CW, DM, DM}; pg8::StaticOrder S; S.init(T, CW, G, bx);
                pg8::EpiStore E{CB, CW, nullptr, 1.f};
                pg8::gemm_phase<pg8::EpiStore, pg8::StaticOrder>(lds, g, S, E);
            }
            PH_END;
            if (EN(5) && PH_ON) REP(5) {   PH_LOCALS;
                for (int r = gw; r < T; r += NGW) {
                    const bf16_t* crow = CB + (size_t)r * CW;
                    const bf16x8 a = *((const bf16x8*)crow + lane);
                    bf16x8 b = {}; if (lane < 20) b = *((const bf16x8*)crow + 64 + lane);
                    float fa[8], fb[8], sa = 0.f, sb = 0.f;
#pragma unroll
                    for (int e = 0; e < 8; ++e) { fa[e] = bf2f((unsigned short)a[e]); fb[e] = bf2f((unsigned short)b[e]); sa += fa[e] * fa[e]; sb += fb[e] * fb[e]; }
                    const float sq = wave_sum(lane < 48 ? sa : 0.f, lane), skv = wave_sum((lane >= 48 ? sa : 0.f) + (lane < 16 ? sb : 0.f), lane);
                    if (lane == 0) { RQ[r] = 1.f / sqrtf(sq * (1.f / NCQ) + RMS_EPS); RKV[r] = 1.f / sqrtf(skv * (1.f / NCKV) + RMS_EPS); }
                    if (lane >= 16 && lane < 20) {
                        const int j = lane - 16, pos = r < TP ? (r & 8191) : (r & 2047);
                        const f32x4 cs = *(const f32x4*)(cosT + pos * 16 + 4 * j), sn = *(const f32x4*)(sinT + pos * 16 + 4 * j);
                        float o1[4], o2[4];
#pragma unroll
                        for (int e = 0; e < 4; ++e) { o1[e] = fb[e] * cs[e] - fb[4 + e] * sn[e]; o2[e] = fb[e] * sn[e] + fb[4 + e] * cs[e]; }
                        u32x4 w; w.x = cvt_pk_bf16(o1[0], o1[1]); w.y = cvt_pk_bf16(o1[2], o1[3]); w.z = cvt_pk_bf16(o2[0], o2[1]); w.w = cvt_pk_bf16(o2[2], o2[3]);
                        *((u32x4*)(KRR + (size_t)r * 32) + j) = w;
                    }
                }
            }
            PH_END;
            if (EN(6) && PH_ON) REP(6) {
                PH_WS;
                { pg8::Gemm g{CB, WUQ, T, NQ, NCQ, CW}; pg8::StaticOrder S; S.init(T, NQ, G, bx);
                  pg8::EpiQRope E{QB, RQ, 0.10206207261596575f * LOG2E, cosT, sinT};
                  pg8::gemm_phase<pg8::EpiQRope, pg8::StaticOrder>(lds, g, S, E); }
                { pg8::Gemm g{CB + NCQ, WUKV, T, NKV, NCKV, CW}; pg8::StaticOrder S; S.init(T, NKV, G, bx);
                  pg8::EpiStore E{KVB, NKV, RKV, 1.f};
                  pg8::gemm_phase<pg8::EpiStore, pg8::StaticOrder>(lds, g, S, E); }
            }
            PH_END;
            if (EN(7) && PH_ON) REP(7) { PH_WS; attn_mla_phase(lds, QB, KVB, KRR, OB, G, bx); }
            PH_END;
        }
        if (EN(8) && PH_ON) REP(8) {
                PH_WS;
            pg8::Gemm g{OB, layer == 0 ? WOA : WOB, T, DM, DM, DM}; pg8::StaticOrder S; S.init(T, DM, G, bx);
            pg8::EpiStore E{Y1B, DM, nullptr, 1.f};
            pg8::gemm_phase<pg8::EpiStore, pg8::StaticOrder>(lds, g, S, E);
        }
        PH_END;
        if (EN(9) && PH_ON) REP(9) { PH_LOCALS; ln_phase(layer == 0 ? kp->x_prompt : X, layer == 0 ? kp->x_sample : X + (size_t)TP * DM, Y1B, (REPN(9) && rep_ == 0) ? (float*)(ws + 560 * MiB) : X, (REPN(9) && rep_ == 0) ? OB : XB, kp->ln_g + (layer * 2 + 0) * DM, kp->ln_b + (layer * 2 + 0) * DM, gw, NGW, lane); }
        PH_END;
        {
            for (int c = 0; c < 3; ++c) {
                const int row0 = c * 32768, crows = c < 2 ? 32768 : 16384, log2S = c < 2 ? 13 : 11;
                if (EN(10) && PH_ON) REP(10) {
                PH_WS;
                    pg8::Gemm g{XB + (size_t)row0 * DM, WIN + (size_t)layer * NFF * DM, crows, NFF, DM, DM}; pg8::StaticOrder S; S.init(crows, NFF, G, bx);
                    pg8::EpiStore E{HB, NFF, nullptr, 1.f};
                    pg8::gemm_phase<pg8::EpiStore, pg8::StaticOrder>(lds, g, S, E);
                }
                PH_END;
                if (EN(11) && PH_ON) REP(11) {   PH_LOCALS;
                    const float* cw = kp->ffn_conv_w + (size_t)layer * 3 * NFF; const float* cb = kp->ffn_conv_b + (size_t)layer * NFF; const bf16_t* H = HB; bf16_t* U = UB;
                    const int nitems = (crows / 8) * 11, smask = (1 << log2S) - 1;
                    for (int it = gw; it < nitems; it += NGW) {
                        const int rr = it / 11, cgp = it - rr * 11, col = (cgp * 64 + lane) * 4, r0 = rr * 8;
                        u32x2 ra[10], rg[10];
                        const bool hp = (r0 & smask) != 0, hn = ((r0 + 8) & smask) != 0;
#pragma unroll
                        for (int i = 0; i < 10; ++i) {
                            const bool ok = (i == 0) ? hp : (i == 9) ? hn : true;
                            if (ok) { ra[i] = *(const u32x2*)(H + (size_t)(r0 - 1 + i) * NFF + col); rg[i] = *(const u32x2*)(H + (size_t)(r0 - 1 + i) * NFF + DFF + col); }
                            else { ra[i] = (u32x2){0u, 0u}; rg[i] = (u32x2){0u, 0u}; }
                        }
                        f32x4 wa[3], wg[3];
#pragma unroll
                        for (int k = 0; k < 3; ++k) { wa[k] = *(const f32x4*)(cw + k * NFF + col); wg[k] = *(const f32x4*)(cw + k * NFF + DFF + col); }
                        const f32x4 ba = *(const f32x4*)(cb + col), bg = *(const f32x4*)(cb + DFF + col);
#define BF4(u) ((f32x4){__uint_as_float((u).x << 16), __uint_as_float((u).x & 0xffff0000u), __uint_as_float((u).y << 16), __uint_as_float((u).y & 0xffff0000u)})
#pragma unroll
                        for (int i = 0; i < 8; ++i) {
                            const f32x4 av = wa[0] * BF4(ra[i]) + wa[1] * BF4(ra[i + 1]) + wa[2] * BF4(ra[i + 2]) + ba;
                            const f32x4 gv = wg[0] * BF4(rg[i]) + wg[1] * BF4(rg[i + 1]) + wg[2] * BF4(rg[i + 2]) + bg;
                            u32x2 w; w.x = cvt_pk_bf16(av[0] * gelu_erf(gv[0]), av[1] * gelu_erf(gv[1])); w.y = cvt_pk_bf16(av[2] * gelu_erf(gv[2]), av[3] * gelu_erf(gv[3]));
                            *(u32x2*)(U + (size_t)(row0 + r0 + i) * DFF + col) = w;
                        }
#undef BF4
                    }
                }
                PH_END;
            }
            if (EN(12) && PH_ON) REP(12) {
                PH_WS;
                pg8::Gemm g{UB, WOUT + (size_t)layer * DM * DFF, T, DM, DFF, DFF}; pg8::StaticOrder S; S.init(T, DM, G, bx);
                pg8::EpiStore E{Y2B, DM, nullptr, 1.f};
                pg8::gemm_phase<pg8::EpiStore, pg8::StaticOrder>(lds, g, S, E);
            }
            PH_END;
            if (EN(13) && PH_ON) REP(13) { PH_LOCALS; ln_phase(X, X + (size_t)TP * DM, Y2B, (REPN(13) && rep_ == 0) ? (float*)(ws + 222 * MiB) : X, (REPN(13) && rep_ == 0) ? (bf16_t*)(ws + 822 * MiB) : XB, kp->ln_g + (layer * 2 + 1) * DM, kp->ln_b + (layer * 2 + 1) * DM, gw, NGW, lane, layer == 0); }
            PH_END;
        }
    }
#undef PH_ON
#undef PH_END
}
constexpr int N_PHASES = 1 + 15 + 2 * (2 + 8) + 4;

extern "C" void kernel_launch(void* const* d_in, const int* in_sizes, int n_in, void* d_out, int out_size, void* d_ws, size_t ws_size, hipStream_t stream) {
    static int grid = 0;
    if (grid == 0) {
        if (n_in != 17 || out_size != T * DM || ws_size < WS_END) { fprintf(stderr, "kernel_launch: unexpected shapes (n_in %d out %d ws %zu)\n", n_in, out_size, ws_size); grid = -1; return; }
        int dev = 0, cus = 0, per_cu = 0;
        if (hipGetDevice(&dev) != hipSuccess || hipDeviceGetAttribute(&cus, hipDeviceAttributeMultiprocessorCount, dev) != hipSuccess) { grid = -1; return; }
        if (hipFuncSetAttribute((const void*)mega_fwd, hipFuncAttributeMaxDynamicSharedMemorySize, LDS_BYTES) != hipSuccess) { fprintf(stderr, "kernel_launch: hipFuncSetAttribute failed\n"); grid = -1; return; }
        if (hipOccupancyMaxActiveBlocksPerMultiprocessor(&per_cu, (const void*)mega_fwd, 512, LDS_BYTES) != hipSuccess || per_cu < 1) { fprintf(stderr, "kernel_launch: occupancy query says %d\n", per_cu); per_cu = 1; }
        (void)hipGetLastError();
        grid = cus * 1;
    }
    if (grid < 0) return;
    if (hipMemsetAsync((char*)d_ws + WS_CTL, 0, CTL_BYTES, stream) != hipSuccess) { fprintf(stderr, "kernel_launch: memset failed\n"); return; }
    Params p{};
    const float** pp = (const float**)&p;
    for (int i = 0; i < 17; ++i) pp[i] = (const float*)d_in[i];
    p.out = (float*)d_out; p.ws = (unsigned char*)d_ws;
#if MK_MULTI
    for (int k = 0; k < N_PHASES; ++k) { p.ph_lo = k; p.ph_hi = k + 1; hipLaunchKernelGGL(mega_fwd, dim3(grid), dim3(512), LDS_BYTES, stream, p); }
#else
    p.ph_lo = 0; p.ph_hi = N_PHASES;
    void* args[] = {&p};
    hipError_t e = hipLaunchCooperativeKernel((const void*)mega_fwd, dim3(grid), dim3(512), args, LDS_BYTES, stream);
    if (e != hipSuccess) fprintf(stderr, "cooperative launch failed: %s (grid %d)\n", hipGetErrorString(e), grid);
#endif
}
```

```cpp
#include <hip/hip_runtime.h>
#include <hip/hip_cooperative_groups.h>
#include <cstdio>
#include <cstdint>
namespace cg = cooperative_groups;

#ifndef MK_MULTI
#define MK_MULTI 0
#endif

#define LAS __attribute__((address_space(3)))
typedef unsigned short bf16_t;
typedef short bf16x8 __attribute__((ext_vector_type(8)));
typedef short s16x4 __attribute__((ext_vector_type(4)));
typedef float f32x4 __attribute__((ext_vector_type(4)));
typedef float f32x2 __attribute__((ext_vector_type(2)));
typedef float f32x16 __attribute__((ext_vector_type(16)));
typedef unsigned u32x4 __attribute__((ext_vector_type(4)));
typedef unsigned u32x2 __attribute__((ext_vector_type(2)));

constexpr int DM = 1024, TP = 65536, TS = 16384, T = TP + TS;
constexpr int NQKV = 9216, DFF = 2816, NFF = 2 * DFF;
constexpr int CW = 768, NCQ = 384, NCKV = 256, NQ = 1536, NKV = 2048;
constexpr int CHUNK = 16384, NCHUNK = 5;
constexpr float ALPHA = 1.4142135623730951f;
constexpr float LOG2E = 1.4426950408889634f;
constexpr float LN_EPS = 1e-5f, RMS_EPS = 1e-6f;

constexpr size_t MiB = 1u << 20;
constexpr size_t WS_COS = 0, WS_SIN = 512 * 1024, WS_BT = 1 * MiB, WS_RQ = 1 * MiB + 256 * 1024, WS_RKV = 1 * MiB + 640 * 1024;
constexpr size_t WS_WQKV = 2 * MiB, WS_WOA = 20 * MiB, WS_WDKV = 22 * MiB, WS_WUQ = 24 * MiB, WS_WUKV = 25 * MiB + 512 * 1024, WS_WOB = 27 * MiB;
constexpr size_t WS_WIN = 29 * MiB, WS_WOUT = 51 * MiB;
constexpr size_t WS_XB = 62 * MiB, WS_O = 222 * MiB, WS_C = 222 * MiB, WS_S = 382 * MiB;
constexpr size_t WS_QKV = WS_S, WS_OG = WS_S + 288 * MiB, WS_LSE = WS_S + 384 * MiB;
constexpr size_t WS_U = WS_O, WS_H = WS_O + 440 * MiB, WS_Y2 = WS_H;
constexpr size_t WS_QB = WS_S, WS_KV = WS_S + 240 * MiB, WS_KRR = WS_S + 560 * MiB;
constexpr size_t WS_CTL = 1016 * MiB, CTL_BYTES = 65536;
constexpr size_t WS_END = WS_CTL + CTL_BYTES;
constexpr int LDS_BYTES = 147456;

__device__ __forceinline__ unsigned cvt_pk_bf16(float lo, float hi) { unsigned r; asm volatile("v_cvt_pk_bf16_f32 %0, %1, %2" : "=v"(r) : "v"(lo), "v"(hi)); return r; }
__device__ __forceinline__ u32x4 pack8(f32x4 v0, f32x4 v1) { u32x4 w; w.x = cvt_pk_bf16(v0[0], v0[1]); w.y = cvt_pk_bf16(v0[2], v0[3]); w.z = cvt_pk_bf16(v1[0], v1[1]); w.w = cvt_pk_bf16(v1[2], v1[3]); return w; }
__device__ __forceinline__ float bf2f(unsigned short b) { return __uint_as_float((unsigned)b << 16); }
__device__ __forceinline__ float wave_sum(float v, int lane) {
#pragma unroll
    for (int o = 1; o < 32; o <<= 1) v += __int_as_float(__builtin_amdgcn_ds_bpermute((lane ^ o) << 2, __float_as_int(v)));
    auto rr = __builtin_amdgcn_permlane32_swap(__float_as_uint(v), __float_as_uint(v), false, false);
    return __uint_as_float(rr[0]) + __uint_as_float(rr[1]);
}

namespace pg8 {
constexpr int BM = 256, BK = 64, HALF = 128, HTB = HALF * BK * 2, STAGE_BYTES = 8 * HTB, NXCD = 8, WGM = 8;
__host__ __device__ __forceinline__ int lds_byte(int r, int c) { const int st = (r >> 4) * 2 + (c >> 5), rr = r & 15, cc = c & 31, ob = rr * 64 + cc * 2; return st * 1024 + (ob ^ (((ob >> 9) & 1) << 5)); }
__host__ __device__ __forceinline__ void stage_rc(int b, int& R, int& C) { const int st = b / 1024, sb = b % 1024, swz = sb ^ (((sb >> 9) & 1) << 5); R = (st >> 1) * 16 + swz / 64; C = (st & 1) * 32 + (swz % 64) / 2; }
__host__ __device__ __forceinline__ int perm32(int rho) { const int n = rho >> 4, i = rho & 15; return 8 * (i >> 2) + 4 * n + (i & 3); }

struct Unit { int pm, pn; };
struct Gemm { const bf16_t* A; const bf16_t* Bt; int M, N, K, lda; };

struct StaticOrder {
    int nM, nN, nwg, G, c;
    __device__ void init(int M, int N, int G_, int c_) { nM = M / BM; nN = N / BM; nwg = nM * nN; G = G_; c = c_; }
    __device__ bool next(int i, Unit& u) const {
        const long L = (long)i * G + c; if (L >= nwg) return false;
        int wgid = (int)L; { const int q = nwg / NXCD, r = nwg % NXCD, xcd = wgid % NXCD, off = wgid / NXCD; wgid = (xcd < r ? xcd * (q + 1) : r * (q + 1) + (xcd - r) * q) + off; }
        const int nig = WGM * nN, gid = wgid / nig, fm = gid * WGM, gsz = (nM - fm) < WGM ? (nM - fm) : WGM;
        u.pm = fm + ((wgid % nig) % gsz); u.pn = (wgid % nig) / gsz; return true;
    }
};

struct EpiStore {
    static constexpr bool PERM = true;
    bf16_t* O; int ldc; const float* rscale; float cscale;
    __device__ __forceinline__ void operator()(const f32x4 (&acc)[2][2][4][2], const Unit& u, int wr, int wc, int fr, int fq) const {
        const int row0 = u.pm * BM + wr * 64 + fr, col0 = u.pn * BM + wc * 32 + 8 * fq;
#pragma unroll
        for (int ai = 0; ai < 2; ++ai)
#pragma unroll
            for (int m = 0; m < 4; ++m) {
                const int row = row0 + ai * HALF + m * 16;
                const float s = rscale ? rscale[row] * cscale : cscale;
                bf16_t* rowp = O + (size_t)row * ldc + col0;
#pragma unroll
                for (int bj = 0; bj < 2; ++bj) *(u32x4*)(rowp + bj * HALF) = pack8(acc[ai][bj][m][0] * s, acc[ai][bj][m][1] * s);
            }
    }
};
struct EpiQRope {
    static constexpr bool PERM = true;
    bf16_t* O; const float* rscale; float cscale; const float* cosT; const float* sinT;
    __device__ __forceinline__ void operator()(const f32x4 (&acc)[2][2][4][2], const Unit& u, int wr, int wc, int fr, int fq) const {
        const int row0 = u.pm * BM + wr * 64 + fr, col0 = u.pn * BM + wc * 32 + 8 * fq;
        int rj[2];
#pragma unroll
        for (int bj = 0; bj < 2; ++bj) { const int w = (col0 + bj * HALF) % 96; rj[bj] = (w >= 64) ? ((w - 64) >> 3) : -1; }
#pragma unroll
        for (int ai = 0; ai < 2; ++ai)
#pragma unroll
            for (int m = 0; m < 4; ++m) {
                const int row = row0 + ai * HALF + m * 16;
                const float s = rscale[row] * cscale;
                const int pos = row < TP ? (row & 8191) : (row & 2047);
                bf16_t* rowp = O + (size_t)row * NQ + col0;
#pragma unroll
                for (int bj = 0; bj < 2; ++bj) {
                    f32x4 v0 = acc[ai][bj][m][0] * s, v1 = acc[ai][bj][m][1] * s;
                    if (rj[bj] >= 0) {
                        const f32x4 cs = *(const f32x4*)(cosT + pos * 16 + 4 * rj[bj]), sn = *(const f32x4*)(sinT + pos * 16 + 4 * rj[bj]);
                        const f32x4 t1 = v0, t2 = v1; v0 = t1 * cs - t2 * sn; v1 = t1 * sn + t2 * cs;
                    }
                    *(u32x4*)(rowp + bj * HALF) = pack8(v0, v1);
                }
            }
    }
};
struct EpiQKV {
    static constexpr bool PERM = true;
    bf16_t* O; int log2S; float qscale;
    __device__ __forceinline__ void operator()(const f32x4 (&acc)[2][2][4][2], const Unit& u, int wr, int wc, int fr, int fq) const {
        const int colt = u.pn * BM, g = colt / 3072, which = (colt - g * 3072) >> 10, sh = 2 * g, log2L = log2S - sh, S = 1 << log2S;
        const float sc = (which == 0) ? qscale : 1.f;
        const int row0 = u.pm * BM + wr * 64 + fr, col0 = colt + wc * 32 + 8 * fq;
#pragma unroll
        for (int ai = 0; ai < 2; ++ai)
#pragma unroll
            for (int m = 0; m < 4; ++m) {
                const int rl = row0 + ai * HALF + m * 16, seq = rl >> log2S, s = rl & (S - 1);
                const int f = ((s & ((1 << sh) - 1)) << log2L) + (s >> sh), drow = (seq << log2S) + f;
                bf16_t* rowp = O + (size_t)drow * NQKV + col0;
#pragma unroll
                for (int bj = 0; bj < 2; ++bj) *(u32x4*)(rowp + bj * HALF) = pack8(acc[ai][bj][m][0] * sc, acc[ai][bj][m][1] * sc);
            }
    }
};
struct EpiRes {
    static constexpr bool PERM = true;
    float* X; float alpha;
    __device__ __forceinline__ void operator()(const f32x4 (&acc)[2][2][4][2], const Unit& u, int wr, int wc, int fr, int fq) const {
        const int row0 = u.pm * BM + wr * 64 + fr, col0 = u.pn * BM + wc * 32 + 8 * fq;
#pragma unroll
        for (int ai = 0; ai < 2; ++ai)
#pragma unroll
            for (int m = 0; m < 4; ++m) {
                float* rowp = X + (size_t)(row0 + ai * HALF + m * 16) * DM + col0;
#pragma unroll
                for (int bj = 0; bj < 2; ++bj) {
                    float* p = rowp + bj * HALF; const f32x4 a = *(const f32x4*)p, b = *(const f32x4*)(p + 4);
                    *(f32x4*)p = a * alpha + acc[ai][bj][m][0]; *(f32x4*)(p + 4) = b * alpha + acc[ai][bj][m][1];
                }
            }
    }
};

template <class Epi, class Sched, bool ALIGN_EPI = true, bool SP2 = true>
__device__ __forceinline__ void gemm_phase(LAS unsigned char* lds, const Gemm g, const Sched& S, const Epi& E) {
    int tid_ = threadIdx.x; asm volatile("" : "+v"(tid_));
    const int tid = tid_, wid = __builtin_amdgcn_readfirstlane(tid >> 6), lane = tid & 63, wr = wid >> 2, wc = wid & 3, fr = lane & 15, fq = lane >> 4;
    const int K = g.K, nt = K / BK, lda = g.lda;
    unsigned voffA[2], voffB[2];
#pragma unroll
    for (int i = 0; i < 2; ++i) { int R, C; stage_rc(tid * 16 + i * 8192, R, C); const int Rb = Epi::PERM ? ((R & ~31) + perm32(R & 31)) : R;
        voffA[i] = (unsigned)(R * lda + C) * 2u; voffB[i] = (unsigned)(Rb * K + C) * 2u; }
    const size_t kstep = (size_t)(BK * 2);
    const size_t hstepA = (size_t)HALF * lda * 2, hstepB = (size_t)HALF * K * 2;
    const size_t tstepA = 2 * hstepA, tstepB = 2 * hstepB;
    const unsigned ldsw = (unsigned)wid * 1024u;
    const int aoff = lds_byte(wr * 64 + fr, fq * 8), boff = lds_byte(wc * 32 + fr, fq * 8);
#define PG8_SA(b, h) (((b) * 2 + (h)) * HTB)
#define PG8_SB(b, h) ((4 + (b) * 2 + (h)) * HTB)
#define PG8_STAGE(bufoff, gbase, voff) do { _Pragma("unroll") for (int _i = 0; _i < 2; ++_i) \
        __builtin_amdgcn_global_load_lds((const unsigned*)((const char*)(gbase) + (voff)[_i]), (LAS unsigned*)(lds + (bufoff) + ldsw + _i * 8192), 16, 0, 0); } while (0)
#define PG8_LDA(dst, b, h) do { _Pragma("unroll") for (int m = 0; m < 4; ++m) _Pragma("unroll") for (int k = 0; k < 2; ++k) dst[m][k] = *(const LAS bf16x8*)(lds + PG8_SA(b, h) + aoff + m * 2048 + k * 1024); } while (0)
#define PG8_LDB(dst, b, h) do { _Pragma("unroll") for (int n = 0; n < 2; ++n) _Pragma("unroll") for (int k = 0; k < 2; ++k) dst[n][k] = *(const LAS bf16x8*)(lds + PG8_SB(b, h) + boff + n * 2048 + k * 1024); } while (0)
#define PG8_MMA(ai, bj, At, Bt) do { __builtin_amdgcn_s_setprio(1); _Pragma("unroll") for (int m = 0; m < 4; ++m) _Pragma("unroll") for (int n = 0; n < 2; ++n) _Pragma("unroll") for (int k = 0; k < 2; ++k) \
        acc[ai][bj][m][n] = __builtin_amdgcn_mfma_f32_16x16x32_bf16(Bt[n][k], At[m][k], acc[ai][bj][m][n], 0, 0, 0); __builtin_amdgcn_s_setprio(0); } while (0)
#define PG8_WAIT_V(n) asm volatile("s_waitcnt vmcnt(" #n ")" ::: "memory")
#define PG8_WAIT_L(n) asm volatile("s_waitcnt lgkmcnt(" #n ")" ::: "memory")
#define PG8_BAR __builtin_amdgcn_s_barrier()
#define PG8_SCHED __builtin_amdgcn_sched_barrier(0)
    Unit cur, nxt; int ui = 0;
    if (!S.next(0, cur)) return;
    f32x4 acc[2][2][4][2];
#pragma unroll
    for (int a = 0; a < 2; ++a)
#pragma unroll
        for (int b = 0; b < 2; ++b)
#pragma unroll
            for (int m = 0; m < 4; ++m)
#pragma unroll
                for (int n = 0; n < 2; ++n) acc[a][b][m][n] = (f32x4){0.f, 0.f, 0.f, 0.f};
    bf16x8 At[4][2], B0[2][2], B1[2][2];
    const char* cA = (const char*)g.A + (size_t)cur.pm * tstepA; const char* cB = (const char*)g.Bt + (size_t)cur.pn * tstepB;
    if constexpr (SP2) {
        PG8_STAGE(PG8_SB(0, 0), cB, voffB); PG8_STAGE(PG8_SB(0, 1), cB + hstepB, voffB); PG8_STAGE(PG8_SA(0, 0), cA, voffA); PG8_STAGE(PG8_SA(0, 1), cA + hstepA, voffA);
        if (wr == 1) PG8_BAR;
        PG8_WAIT_V(2); PG8_BAR;
        PG8_STAGE(PG8_SB(1, 0), cB + kstep, voffB); PG8_STAGE(PG8_SA(1, 0), cA + kstep, voffA); PG8_STAGE(PG8_SB(1, 1), cB + hstepB + kstep, voffB);
        PG8_WAIT_V(6); PG8_BAR;
    }
    for (;;) {
        const bool has_next = S.next(ui + 1, nxt);
        const char* nA = has_next ? (const char*)g.A + (size_t)nxt.pm * tstepA : cA; const char* nB = has_next ? (const char*)g.Bt + (size_t)nxt.pn * tstepB : cB;
        for (int t = 0; t < nt; t += 2) {
            const bool last = (t == nt - 2);
            const char* a1 = cA + (size_t)(t + 1) * kstep;
            const char* a2 = last ? nA : cA + (size_t)(t + 2) * kstep; const char* b2 = last ? nB : cB + (size_t)(t + 2) * kstep;
            const char* a3 = a2 + kstep; const char* b3 = b2 + kstep;
            PG8_LDB(B0, 0, 0); PG8_LDB(B1, 0, 1); PG8_SCHED; PG8_LDA(At, 0, 0); PG8_STAGE(PG8_SA(1, 1), a1 + hstepA, voffA);
            PG8_WAIT_V(8); PG8_WAIT_L(0); PG8_BAR; PG8_MMA(0, 0, At, B0); PG8_MMA(0, 1, At, B1); PG8_BAR; PG8_SCHED;
            PG8_LDA(At, 0, 1); PG8_STAGE(PG8_SB(0, 0), b2, voffB); PG8_STAGE(PG8_SB(0, 1), b2 + hstepB, voffB); PG8_STAGE(PG8_SA(0, 0), a2, voffA);
            PG8_WAIT_V(8); PG8_WAIT_L(0); PG8_BAR; PG8_MMA(1, 0, At, B0); PG8_MMA(1, 1, At, B1); PG8_BAR; PG8_SCHED;
            PG8_LDB(B0, 1, 0); PG8_LDB(B1, 1, 1); PG8_SCHED; PG8_LDA(At, 1, 0); PG8_STAGE(PG8_SA(0, 1), a2 + hstepA, voffA);
            PG8_WAIT_V(8); PG8_WAIT_L(0); PG8_BAR; PG8_MMA(0, 0, At, B0); PG8_MMA(0, 1, At, B1); PG8_BAR; PG8_SCHED;
            PG8_LDA(At, 1, 1); PG8_STAGE(PG8_SB(1, 0), b3, voffB); PG8_STAGE(PG8_SB(1, 1), b3 + hstepB, voffB); PG8_STAGE(PG8_SA(1, 0), a3, voffA);
            PG8_WAIT_V(8); PG8_WAIT_L(0); PG8_BAR; PG8_MMA(1, 0, At, B0); PG8_MMA(1, 1, At, B1); PG8_BAR; PG8_SCHED;
        }
        if constexpr (ALIGN_EPI) { if (wr == 0) PG8_BAR; }
        { int l2 = threadIdx.x; asm volatile("" : "+v"(l2)); l2 &= 63; E(acc, cur, wr, wc, l2 & 15, l2 >> 4); }
        if (!has_next) break;
#pragma unroll
        for (int a = 0; a < 2; ++a)
#pragma unroll
            for (int b = 0; b < 2; ++b)
#pragma unroll
                for (int m = 0; m < 4; ++m)
#pragma unroll
                    for (int n = 0; n < 2; ++n) acc[a][b][m][n] = (f32x4){0.f, 0.f, 0.f, 0.f};
        cur = nxt; cA = nA; cB = nB; ++ui;
        if constexpr (ALIGN_EPI) { if (wr == 1) PG8_BAR; }
    }
    PG8_WAIT_V(0);
    if constexpr (!ALIGN_EPI) { if (wr == 0) PG8_BAR; }
    PG8_BAR;
#undef PG8_SA
#undef PG8_SB
#undef PG8_STAGE
#undef PG8_LDA
#undef PG8_LDB
#undef PG8_MMA
#undef PG8_WAIT_V
#undef PG8_WAIT_L
#undef PG8_BAR
#undef PG8_SCHED
}
}

struct Params {
    const float *x_prompt, *x_sample, *rel_bias, *w_qkv_a, *w_o_a, *w_dkv_b, *g_q_b, *g_kv_b, *w_uq_b, *w_ukv_b, *w_o_b, *ffn_w_in, *ffn_conv_w, *ffn_conv_b, *ffn_w_out, *ln_g, *ln_b;
    float* out; unsigned char* ws;
    int ph_lo, ph_hi;
};

__device__ __forceinline__ int rope_perm32(int i) { const int t = i >> 4, ii = i & 15; return 8 * (ii >> 2) + 4 * t + (ii & 3); }
__device__ __forceinline__ int rowmap(int mode, int n) {
    if (mode == 1) { const int h = n / 96, w = n - h * 96; return w < 64 ? n : h * 96 + 64 + rope_perm32(w - 64); }
    if (mode == 2) { return n < 640 ? n : 640 + rope_perm32(n - 640); }
    return n;
}
__device__ __forceinline__ void transpose_item(const float* W, int K, int N, bf16_t* WT, int mode, const float* kscale, LAS float* scr, int item, int lane) {
    const int nblk = N / 32, kb = item / nblk, nb = item % nblk, k0 = 64 * kb, n0 = 32 * nb;
    const int kr = lane >> 3, c4 = (lane & 7) * 4;
#pragma unroll
    for (int i = 0; i < 8; ++i) { const int kk = kr + 8 * i; f32x4 v = *(const f32x4*)(W + (size_t)(k0 + kk) * N + n0 + c4); if (kscale) v = v * kscale[k0 + kk];
        scr[kk * 33 + c4] = v.x; scr[kk * 33 + c4 + 1] = v.y; scr[kk * 33 + c4 + 2] = v.z; scr[kk * 33 + c4 + 3] = v.w; }
    asm volatile("s_waitcnt lgkmcnt(0)" ::: "memory");
    const int c = lane & 7;
#pragma unroll
    for (int j = 0; j < 4; ++j) { const int n = (lane >> 3) + 8 * j; const LAS float* s = scr + (8 * c) * 33 + n;
        u32x4 o; o.x = cvt_pk_bf16(s[0 * 33], s[1 * 33]); o.y = cvt_pk_bf16(s[2 * 33], s[3 * 33]); o.z = cvt_pk_bf16(s[4 * 33], s[5 * 33]); o.w = cvt_pk_bf16(s[6 * 33], s[7 * 33]);
        *(u32x4*)(WT + (size_t)rowmap(mode, n0 + n) * K + k0 + 8 * c) = o; }
    asm volatile("s_waitcnt lgkmcnt(0)" ::: "memory");
}
__device__ __forceinline__ int t5_bucket(int rel) {
    const int n = rel < 0 ? -rel : rel; const int ret = rel > 0 ? 16 : 0;
    if (n < 8) return ret + n;
    int large = 8 + (int)(__log2f((float)n * 0.125f) * (8.0f / 7.0f));
    if (large > 15) large = 15;
    return ret + large;
}
__device__ __forceinline__ void rope_entry(int pos, int i, float& c, float& s) {
    const double x = -(double)i * (13.287712379549449 / 16.0);
    const double fl = __builtin_floor(x), fr = (x - fl) * 0.6931471805599453;
    double e = 1.0, term = 1.0;
#pragma unroll 1
    for (int k = 1; k < 22; ++k) { term *= fr / (double)k; e += term; }
    const long long bits = (long long)(1023 + (int)fl) << 52;
    const double inv = e * __builtin_bit_cast(double, bits);
    const double ang = (double)pos * inv;
    const double kq = __builtin_rint(ang * 0.6366197723675814);
    double r = __builtin_fma(-kq, 1.5707963267948966, ang); r = __builtin_fma(-kq, 6.123233995736766e-17, r);
    const double r2 = r * r;
    double sp = r * (1.0 + r2 * (-1.0 / 6 + r2 * (1.0 / 120 + r2 * (-1.0 / 5040 + r2 * (1.0 / 362880 + r2 * (-1.0 / 39916800 + r2 * (1.0 / 6227020800.0)))))));
    double cp = 1.0 + r2 * (-0.5 + r2 * (1.0 / 24 + r2 * (-1.0 / 720 + r2 * (1.0 / 40320 + r2 * (-1.0 / 3628800 + r2 * (1.0 / 479001600.0))))));
    const int q = (int)((long long)kq & 3);
    double sv = (q == 0) ? sp : (q == 1) ? cp : (q == 2) ? -sp : -cp;
    double cv = (q == 0) ? cp : (q == 1) ? -sp : (q == 2) ? -cp : sp;
    c = (float)cv; s = (float)sv;
}

__device__ __forceinline__ float gelu_erf(float v) {
    const float av = __builtin_fabsf(v), d = av * 0.2316418882f + 1.0f, t = __builtin_amdgcn_rcpf(d);
    float q = t * 0.5307027145f + (-0.7265760135f); q = q * t + 0.7107068705f; q = q * t + (-0.142248368f); q = q * t + 0.127414796f; q = q * t;
    const float e = __builtin_amdgcn_exp2f((v * v) * (-0.72134752044f));
    const float m = v * (q * e), r = v - m;
    return v < 0.f ? m : r;
}

__device__ __forceinline__ void ln_phase(const float* x0, const float* x1, const bf16_t* Y, float* Xo, bf16_t* XBo, const float* g, const float* b, int gw, int NGW, int lane, bool wb = true) {
    f32x4 gg[4], bb[4];
#pragma unroll
    for (int j = 0; j < 4; ++j) { gg[j] = *((const f32x4*)g + lane + 64 * j); bb[j] = *((const f32x4*)b + lane + 64 * j); }
    f32x4 cx[4]; u32x2 cy[4];
#define LN_LOAD(r, vx, vy) do { const float* src_ = (r) < TP ? x0 + (size_t)(r) * DM : x1 + (size_t)((r) - TP) * DM; \
        _Pragma("unroll") for (int j = 0; j < 4; ++j) { vx[j] = *((const f32x4*)src_ + lane + 64 * j); vy[j] = *((const u32x2*)(Y + (size_t)(r) * DM) + lane + 64 * j); } } while (0)
    f32x4 nx[4] = {}; u32x2 ny[4] = {};
    if (gw < T) LN_LOAD(gw, cx, cy);
    if (gw + NGW < T) LN_LOAD(gw + NGW, nx, ny);
    for (int r = gw; r < T; r += NGW) {
        f32x4 mx[4] = {}; u32x2 my[4] = {};
        const int rn = r + 2 * NGW;
        if (rn < T) LN_LOAD(rn, mx, my);
        f32x4 v[4]; float s = 0.f;
#pragma unroll
        for (int j = 0; j < 4; ++j) {
            const f32x4 yf = {__uint_as_float(cy[j].x << 16), __uint_as_float(cy[j].x & 0xffff0000u), __uint_as_float(cy[j].y << 16), __uint_as_float(cy[j].y & 0xffff0000u)};
            v[j] = cx[j] * ALPHA + yf; s += (v[j].x + v[j].y) + (v[j].z + v[j].w);
        }
        const float mean = wave_sum(s, lane) * (1.f / DM); float s2 = 0.f;
#pragma unroll
        for (int j = 0; j < 4; ++j) { v[j] = v[j] - mean; s2 += (v[j].x * v[j].x + v[j].y * v[j].y) + (v[j].z * v[j].z + v[j].w * v[j].w); }
        const float rstd = 1.f / sqrtf(wave_sum(s2, lane) * (1.f / DM) + LN_EPS);
#pragma unroll
        for (int j = 0; j < 4; ++j) {
            const f32x4 o = v[j] * rstd * gg[j] + bb[j];
            *((f32x4*)(Xo + (size_t)r * DM) + lane + 64 * j) = o;
            if (wb) { u32x2 w; w.x = cvt_pk_bf16(o.x, o.y); w.y = cvt_pk_bf16(o.z, o.w); *((u32x2*)(XBo + (size_t)r * DM) + lane + 64 * j) = w; }
        }
#pragma unroll
        for (int j = 0; j < 4; ++j) { cx[j] = nx[j]; cy[j] = ny[j]; nx[j] = mx[j]; ny[j] = my[j]; }
    }
#undef LN_LOAD
}

__device__ __forceinline__ s16x4 tr_read(unsigned addr) { s16x4 r; asm volatile("ds_read_b64_tr_b16 %0, %1" : "=&v"(r) : "v"(addr) : "memory"); return r; }
#define MFMA32(a, b, c) __builtin_amdgcn_mfma_f32_32x32x16_bf16(a, b, c, 0, 0, 0)
__device__ __forceinline__ float xhalf_max(float v) { auto rr = __builtin_amdgcn_permlane32_swap(__float_as_uint(v), __float_as_uint(v), false, false); return fmaxf(__uint_as_float(rr[0]), __uint_as_float(rr[1])); }
__device__ __forceinline__ float xhalf_sum(float v) { auto rr = __builtin_amdgcn_permlane32_swap(__float_as_uint(v), __float_as_uint(v), false, false); return __uint_as_float(rr[0]) + __uint_as_float(rr[1]); }
__device__ __forceinline__ float max3(float a, float b, float c) { float r; asm("v_max3_f32 %0, %1, %2, %3" : "=v"(r) : "v"(a), "v"(b), "v"(c)); return r; }
__device__ __forceinline__ bf16x8 pack_p(const f32x16& p, int j2) {
    u32x4 w; w.x = cvt_pk_bf16(p[8 * j2 + 0], p[8 * j2 + 1]); w.y = cvt_pk_bf16(p[8 * j2 + 2], p[8 * j2 + 3]); w.z = cvt_pk_bf16(p[8 * j2 + 4], p[8 * j2 + 5]); w.w = cvt_pk_bf16(p[8 * j2 + 6], p[8 * j2 + 7]);
    return __builtin_bit_cast(bf16x8, w);
}
__device__ __forceinline__ void pv_tile(f32x16& o, unsigned vaddr, const bf16x8 (&pb)[4]) {
    s16x4 lo[4], hi[4];
#pragma unroll
    for (int k = 0; k < 4; ++k) { lo[k] = tr_read(vaddr + (16 * k) * 64); hi[k] = tr_read(vaddr + (16 * k + 8) * 64); }
    asm volatile("s_waitcnt lgkmcnt(0)" ::: "memory"); __builtin_amdgcn_sched_barrier(0);
#pragma unroll
    for (int k = 0; k < 4; ++k) { const bf16x8 a = (bf16x8){lo[k][0], lo[k][1], lo[k][2], lo[k][3], hi[k][0], hi[k][1], hi[k][2], hi[k][3]}; o = MFMA32(a, pb[k], o); }
}

__device__ __forceinline__ void pv_issue(unsigned vaddr, s16x4 (&lo)[4], s16x4 (&hi)[4]) {
#pragma unroll
    for (int k = 0; k < 4; ++k) { lo[k] = tr_read(vaddr + (16 * k) * 64); hi[k] = tr_read(vaddr + (16 * k + 8) * 64); }
}
__device__ __forceinline__ void pv_mma(f32x16& o, const s16x4 (&lo)[4], const s16x4 (&hi)[4], const bf16x8 (&pb)[4]) {
#pragma unroll
    for (int k = 0; k < 4; ++k) { const bf16x8 a = (bf16x8){lo[k][0], lo[k][1], lo[k][2], lo[k][3], hi[k][0], hi[k][1], hi[k][2], hi[k][3]}; o = MFMA32(a, pb[k], o); }
}
#define MLA_COMPUTE(cur) { \
            const LAS unsigned char* Kb = lds + cur * KBUF; \
            f32x16 s0 = {}, s1 = {}; \
            _Pragma("unroll") \
            for (int ks = 0; ks < 6; ++ks) { \
                const bf16x8 a0 = *(const LAS bf16x8*)(Kb + r32 * 208 + ks * 32 + hi * 16), a1 = *(const LAS bf16x8*)(Kb + (32 + r32) * 208 + ks * 32 + hi * 16); \
                s0 = MFMA32(a0, qf[ks], s0); s1 = MFMA32(a1, qf[ks], s1); \
            } \
            const unsigned va = trb + cur * VBUF; \
            s16x4 vl0[4], vh0[4]; \
            pv_issue(va, vl0, vh0);    \
            float pa = max3(s0[0], s0[1], s0[2]), pc = max3(s1[0], s1[1], s1[2]); \
            _Pragma("unroll") \
            for (int r = 3; r < 15; r += 2) { pa = max3(pa, s0[r], s0[r + 1]); pc = max3(pc, s1[r], s1[r + 1]); } \
            float pmax = max3(pa, pc, fmaxf(s0[15], s1[15])); \
            pmax = xhalf_max(pmax); \
              \
            if (__any(pmax - m > (slow ? 8.f : 64.f)) || (j == 0 && __any(pmax < -32.f))) { \
                const float mn = (j == 0) ? pmax : fmaxf(m, pmax), alpha = (j == 0) ? 1.f : __builtin_amdgcn_exp2f(m - mn); \
                m = mn; l *= alpha; slow = true; \
            _Pragma("unroll") \
                for (int r = 0; r < 16; ++r) { o0[r] *= alpha; o1[r] *= alpha; } \
            } \
            if (slow) { \
            _Pragma("unroll") \
                for (int r = 0; r < 16; ++r) { s0[r] -= m; s1[r] -= m; } \
            } \
            f32x2 ps2 = {0.f, 0.f}; \
            _Pragma("unroll") \
            for (int r = 0; r < 16; ++r) { s0[r] = __builtin_amdgcn_exp2f(s0[r]); s1[r] = __builtin_amdgcn_exp2f(s1[r]); } \
            _Pragma("unroll") \
            for (int r = 0; r < 16; r += 2) { ps2 += (f32x2){s0[r], s0[r + 1]}; ps2 += (f32x2){s1[r], s1[r + 1]}; } \
            l += ps2.x + ps2.y; \
            bf16x8 pb[4]; \
            pb[0] = pack_p(s0, 0); pb[1] = pack_p(s0, 1); pb[2] = pack_p(s1, 0); pb[3] = pack_p(s1, 1); \
            asm volatile("s_waitcnt lgkmcnt(0)" ::: "memory"); __builtin_amdgcn_sched_barrier(0); \
            pv_mma(o0, vl0, vh0, pb); pv_tile(o1, va + 4096, pb); \
            }
__device__ __forceinline__ void attn_mla_phase(LAS unsigned char* lds, const bf16_t* QB, const bf16_t* KV, const bf16_t* KRR, bf16_t* O, int G, int bx) {
    constexpr int KBUF = 64 * 208, VBUF = 8192, VOFF = 2 * KBUF;
    int tid_ = threadIdx.x; asm volatile("" : "+v"(tid_));
    const int tid = tid_, wid = __builtin_amdgcn_readfirstlane(tid >> 6), lane = tid & 63, r32 = lane & 31, hi = lane >> 5;
    const bool xs = (G % 8) == 0;
    const int nslots = xs ? G / 8 : G, slot = xs ? bx / 8 : bx, xcd = xs ? bx % 8 : 0, npx = xs ? 16 : 128;
    const int nent = npx * 40;
    const int skey = tid >> 3, sch = tid & 7, rkey = tid >> 2, rch = tid & 3;
    const int kdst = skey * 208 + sch * 16, rdst = rkey * 208 + 128 + rch * 16, vdst = (sch >> 2) * 4096 + skey * 64 + (sch & 3) * 16;
    const unsigned trb = (unsigned)(size_t)(lds + VOFF) + (unsigned)((4 * hi + ((lane & 15) >> 2)) * 64 + 32 * ((lane >> 4) & 1) + 8 * (lane & 3));
#define MLA_DEC(LI, P) int P##pair, P##qb, P##base, P##S; \
        if ((LI) < npx * 32) { P##pair = xs ? ((LI) >> 5) * 8 + xcd : ((LI) >> 5); P##qb = (LI) & 31; P##base = (P##pair >> 4) * 8192; P##S = 8192; } \
        else { const int l2_ = (LI) - npx * 32; P##pair = xs ? (l2_ >> 3) * 8 + xcd : (l2_ >> 3); P##qb = l2_ & 7; P##base = TP + (P##pair >> 4) * 2048; P##S = 2048; } \
        const int P##h = P##pair & 15; \
        const size_t P##qrow = (size_t)P##base + P##qb * 256 + wid * 32 + r32; \
        const bf16_t* P##qsrc = QB + P##qrow * NQ + P##h * 96 + hi * 8; \
        const bf16_t* P##kn = KV + (size_t)(P##base + skey) * NKV + P##h * 128 + sch * 8; \
        const bf16_t* P##kr = KRR + (size_t)(P##base + rkey) * 32 + rch * 8
    int li = slot;
    if (li >= nent) return;
    bf16x8 qf[6]; bf16x8 ska, sva, sra = {}, skb, svb, srb = {};
    {
        MLA_DEC(li, f_);
#pragma unroll
        for (int ks = 0; ks < 6; ++ks) qf[ks] = *(const bf16x8*)(f_qsrc + ks * 16);
        ska = *(const bf16x8*)f_kn; sva = *(const bf16x8*)(f_kn + 64); if (tid < 256) sra = *(const bf16x8*)f_kr;
        *(LAS bf16x8*)(lds + kdst) = ska; *(LAS bf16x8*)(lds + VOFF + vdst) = sva; if (tid < 256) *(LAS bf16x8*)(lds + rdst) = sra;
        ska = *(const bf16x8*)(f_kn + (size_t)64 * NKV); sva = *(const bf16x8*)(f_kn + (size_t)64 * NKV + 64); if (tid < 256) sra = *(const bf16x8*)(f_kr + 64 * 32);
    }
    __syncthreads();
    for (;;) {
        MLA_DEC(li, c_);
        const int lin = li + nslots; const bool hasn = lin < nent;
        MLA_DEC(hasn ? lin : li, n_);
        const int h = c_h; const size_t qrow = c_qrow;
        f32x16 o0 = {}, o1 = {}; float m = 0.f, l = 0.f; bool slow = false;
        const int NT = c_S / 64;
        const bf16_t* kn_src = c_kn; const bf16_t* kr_src = c_kr;
#define MLA_STEP(cur, SKL, SVL, SRL, SKW, SVW, SRW) { \
            { const bool own_ = j + 2 < NT; const size_t off = (size_t)(own_ ? j + 2 : j + 2 - NT) * 64; const bf16_t* kn_ = own_ ? kn_src : n_kn; const bf16_t* kr_ = own_ ? kr_src : n_kr; \
              SKL = *(const bf16x8*)(kn_ + off * NKV); SVL = *(const bf16x8*)(kn_ + off * NKV + 64); if (tid < 256) SRL = *(const bf16x8*)(kr_ + off * 32); } \
            MLA_COMPUTE(cur) \
            *(LAS bf16x8*)(lds + ((cur) ^ 1) * KBUF + kdst) = SKW; *(LAS bf16x8*)(lds + VOFF + ((cur) ^ 1) * VBUF + vdst) = SVW; if (tid < 256) *(LAS bf16x8*)(lds + ((cur) ^ 1) * KBUF + rdst) = SRW; \
            __syncthreads(); ++j; }
        for (int j = 0; j < NT;) {
            MLA_STEP(0, skb, svb, srb, ska, sva, sra)
            MLA_STEP(1, ska, sva, sra, skb, svb, srb)
        }
#undef MLA_STEP
        if (hasn) {
#pragma unroll
            for (int ks = 0; ks < 6; ++ks) qf[ks] = *(const bf16x8*)(n_qsrc + ks * 16);
        }
        l = xhalf_sum(l);
        const float inv = 1.f / l;
        bf16_t* orow = O + qrow * DM + h * 64 + 4 * hi;
#pragma unroll
        for (int g4 = 0; g4 < 4; ++g4) {
            u32x2 w0, w1;
            w0.x = cvt_pk_bf16(o0[4 * g4] * inv, o0[4 * g4 + 1] * inv); w0.y = cvt_pk_bf16(o0[4 * g4 + 2] * inv, o0[4 * g4 + 3] * inv);
            w1.x = cvt_pk_bf16(o1[4 * g4] * inv, o1[4 * g4 + 1] * inv); w1.y = cvt_pk_bf16(o1[4 * g4 + 2] * inv, o1[4 * g4 + 3] * inv);
            *(u32x2*)(orow + 8 * g4) = w0; *(u32x2*)(orow + 32 + 8 * g4) = w1;
        }
        if (!hasn) break;
        li = lin;
    }
#undef MLA_DEC
}

#undef MLA_COMPUTE
__device__ __forceinline__ void attn_dil_phase(LAS unsigned char* lds, const bf16_t* QKV, const float* BT, bf16_t* OG, float* LSE, int nseq, int log2S, int G, int bx) {
    constexpr int KBUF = 64 * 272, VBUF = 16384, VOFF = 2 * KBUF, TOFF = VOFF + 2 * VBUF;
    int tid_ = threadIdx.x; asm volatile("" : "+v"(tid_));
    const int tid = tid_, wid = __builtin_amdgcn_readfirstlane(tid >> 6), lane = tid & 63, r32 = lane & 31, hi = lane >> 5;
    const int S = 1 << log2S, nqb = S >> 8, nunits = nseq * 24 * nqb;
    const int key0 = tid >> 4, ch0 = tid & 15;
    const int kdst = key0 * 272 + ch0 * 16, vdst = (ch0 >> 2) * 4096 + key0 * 64 + (ch0 & 3) * 16;
    const unsigned trb = (unsigned)(size_t)(lds + VOFF) + (unsigned)((4 * hi + ((lane & 15) >> 2)) * 64 + 32 * ((lane >> 4) & 1) + 8 * (lane & 3));
    LAS float* tab = (LAS float*)(lds + TOFF);
#define DIL_DEC(uu, P) const int P##qb = (uu) % nqb; int P##rest = (uu) / nqb; const int P##h = P##rest & 7; P##rest >>= 3; const int P##g = P##rest % 3, P##seq = P##rest / 3; \
        const int P##f0 = P##qb * 256, P##rowbase = P##seq << log2S, P##tlo = (P##f0 == 0) ? 1 : 0; \
        const bf16_t* P##qsrc = QKV + ((size_t)P##rowbase + P##f0 + wid * 32 + r32) * NQKV + P##g * 3072 + P##h * 128 + hi * 8; \
        const bf16_t* P##ksrc = QKV + (long)(P##rowbase + P##f0 - 64 + key0) * NQKV + P##g * 3072 + 1024 + P##h * 128 + ch0 * 8; \
        const float* P##tsrc = BT + (P##g * 8 + P##h) * 384 + (tid < 384 ? tid : 0)
#define DIL_TILE(src, t) do { const bf16_t* p_ = (src) + (size_t)((t) * 64) * NQKV; k0r = *(const bf16x8*)p_; v0r = *(const bf16x8*)(p_ + 1024); k1r = *(const bf16x8*)(p_ + (size_t)32 * NQKV); v1r = *(const bf16x8*)(p_ + (size_t)32 * NQKV + 1024); } while (0)
    bf16x8 qn[8] = {}, k0r = {}, k1r = {}, v0r = {}, v1r = {}; float tabv = 0.f;
    if (bx < nunits) {
        DIL_DEC(bx, a_);
#pragma unroll
        for (int ks = 0; ks < 8; ++ks) qn[ks] = *(const bf16x8*)(a_qsrc + ks * 16);
        DIL_TILE(a_ksrc, a_tlo); tabv = *a_tsrc;
    }
    for (int u = bx; u < nunits; u += G) {
        DIL_DEC(u, c_);
        const int h = c_h, g = c_g, f0 = c_f0, rowbase = c_rowbase, tlo = c_tlo;
        const int sh = 2 * g, log2L = log2S - sh;
        bf16x8 qf[8];
#pragma unroll
        for (int ks = 0; ks < 8; ++ks) qf[ks] = qn[ks];
        if (tid < 384) tab[tid] = tabv;
        f32x16 o[4] = {}; float m = -1e30f, l = 0.f;
        const int thi = (f0 + 256 >= S) ? 4 : 5;
        const int wt0 = wid >> 1, myblk = (f0 + 32 * wid) >> log2L;
        const bf16_t* ksrc = c_ksrc;
        const int tbase = 128 - 32 * wid - r32 + 4 * hi;
        *(LAS bf16x8*)(lds + kdst) = k0r; *(LAS bf16x8*)(lds + kdst + 32 * 272) = k1r; *(LAS bf16x8*)(lds + VOFF + vdst) = v0r; *(LAS bf16x8*)(lds + VOFF + vdst + 32 * 64) = v1r;
        const int un = u + G; const bool hasn = un < nunits;
        DIL_DEC(hasn ? un : u, n_);
        if (hasn) {
#pragma unroll
            for (int ks = 0; ks < 8; ++ks) qn[ks] = *(const bf16x8*)(n_qsrc + ks * 16);
            tabv = *n_tsrc;
        }
        __syncthreads();
        for (int t = tlo; t <= thi; ++t) {
            const int cur = (t - tlo) & 1;
            if (t < thi) DIL_TILE(ksrc, t + 1); else if (hasn) DIL_TILE(n_ksrc, n_tlo);
            const int fk0 = f0 - 64 + 64 * t;
            if (t >= wt0 && t <= wt0 + 2 && (fk0 >> log2L) == myblk) {
                const LAS unsigned char* Kb = lds + cur * KBUF;
                f32x16 s0 = {}, s1 = {};
#pragma unroll
                for (int ks = 0; ks < 8; ++ks) {
                    const bf16x8 a0 = *(const LAS bf16x8*)(Kb + r32 * 272 + ks * 32 + hi * 16), a1 = *(const LAS bf16x8*)(Kb + (32 + r32) * 272 + ks * 32 + hi * 16);
                    s0 = MFMA32(a0, qf[ks], s0); s1 = MFMA32(a1, qf[ks], s1);
                }
                const LAS float* tb = tab + tbase + 64 * t;
#pragma unroll
                for (int r = 0; r < 16; ++r) { s0[r] += tb[(r & 3) + 8 * (r >> 2)]; s1[r] += tb[32 + (r & 3) + 8 * (r >> 2)]; }
                float pmax = s0[0];
#pragma unroll
                for (int r = 1; r < 16; ++r) pmax = fmaxf(pmax, s0[r]);
#pragma unroll
                for (int r = 0; r < 16; ++r) pmax = fmaxf(pmax, s1[r]);
                pmax = xhalf_max(pmax);
                if (__any(pmax > m + 8.f)) {
                    const float mn = fmaxf(m, pmax), alpha = __builtin_amdgcn_exp2f(m - mn);
                    m = mn; l *= alpha;
#pragma unroll
                    for (int d = 0; d < 4; ++d)
#pragma unroll
                        for (int r = 0; r < 16; ++r) o[d][r] *= alpha;
                }
                float ps = 0.f;
#pragma unroll
                for (int r = 0; r < 16; ++r) { s0[r] = __builtin_amdgcn_exp2f(s0[r] - m); s1[r] = __builtin_amdgcn_exp2f(s1[r] - m); ps += s0[r] + s1[r]; }
                l += ps;
                bf16x8 pb[4];
                pb[0] = pack_p(s0, 0); pb[1] = pack_p(s0, 1); pb[2] = pack_p(s1, 0); pb[3] = pack_p(s1, 1);
                const unsigned va = trb + cur * VBUF;
                pv_tile(o[0], va, pb); pv_tile(o[1], va + 4096, pb); pv_tile(o[2], va + 8192, pb); pv_tile(o[3], va + 12288, pb);
            }
            if (t < thi) {
                const int nb = cur ^ 1;
                *(LAS bf16x8*)(lds + nb * KBUF + kdst) = k0r; *(LAS bf16x8*)(lds + nb * KBUF + kdst + 32 * 272) = k1r;
                *(LAS bf16x8*)(lds + VOFF + nb * VBUF + vdst) = v0r; *(LAS bf16x8*)(lds + VOFF + nb * VBUF + vdst + 32 * 64) = v1r;
            }
            __syncthreads();
        }
        l = xhalf_sum(l);
        const float inv = 1.f / l;
        const int f = f0 + wid * 32 + r32, stok = ((f & ((1 << log2L) - 1)) << sh) + (f >> log2L);
        const size_t orow = (size_t)rowbase + stok;
        bf16_t* op = OG + ((size_t)g * CHUNK + orow) * DM + h * 128 + 4 * hi;
#pragma unroll
        for (int d = 0; d < 4; ++d)
#pragma unroll
            for (int g4 = 0; g4 < 4; ++g4) {
                u32x2 w; w.x = cvt_pk_bf16(o[d][4 * g4] * inv, o[d][4 * g4 + 1] * inv); w.y = cvt_pk_bf16(o[d][4 * g4 + 2] * inv, o[d][4 * g4 + 3] * inv);
                *(u32x2*)(op + 32 * d + 8 * g4) = w;
            }
        if (hi == 0) LSE[((size_t)g * CHUNK + orow) * 8 + h] = m + __log2f(l);
    }
}
#undef DIL_DEC
#undef DIL_TILE

#define XB_TMO      128
#define XB_XCNT(j)  (256  + 64 * (j))
#define XB_XSUB(j)  (1280 + 64 * (j))
#define XB_XGEN(j)  (2304 + 64 * (j))
#define XB_TOP      3328
#define XB_TOPGEN   3392
#define XCD_BAR_WORDS 3456
#define XB_SPIN_CAP (1u << 18)

__device__ __forceinline__ unsigned xb_ld(unsigned* p)              { return __hip_atomic_load(p, __ATOMIC_RELAXED, __HIP_MEMORY_SCOPE_AGENT); }
__device__ __forceinline__ unsigned xb_add(unsigned* p, unsigned v) { return __hip_atomic_fetch_add(p, v, __ATOMIC_RELAXED, __HIP_MEMORY_SCOPE_AGENT); }
__device__ __forceinline__ unsigned xb_xcc_id() { return (unsigned)__builtin_amdgcn_s_getreg((3 << 11) | 20) & 0xFu; }
#define XB_SPIN(cond, bar) do { unsigned _sp = 0; while (cond) { __builtin_amdgcn_s_sleep(1); \
    if ((++_sp & 255u) == 0u) { if (xb_ld(&(bar)[XB_TMO])) break; if (_sp > XB_SPIN_CAP) { atomicAdd(&(bar)[XB_TMO], 1u); break; } } } } while (0)

struct XcdBarrier {
    unsigned* bar; unsigned x;
    volatile LAS unsigned* st;
};

__device__ __forceinline__ XcdBarrier xcd_barrier_post(unsigned* bar, volatile LAS unsigned* st) {
    XcdBarrier b; b.bar = bar; b.x = xb_xcc_id(); b.st = st;
    if (threadIdx.x == 0) (void)xb_add(&bar[XB_XCNT(b.x)], 1u);
    return b;
}
__device__ __forceinline__ void xcd_barrier_complete(unsigned* bar, unsigned x, unsigned& nloc, unsigned& nx) {
    const unsigned G = gridDim.x * gridDim.y * gridDim.z;
    unsigned sum, cnt, mine, sp = 0u;
    for (;;) {
        sum = 0u; cnt = 0u; mine = 0u;
#pragma unroll
        for (unsigned j = 0; j < 16; ++j) { const unsigned c = xb_ld(&bar[XB_XCNT(j)]); sum += c; cnt += (c > 0u) ? 1u : 0u; mine = (j == x) ? c : mine; }
        if (sum == G) break;
        __builtin_amdgcn_s_sleep(1);
        if ((++sp & 255u) == 0u) { if (xb_ld(&bar[XB_TMO])) break; if (sp > XB_SPIN_CAP) { atomicAdd(&bar[XB_TMO], 1u); break; } }
    }
    nloc = mine > 0u ? mine : 1u; nx = cnt > 0u ? cnt : 1u;
}

__device__ __forceinline__ void xcd_barrier(const XcdBarrier& b) {
    asm volatile("s_waitcnt vmcnt(0)" ::: "memory");
    __syncthreads();
    if (threadIdx.x == 0) {
        unsigned* bar = b.bar;
        __builtin_amdgcn_s_waitcnt(0);
        unsigned nloc = b.st[0], nx = b.st[1];
        if (nloc == 0u) { xcd_barrier_complete(bar, b.x, nloc, nx); b.st[0] = nloc; b.st[1] = nx; }
        const unsigned old = xb_add(&bar[XB_XSUB(b.x)], 1u);
        const unsigned gen = old / nloc;
        if (old + 1u == (gen + 1u) * nloc) {
            __builtin_amdgcn_fence(__ATOMIC_RELEASE, "agent");
            asm volatile("s_waitcnt vmcnt(0)" ::: "memory");
            const unsigned og = xb_add(&bar[XB_TOP], 1u);
            const unsigned tg = og / nx;
            if (og + 1u == (tg + 1u) * nx) xb_add(&bar[XB_TOPGEN], 1u);
            else XB_SPIN(xb_ld(&bar[XB_TOPGEN]) == tg, bar);
            __builtin_amdgcn_fence(__ATOMIC_ACQUIRE, "agent");
            xb_add(&bar[XB_XGEN(b.x)], 1u);
            asm volatile("s_waitcnt vmcnt(0)" ::: "memory");
        } else {
            XB_SPIN(xb_ld(&bar[XB_XGEN(b.x)]) == gen, bar);
            __builtin_amdgcn_fence(__ATOMIC_ACQUIRE, "agent");
            asm volatile("s_waitcnt vmcnt(0)" ::: "memory");
        }
    }
    __syncthreads();
}

__global__ void __launch_bounds__(512, 2) mega_fwd(Params p) {
    extern __shared__ __attribute__((aligned(16))) unsigned char lds_raw[];
    LAS unsigned char* lds = (LAS unsigned char*)lds_raw;
    const int G0 = gridDim.x, bx0 = blockIdx.x;
#define PH_LOCALS PH_WS; int tid = threadIdx.x; asm volatile("" : "+v"(tid)); const int lane = tid & 63, wave = __builtin_amdgcn_readfirstlane(tid >> 6), gw = bx * 8 + wave; (void)lane; (void)gw
#define PH_WS const __attribute__((address_space(4))) Params* kp = (const __attribute__((address_space(4))) Params*)__builtin_amdgcn_kernarg_segment_ptr(); asm volatile("" : "+s"(kp)); \
        unsigned char* ws = kp->ws; float* X = kp->out; (void)X; int G = G0, bx = bx0; asm volatile("" : "+s"(G), "+s"(bx)); const int NGW = G * 8; (void)NGW
#define XB ((bf16_t*)(ws + WS_XB))
#define OB ((bf16_t*)(ws + WS_O))
#define cosT ((float*)(ws + WS_COS))
#define sinT ((float*)(ws + WS_SIN))
#define BT ((float*)(ws + WS_BT))
#define RQ ((float*)(ws + WS_RQ))
#define RKV ((float*)(ws + WS_RKV))
#define WQKV ((bf16_t*)(ws + WS_WQKV))
#define WOA ((bf16_t*)(ws + WS_WOA))
#define WDKV ((bf16_t*)(ws + WS_WDKV))
#define WUQ ((bf16_t*)(ws + WS_WUQ))
#define WUKV ((bf16_t*)(ws + WS_WUKV))
#define WOB ((bf16_t*)(ws + WS_WOB))
#define WIN ((bf16_t*)(ws + WS_WIN))
#define WOUT ((bf16_t*)(ws + WS_WOUT))
#define QKV ((bf16_t*)(ws + WS_QKV))
#define OG ((bf16_t*)(ws + WS_OG))
#define LSE ((float*)(ws + WS_LSE))
#define CB ((bf16_t*)(ws + WS_C))
#define QB ((bf16_t*)(ws + WS_QB))
#define KVB ((bf16_t*)(ws + WS_KV))
#define KRR ((bf16_t*)(ws + WS_KRR))
#define UB ((bf16_t*)(ws + WS_U))
#define Y1B ((bf16_t*)(ws + WS_S))
#define Y2B ((bf16_t*)(ws + WS_Y2))
#define HB ((bf16_t*)(ws + WS_H))
    cg::grid_group grid = cg::this_grid();
    volatile LAS unsigned* bst = (volatile LAS unsigned*)(lds + LDS_BYTES - 64);
    if (threadIdx.x == 0) { bst[0] = 0u; bst[1] = 0u; }
    __syncthreads();
    const XcdBarrier xbar = xcd_barrier_post((unsigned*)(p.ws + WS_CTL), bst);
    int ph = 0;
    const int lo = p.ph_lo, hi = p.ph_hi;
#define PH_ON (ph >= lo && ph < hi)
#ifndef MK_EN
#define MK_EN 0xffffffffu
#endif
#define EN(k) (((MK_EN) >> (k)) & 1u)
#ifndef MK_REP
#define MK_REP 0u
#endif
#define REPN(k) ((((MK_REP) >> (k)) & 1u) != 0)
#define REPN(k) ((((MK_REP) >> (k)) & 1u) != 0)
#define REP(k) for (int rep_ = 0; rep_ < ((((MK_REP) >> (k)) & 1u) ? 2 : 1); ++rep_)
#define PH_END do { if (ph >= lo && ph + 1 < hi) { if (lo < 0) grid.sync(); else xcd_barrier(xbar); } ++ph; } while (0)

    if (EN(0) && PH_ON) REP(0) {
        PH_LOCALS;
        LAS float* scr = (LAS float*)(lds + wave * 16384);
        constexpr int I_QKV = (DM / 64) * (NQKV / 32), I_O = (DM / 64) * (DM / 32), I_DKV = (DM / 64) * (672 / 32), I_UQ = (NCQ / 64) * (NQ / 32), I_UKV = (NCKV / 64) * (NKV / 32);
        constexpr int I_IN = (DM / 64) * (NFF / 32), I_OUT = (DFF / 64) * (DM / 32);
        constexpr int NITEMS = I_QKV + 2 * I_O + I_DKV + I_UQ + I_UKV + 2 * I_IN + 2 * I_OUT;
        for (int it = gw; it < NITEMS; it += NGW) {
            int r = it;
            if (r < I_QKV) { transpose_item(kp->w_qkv_a, DM, NQKV, WQKV, 0, nullptr, scr, r, lane); continue; } r -= I_QKV;
            if (r < I_O) { transpose_item(kp->w_o_a, DM, DM, WOA, 0, nullptr, scr, r, lane); continue; } r -= I_O;
            if (r < I_O) { transpose_item(kp->w_o_b, DM, DM, WOB, 0, nullptr, scr, r, lane); continue; } r -= I_O;
            if (r < I_DKV) { transpose_item(kp->w_dkv_b, DM, 672, WDKV, 2, nullptr, scr, r, lane); continue; } r -= I_DKV;
            if (r < I_UQ) { transpose_item(kp->w_uq_b, NCQ, NQ, WUQ, 1, kp->g_q_b, scr, r, lane); continue; } r -= I_UQ;
            if (r < I_UKV) { transpose_item(kp->w_ukv_b, NCKV, NKV, WUKV, 0, kp->g_kv_b, scr, r, lane); continue; } r -= I_UKV;
            if (r < 2 * I_IN) { const int ly = r / I_IN; transpose_item(kp->ffn_w_in + (size_t)ly * DM * NFF, DM, NFF, WIN + (size_t)ly * NFF * DM, 0, nullptr, scr, r - ly * I_IN, lane); continue; } r -= 2 * I_IN;
            { const int ly = r / I_OUT; transpose_item(kp->ffn_w_out + (size_t)ly * DFF * DM, DFF, DM, WOUT + (size_t)ly * DM * DFF, 0, nullptr, scr, r - ly * I_OUT, lane); }
        }
        for (int i = bx * 512 + tid; i < 96 * DM / 8; i += G * 512) *((u32x4*)(WDKV + (size_t)672 * DM) + i) = (u32x4){0u, 0u, 0u, 0u};
        for (int r = gw; r < T; r += 2 * NGW) {
            const int r2 = r + NGW; const bool h2 = r2 < T;
            const float* src = r < TP ? kp->x_prompt + (size_t)r * DM : kp->x_sample + (size_t)(r - TP) * DM;
            const float* src2 = r2 < TP ? kp->x_prompt + (size_t)r2 * DM : kp->x_sample + (size_t)((h2 ? r2 : r) - TP) * DM;
            f32x4 va[4], vb[4] = {};
#pragma unroll
            for (int j = 0; j < 4; ++j) { va[j] = *((const f32x4*)src + lane + 64 * j); if (h2) vb[j] = *((const f32x4*)src2 + lane + 64 * j); }
#pragma unroll
            for (int j = 0; j < 4; ++j) {
                u32x2 w; w.x = cvt_pk_bf16(va[j].x, va[j].y); w.y = cvt_pk_bf16(va[j].z, va[j].w);
                *((u32x2*)(XB + (size_t)r * DM) + lane + 64 * j) = w;
                if (h2) { u32x2 w2; w2.x = cvt_pk_bf16(vb[j].x, vb[j].y); w2.y = cvt_pk_bf16(vb[j].z, vb[j].w); *((u32x2*)(XB + (size_t)r2 * DM) + lane + 64 * j) = w2; }
            }
        }
        for (int i = bx * 512 + tid; i < 8192 * 16; i += G * 512) { float c, s; rope_entry(i >> 4, i & 15, c, s); cosT[i] = c; sinT[i] = s; }
        for (int i = bx * 512 + tid; i < 24 * 384; i += G * 512) {
            const int gh = i / 384, d = i % 384 - 192, g = gh >> 3;
            float v = -1e30f;
            if (d >= -64 && d <= 64) v = kp->rel_bias[t5_bucket(d * (1 << (2 * g))) * 24 + gh] * LOG2E;
            BT[i] = v;
        }
    }
    PH_END;

    {
        for (int c = 0; c < NCHUNK; ++c) {
            const int row0 = c * CHUNK, log2S = c < 4 ? 13 : 11, nseq = c < 4 ? 2 : 8;
            if (EN(1) && PH_ON) REP(1) {
                PH_WS;
                pg8::Gemm g{XB + (size_t)row0 * DM, WQKV, CHUNK, NQKV, DM, DM}; pg8::StaticOrder S; S.init(CHUNK, NQKV, G, bx);
                pg8::EpiQKV E{QKV, log2S, 0.08838834764831845f * LOG2E};
                pg8::gemm_phase<pg8::EpiQKV, pg8::StaticOrder>(lds, g, S, E);
            }
            PH_END;
            if (EN(2) && PH_ON) REP(2) { PH_WS; attn_dil_phase(lds, QKV, BT, OG, LSE, nseq, log2S, G, bx); }
            PH_END;
            if (EN(3) && PH_ON) REP(3) {   PH_LOCALS;
                for (int r = gw; r < CHUNK; r += NGW) {
                    const int h = lane >> 3;
                    const float l0 = LSE[((size_t)0 * CHUNK + r) * 8 + h], l1 = LSE[((size_t)1 * CHUNK + r) * 8 + h], l2 = LSE[((size_t)2 * CHUNK + r) * 8 + h];
                    const float mx = fmaxf(l0, fmaxf(l1, l2));
                    float w0 = __builtin_amdgcn_exp2f(l0 - mx), w1 = __builtin_amdgcn_exp2f(l1 - mx), w2 = __builtin_amdgcn_exp2f(l2 - mx);
                    const float inv = 1.f / (w0 + w1 + w2); w0 *= inv; w1 *= inv; w2 *= inv;
#pragma unroll
                    for (int j = 0; j < 2; ++j) {
                        const bf16x8 a = *((const bf16x8*)(OG + ((size_t)0 * CHUNK + r) * DM) + lane * 2 + j), b = *((const bf16x8*)(OG + ((size_t)1 * CHUNK + r) * DM) + lane * 2 + j),
                                     cc = *((const bf16x8*)(OG + ((size_t)2 * CHUNK + r) * DM) + lane * 2 + j);
                        float v[8];
#pragma unroll
                        for (int e = 0; e < 8; ++e) v[e] = w0 * bf2f((unsigned short)a[e]) + w1 * bf2f((unsigned short)b[e]) + w2 * bf2f((unsigned short)cc[e]);
                        u32x4 w; w.x = cvt_pk_bf16(v[0], v[1]); w.y = cvt_pk_bf16(v[2], v[3]); w.z = cvt_pk_bf16(v[4], v[5]); w.w = cvt_pk_bf16(v[6], v[7]);
                        *((u32x4*)(OB + (size_t)(row0 + r) * DM) + lane * 2 + j) = w;
                    }
                }
            }
            if (c + 1 < NCHUNK && MK_MULTI == 0) ++ph; else PH_END;
        }
    }
    for (int layer = 0; layer < 2; ++layer) {
        if (layer == 1) {
            if (EN(4) && PH_ON) REP(4) {
                PH_WS;
                pg8::Gemm g{XB, WDKV, T, CW, DM, DM}; pg8::StaticOrder S; S.init(T, CW, G, bx);
                pg8::EpiStore E{CB, CW, nullptr, 1.f};
                pg8::gemm_phase<pg8::EpiStore, pg8::StaticOrder>(lds, g, S, E);
            }
            PH_END;
            if (EN(5) && PH_ON) REP(5) {   PH_LOCALS;
                for (int r = gw; r < T; r += NGW) {
                    const bf16_t* crow = CB + (size_t)r * CW;
                    const bf16x8 a = *((const bf16x8*)crow + lane);
                    bf16x8 b = {}; if (lane < 20) b = *((const bf16x8*)crow + 64 + lane);
                    float fa[8], fb[8], sa = 0.f, sb = 0.f;
#pragma unroll
                    for (int e = 0; e < 8; ++e) { fa[e] = bf2f((unsigned short)a[e]); fb[e] = bf2f((unsigned short)b[e]); sa += fa[e] * fa[e]; sb += fb[e] * fb[e]; }
                    const float sq = wave_sum(lane < 48 ? sa : 0.f, lane), skv = wave_sum((lane >= 48 ? sa : 0.f) + (lane < 16 ? sb : 0.f), lane);
                    if (lane == 0) { RQ[r] = 1.f / sqrtf(sq * (1.f / NCQ) + RMS_EPS); RKV[r] = 1.f / sqrtf(skv * (1.f / NCKV) + RMS_EPS); }
                    if (lane >= 16 && lane < 20) {
                        const int j = lane - 16, pos = r < TP ? (r & 8191) : (r & 2047);
                        const f32x4 cs = *(const f32x4*)(cosT + pos * 16 + 4 * j), sn = *(const f32x4*)(sinT + pos * 16 + 4 * j);
                        float o1[4], o2[4];
#pragma unroll
                        for (int e = 0; e < 4; ++e) { o1[e] = fb[e] * cs[e] - fb[4 + e] * sn[e]; o2[e] = fb[e] * sn[e] + fb[4 + e] * cs[e]; }
                        u32x4 w; w.x = cvt_pk_bf16(o1[0], o1[1]); w.y = cvt_pk_bf16(o1[2], o1[3]); w.z = cvt_pk_bf16(o2[0], o2[1]); w.w = cvt_pk_bf16(o2[2], o2[3]);
                        *((u32x4*)(KRR + (size_t)r * 32) + j) = w;
                    }
                }
            }
            PH_END;
            if (EN(6) && PH_ON) REP(6) {
                PH_WS;
                { pg8::Gemm g{CB, WUQ, T, NQ, NCQ, CW}; pg8::StaticOrder S; S.init(T, NQ, G, bx);
                  pg8::EpiQRope E{QB, RQ, 0.10206207261596575f * LOG2E, cosT, sinT};
                  pg8::gemm_phase<pg8::EpiQRope, pg8::StaticOrder>(lds, g, S, E); }
                { pg8::Gemm g{CB + NCQ, WUKV, T, NKV, NCKV, CW}; pg8::StaticOrder S; S.init(T, NKV, G, bx);
                  pg8::EpiStore E{KVB, NKV, RKV, 1.f};
                  pg8::gemm_phase<pg8::EpiStore, pg8::StaticOrder>(lds, g, S, E); }
            }
            PH_END;
            if (EN(7) && PH_ON) REP(7) { PH_WS; attn_mla_phase(lds, QB, KVB, KRR, OB, G, bx); }
            PH_END;
        }
        if (EN(8) && PH_ON) REP(8) {
                PH_WS;
            pg8::Gemm g{OB, layer == 0 ? WOA : WOB, T, DM, DM, DM}; pg8::StaticOrder S; S.init(T, DM, G, bx);
            pg8::EpiStore E{Y1B, DM, nullptr, 1.f};
            pg8::gemm_phase<pg8::EpiStore, pg8::StaticOrder>(lds, g, S, E);
        }
        PH_END;
        if (EN(9) && PH_ON) REP(9) { PH_LOCALS; ln_phase(layer == 0 ? kp->x_prompt : X, layer == 0 ? kp->x_sample : X + (size_t)TP * DM, Y1B, (REPN(9) && rep_ == 0) ? (float*)(ws + 560 * MiB) : X, (REPN(9) && rep_ == 0) ? OB : XB, kp->ln_g + (layer * 2 + 0) * DM, kp->ln_b + (layer * 2 + 0) * DM, gw, NGW, lane); }
        PH_END;
        {
            for (int c = 0; c < 3; ++c) {
                const int row0 = c * 32768, crows = c < 2 ? 32768 : 16384, log2S = c < 2 ? 13 : 11;
                if (EN(10) && PH_ON) REP(10) {
                PH_WS;
                    pg8::Gemm g{XB + (size_t)row0 * DM, WIN + (size_t)layer * NFF * DM, crows, NFF, DM, DM}; pg8::StaticOrder S; S.init(crows, NFF, G, bx);
                    pg8::EpiStore E{HB, NFF, nullptr, 1.f};
                    pg8::gemm_phase<pg8::EpiStore, pg8::StaticOrder>(lds, g, S, E);
                }
                PH_END;
                if (EN(11) && PH_ON) REP(11) {   PH_LOCALS;
                    const float* cw = kp->ffn_conv_w + (size_t)layer * 3 * NFF; const float* cb = kp->ffn_conv_b + (size_t)layer * NFF; const bf16_t* H = HB; bf16_t* U = UB;
                    const int nitems = (crows / 8) * 11, smask = (1 << log2S) - 1;
                    for (int it = gw; it < nitems; it += NGW) {
                        const int rr = it / 11, cgp = it - rr * 11, col = (cgp * 64 + lane) * 4, r0 = rr * 8;
                        u32x2 ra[10], rg[10];
                        const bool hp = (r0 & smask) != 0, hn = ((r0 + 8) & smask) != 0;
#pragma unroll
                        for (int i = 0; i < 10; ++i) {
                            const bool ok = (i == 0) ? hp : (i == 9) ? hn : true;
                            if (ok) { ra[i] = *(const u32x2*)(H + (size_t)(r0 - 1 + i) * NFF + col); rg[i] = *(const u32x2*)(H + (size_t)(r0 - 1 + i) * NFF + DFF + col); }
                            else { ra[i] = (u32x2){0u, 0u}; rg[i] = (u32x2){0u, 0u}; }
                        }
                        f32x4 wa[3], wg[3];
#pragma unroll
                        for (int k = 0; k < 3; ++k) { wa[k] = *(const f32x4*)(cw + k * NFF + col); wg[k] = *(const f32x4*)(cw + k * NFF + DFF + col); }
                        const f32x4 ba = *(const f32x4*)(cb + col), bg = *(const f32x4*)(cb + DFF + col);
#define BF4(u) ((f32x4){__uint_as_float((u).x << 16), __uint_as_float((u).x & 0xffff0000u), __uint_as_float((u).y << 16), __uint_as_float((u).y & 0xffff0000u)})
#pragma unroll
                        for (int i = 0; i < 8; ++i) {
                            const f32x4 av = wa[0] * BF4(ra[i]) + wa[1] * BF4(ra[i + 1]) + wa[2] * BF4(ra[i + 2]) + ba;
                            const f32x4 gv = wg[0] * BF4(rg[i]) + wg[1] * BF4(rg[i + 1]) + wg[2] * BF4(rg[i + 2]) + bg;
                            u32x2 w; w.x = cvt_pk_bf16(av[0] * gelu_erf(gv[0]), av[1] * gelu_erf(gv[1])); w.y = cvt_pk_bf16(av[2] * gelu_erf(gv[2]), av[3] * gelu_erf(gv[3]));
                            *(u32x2*)(U + (size_t)(row0 + r0 + i) * DFF + col) = w;
                        }
#undef BF4
                    }
                }
                PH_END;
            }
            if (EN(12) && PH_ON) REP(12) {
                PH_WS;
                pg8::Gemm g{UB, WOUT + (size_t)layer * DM * DFF, T, DM, DFF, DFF}; pg8::StaticOrder S; S.init(T, DM, G, bx);
                pg8::EpiStore E{Y2B, DM, nullptr, 1.f};
                pg8::gemm_phase<pg8::EpiStore, pg8::StaticOrder>(lds, g, S, E);
            }
            PH_END;
            if (EN(13) && PH_ON) REP(13) { PH_LOCALS; ln_phase(X, X + (size_t)TP * DM, Y2B, (REPN(13) && rep_ == 0) ? (float*)(ws + 222 * MiB) : X, (REPN(13) && rep_ == 0) ? (bf16_t*)(ws + 822 * MiB) : XB, kp->ln_g + (layer * 2 + 1) * DM, kp->ln_b + (layer * 2 + 1) * DM, gw, NGW, lane, layer == 0); }
            PH_END;
        }
    }
#undef PH_ON
#undef PH_END
}
constexpr int N_PHASES = 1 + 15 + 2 * (2 + 8) + 4;

extern "C" void kernel_launch(void* const* d_in, const int* in_sizes, int n_in, void* d_out, int out_size, void* d_ws, size_t ws_size, hipStream_t stream) {
    static int grid = 0;
    if (grid == 0) {
        if (n_in != 17 || out_size != T * DM || ws_size < WS_END) { fprintf(stderr, "kernel_launch: unexpected shapes (n_in %d out %d ws %zu)\n", n_in, out_size, ws_size); grid = -1; return; }
        int dev = 0, cus = 0, per_cu = 0;
        if (hipGetDevice(&dev) != hipSuccess || hipDeviceGetAttribute(&cus, hipDeviceAttributeMultiprocessorCount, dev) != hipSuccess) { grid = -1; return; }
        if (hipFuncSetAttribute((const void*)mega_fwd, hipFuncAttributeMaxDynamicSharedMemorySize, LDS_BYTES) != hipSuccess) { fprintf(stderr, "kernel_launch: hipFuncSetAttribute failed\n"); grid = -1; return; }
        if (hipOccupancyMaxActiveBlocksPerMultiprocessor(&per_cu, (const void*)mega_fwd, 512, LDS_BYTES) != hipSuccess || per_cu < 1) { fprintf(stderr, "kernel_launch: occupancy query says %d\n", per_cu); per_cu = 1; }
        (void)hipGetLastError();
        grid = cus * 1;
    }
    if (grid < 0) return;
    if (hipMemsetAsync((char*)d_ws + WS_CTL, 0, CTL_BYTES, stream) != hipSuccess) { fprintf(stderr, "kernel_launch: memset failed\n"); return; }
    Params p{};
    const float** pp = (const float**)&p;
    for (int i = 0; i < 17; ++i) pp[i] = (const float*)d_in[i];
    p.out = (float*)d_out; p.ws = (unsigned char*)d_ws;
#if MK_MULTI
    for (int k = 0; k < N_PHASES; ++k) { p.ph_lo = k; p.ph_hi = k + 1; hipLaunchKernelGGL(mega_fwd, dim3(grid), dim3(512), LDS_BYTES, stream, p); }
#else
    p.ph_lo = 0; p.ph_hi = N_PHASES;
    void* args[] = {&p};
    hipError_t e = hipLaunchCooperativeKernel((const void*)mega_fwd, dim3(grid), dim3(512), args, LDS_BYTES, stream);
    if (e != hipSuccess) fprintf(stderr, "cooperative launch failed: %s (grid %d)\n", hipGetErrorString(e), grid);
#endif
}
```

```cpp
#include <hip/hip_runtime.h>
#include <hip/hip_cooperative_groups.h>
#include <cstdio>
#include <cstdint>
namespace cg = cooperative_groups;

#ifndef MK_MULTI
#define MK_MULTI 0
#endif

#define LAS __attribute__((address_space(3)))
typedef unsigned short bf16_t;
typedef short bf16x8 __attribute__((ext_vector_type(8)));
typedef short s16x4 __attribute__((ext_vector_type(4)));
typedef float f32x4 __attribute__((ext_vector_type(4)));
typedef float f32x2 __attribute__((ext_vector_type(2)));
typedef float f32x16 __attribute__((ext_vector_type(16)));
typedef unsigned u32x4 __attribute__((ext_vector_type(4)));
typedef unsigned u32x2 __attribute__((ext_vector_type(2)));

constexpr int DM = 1024, TP = 65536, TS = 16384, T = TP + TS;
constexpr int NQKV = 9216, DFF = 2816, NFF = 2 * DFF;
constexpr int CW = 768, NCQ = 384, NCKV = 256, NQ = 1536, NKV = 2048;
constexpr int CHUNK = 16384, NCHUNK = 5;
constexpr float ALPHA = 1.4142135623730951f;
constexpr float LOG2E = 1.4426950408889634f;
constexpr float LN_EPS = 1e-5f, RMS_EPS = 1e-6f;

constexpr size_t MiB = 1u << 20;
constexpr size_t WS_COS = 0, WS_SIN = 512 * 1024, WS_BT = 1 * MiB, WS_RQ = 1 * MiB + 256 * 1024, WS_RKV = 1 * MiB + 640 * 1024;
constexpr size_t WS_WQKV = 2 * MiB, WS_WOA = 20 * MiB, WS_WDKV = 22 * MiB, WS_WUQ = 24 * MiB, WS_WUKV = 25 * MiB + 512 * 1024, WS_WOB = 27 * MiB;
constexpr size_t WS_WIN = 29 * MiB, WS_WOUT = 51 * MiB;
constexpr size_t WS_XB = 62 * MiB, WS_O = 222 * MiB, WS_C = 222 * MiB, WS_S = 382 * MiB;
constexpr size_t WS_QKV = WS_S, WS_OG = WS_S + 288 * MiB, WS_LSE = WS_S + 384 * MiB;
constexpr size_t WS_U = WS_O, WS_H = WS_O + 440 * MiB, WS_Y2 = WS_H;
constexpr size_t WS_QB = WS_S, WS_KV = WS_S + 240 * MiB, WS_KRR = WS_S + 560 * MiB;
constexpr size_t WS_CTL = 1016 * MiB, CTL_BYTES = 65536;
constexpr size_t WS_END = WS_CTL + CTL_BYTES;
constexpr int LDS_BYTES = 147456;

__device__ __forceinline__ unsigned cvt_pk_bf16(float lo, float hi) { unsigned r; asm volatile("v_cvt_pk_bf16_f32 %0, %1, %2" : "=v"(r) : "v"(lo), "v"(hi)); return r; }
__device__ __forceinline__ u32x4 pack8(f32x4 v0, f32x4 v1) { u32x4 w; w.x = cvt_pk_bf16(v0[0], v0[1]); w.y = cvt_pk_bf16(v0[2], v0[3]); w.z = cvt_pk_bf16(v1[0], v1[1]); w.w = cvt_pk_bf16(v1[2], v1[3]); return w; }
__device__ __forceinline__ float bf2f(unsigned short b) { return __uint_as_float((unsigned)b << 16); }
__device__ __forceinline__ float wave_sum(float v, int lane) {
#pragma unroll
    for (int o = 1; o < 32; o <<= 1) v += __int_as_float(__builtin_amdgcn_ds_bpermute((lane ^ o) << 2, __float_as_int(v)));
    auto rr = __builtin_amdgcn_permlane32_swap(__float_as_uint(v), __float_as_uint(v), false, false);
    return __uint_as_float(rr[0]) + __uint_as_float(rr[1]);
}

namespace pg8 {
constexpr int BM = 256, BK = 64, HALF = 128, HTB = HALF * BK * 2, STAGE_BYTES = 8 * HTB, NXCD = 8, WGM = 8;
__host__ __device__ __forceinline__ int lds_byte(int r, int c) { const int st = (r >> 4) * 2 + (c >> 5), rr = r & 15, cc = c & 31, ob = rr * 64 + cc * 2; return st * 1024 + (ob ^ (((ob >> 9) & 1) << 5)); }
__host__ __device__ __forceinline__ void stage_rc(int b, int& R, int& C) { const int st = b / 1024, sb = b % 1024, swz = sb ^ (((sb >> 9) & 1) << 5); R = (st >> 1) * 16 + swz / 64; C = (st & 1) * 32 + (swz % 64) / 2; }
__host__ __device__ __forceinline__ int perm32(int rho) { const int n = rho >> 4, i = rho & 15; return 8 * (i >> 2) + 4 * n + (i & 3); }

struct Unit { int pm, pn; };
struct Gemm { const bf16_t* A; const bf16_t* Bt; int M, N, K, lda; };

struct StaticOrder {
    int nM, nN, nwg, G, c;
    __device__ void init(int M, int N, int G_, int c_) { nM = M / BM; nN = N / BM; nwg = nM * nN; G = G_; c = c_; }
    __device__ bool next(int i, Unit& u) const {
        const long L = (long)i * G + c; if (L >= nwg) return false;
        int wgid = (int)L; { const int q = nwg / NXCD, r = nwg % NXCD, xcd = wgid % NXCD, off = wgid / NXCD; wgid = (xcd < r ? xcd * (q + 1) : r * (q + 1) + (xcd - r) * q) + off; }
        const int nig = WGM * nN, gid = wgid / nig, fm = gid * WGM, gsz = (nM - fm) < WGM ? (nM - fm) : WGM;
        u.pm = fm + ((wgid % nig) % gsz); u.pn = (wgid % nig) / gsz; return true;
    }
};

struct EpiStore {
    static constexpr bool PERM = true;
    bf16_t* O; int ldc; const float* rscale; float cscale;
    __device__ __forceinline__ void operator()(const f32x4 (&acc)[2][2][4][2], const Unit& u, int wr, int wc, int fr, int fq) const {
        const int row0 = u.pm * BM + wr * 64 + fr, col0 = u.pn * BM + wc * 32 + 8 * fq;
#pragma unroll
        for (int ai = 0; ai < 2; ++ai)
#pragma unroll
            for (int m = 0; m < 4; ++m) {
                const int row = row0 + ai * HALF + m * 16;
                const float s = rscale ? rscale[row] * cscale : cscale;
                bf16_t* rowp = O + (size_t)row * ldc + col0;
#pragma unroll
                for (int bj = 0; bj < 2; ++bj) *(u32x4*)(rowp + bj * HALF) = pack8(acc[ai][bj][m][0] * s, acc[ai][bj][m][1] * s);
            }
    }
};
struct EpiQRope {
    static constexpr bool PERM = true;
    bf16_t* O; const float* rscale; float cscale; const float* cosT; const float* sinT;
    __device__ __forceinline__ void operator()(const f32x4 (&acc)[2][2][4][2], const Unit& u, int wr, int wc, int fr, int fq) const {
        const int row0 = u.pm * BM + wr * 64 + fr, col0 = u.pn * BM + wc * 32 + 8 * fq;
        int rj[2];
#pragma unroll
        for (int bj = 0; bj < 2; ++bj) { const int w = (col0 + bj * HALF) % 96; rj[bj] = (w >= 64) ? ((w - 64) >> 3) : -1; }
#pragma unroll
        for (int ai = 0; ai < 2; ++ai)
#pragma unroll
            for (int m = 0; m < 4; ++m) {
                const int row = row0 + ai * HALF + m * 16;
                const float s = rscale[row] * cscale;
                const int pos = row < TP ? (row & 8191) : (row & 2047);
                bf16_t* rowp = O + (size_t)row * NQ + col0;
#pragma unroll
                for (int bj = 0; bj < 2; ++bj) {
                    f32x4 v0 = acc[ai][bj][m][0] * s, v1 = acc[ai][bj][m][1] * s;
                    if (rj[bj] >= 0) {
                        const f32x4 cs = *(const f32x4*)(cosT + pos * 16 + 4 * rj[bj]), sn = *(const f32x4*)(sinT + pos * 16 + 4 * rj[bj]);
                        const f32x4 t1 = v0, t2 = v1; v0 = t1 * cs - t2 * sn; v1 = t1 * sn + t2 * cs;
                    }
                    *(u32x4*)(rowp + bj * HALF) = pack8(v0, v1);
                }
            }
    }
};
struct EpiQKV {
    static constexpr bool PERM = true;
    bf16_t* O; int log2S; float qscale;
    __device__ __forceinline__ void operator()(const f32x4 (&acc)[2][2][4][2], const Unit& u, int wr, int wc, int fr, int fq) const {
        const int colt = u.pn * BM, g = colt / 3072, which = (colt - g * 3072) >> 10, sh = 2 * g, log2L = log2S - sh, S = 1 << log2S;
        const float sc = (which == 0) ? qscale : 1.f;
        const int row0 = u.pm * BM + wr * 64 + fr, col0 = colt + wc * 32 + 8 * fq;
#pragma unroll
        for (int ai = 0; ai < 2; ++ai)
#pragma unroll
            for (int m = 0; m < 4; ++m) {
                const int rl = row0 + ai * HALF + m * 16, seq = rl >> log2S, s = rl & (S - 1);
                const int f = ((s & ((1 << sh) - 1)) << log2L) + (s >> sh), drow = (seq << log2S) + f;
                bf16_t* rowp = O + (size_t)drow * NQKV + col0;
#pragma unroll
                for (int bj = 0; bj < 2; ++bj) *(u32x4*)(rowp + bj * HALF) = pack8(acc[ai][bj][m][0] * sc, acc[ai][bj][m][1] * sc);
            }
    }
};
struct EpiRes {
    static constexpr bool PERM = true;
    float* X; float alpha;
    __device__ __forceinline__ void operator()(const f32x4 (&acc)[2][2][4][2], const Unit& u, int wr, int wc, int fr, int fq) const {
        const int row0 = u.pm * BM + wr * 64 + fr, col0 = u.pn * BM + wc * 32 + 8 * fq;
#pragma unroll
        for (int ai = 0; ai < 2; ++ai)
#pragma unroll
            for (int m = 0; m < 4; ++m) {
                float* rowp = X + (size_t)(row0 + ai * HALF + m * 16) * DM + col0;
#pragma unroll
                for (int bj = 0; bj < 2; ++bj) {
                    float* p = rowp + bj * HALF; const f32x4 a = *(const f32x4*)p, b = *(const f32x4*)(p + 4);
                    *(f32x4*)p = a * alpha + acc[ai][bj][m][0]; *(f32x4*)(p + 4) = b * alpha + acc[ai][bj][m][1];
                }
            }
    }
};

template <class Epi, class Sched, bool ALIGN_EPI = true, bool SP2 = true>
__device__ __forceinline__ void gemm_phase(LAS unsigned char* lds, const Gemm g, const Sched& S, const Epi& E) {
    int tid_ = threadIdx.x; asm volatile("" : "+v"(tid_));
    const int tid = tid_, wid = __builtin_amdgcn_readfirstlane(tid >> 6), lane = tid & 63, wr = wid >> 2, wc = wid & 3, fr = lane & 15, fq = lane >> 4;
    const int K = g.K, nt = K / BK, lda = g.lda;
    unsigned voffA[2], voffB[2];
#pragma unroll
    for (int i = 0; i < 2; ++i) { int R, C; stage_rc(tid * 16 + i * 8192, R, C); const int Rb = Epi::PERM ? ((R & ~31) + perm32(R & 31)) : R;
        voffA[i] = (unsigned)(R * lda + C) * 2u; voffB[i] = (unsigned)(Rb * K + C) * 2u; }
    const size_t kstep = (size_t)(BK * 2);
    const size_t hstepA = (size_t)HALF * lda * 2, hstepB = (size_t)HALF * K * 2;
    const size_t tstepA = 2 * hstepA, tstepB = 2 * hstepB;
    const unsigned ldsw = (unsigned)wid * 1024u;
    const int aoff = lds_byte(wr * 64 + fr, fq * 8), boff = lds_byte(wc * 32 + fr, fq * 8);
#define PG8_SA(b, h) (((b) * 2 + (h)) * HTB)
#define PG8_SB(b, h) ((4 + (b) * 2 + (h)) * HTB)
#define PG8_STAGE(bufoff, gbase, voff) do { _Pragma("unroll") for (int _i = 0; _i < 2; ++_i) \
        __builtin_amdgcn_global_load_lds((const unsigned*)((const char*)(gbase) + (voff)[_i]), (LAS unsigned*)(lds + (bufoff) + ldsw + _i * 8192), 16, 0, 0); } while (0)
#define PG8_LDA(dst, b, h) do { _Pragma("unroll") for (int m = 0; m < 4; ++m) _Pragma("unroll") for (int k = 0; k < 2; ++k) dst[m][k] = *(const LAS bf16x8*)(lds + PG8_SA(b, h) + aoff + m * 2048 + k * 1024); } while (0)
#define PG8_LDB(dst, b, h) do { _Pragma("unroll") for (int n = 0; n < 2; ++n) _Pragma("unroll") for (int k = 0; k < 2; ++k) dst[n][k] = *(const LAS bf16x8*)(lds + PG8_SB(b, h) + boff + n * 2048 + k * 1024); } while (0)
#define PG8_MMA(ai, bj, At, Bt) do { __builtin_amdgcn_s_setprio(1); _Pragma("unroll") for (int m = 0; m < 4; ++m) _Pragma("unroll") for (int n = 0; n < 2; ++n) _Pragma("unroll") for (int k = 0; k < 2; ++k) \
        acc[ai][bj][m][n] = __builtin_amdgcn_mfma_f32_16x16x32_bf16(Bt[n][k], At[m][k], acc[ai][bj][m][n], 0, 0, 0); __builtin_amdgcn_s_setprio(0); } while (0)
#define PG8_WAIT_V(n) asm volatile("s_waitcnt vmcnt(" #n ")" ::: "memory")
#define PG8_WAIT_L(n) asm volatile("s_waitcnt lgkmcnt(" #n ")" ::: "memory")
#define PG8_BAR __builtin_amdgcn_s_barrier()
#define PG8_SCHED __builtin_amdgcn_sched_barrier(0)
    Unit cur, nxt; int ui = 0;
    if (!S.next(0, cur)) return;
    f32x4 acc[2][2][4][2];
#pragma unroll
    for (int a = 0; a < 2; ++a)
#pragma unroll
        for (int b = 0; b < 2; ++b)
#pragma unroll
            for (int m = 0; m < 4; ++m)
#pragma unroll
                for (int n = 0; n < 2; ++n) acc[a][b][m][n] = (f32x4){0.f, 0.f, 0.f, 0.f};
    bf16x8 At[4][2], B0[2][2], B1[2][2];
    const char* cA = (const char*)g.A + (size_t)cur.pm * tstepA; const char* cB = (const char*)g.Bt + (size_t)cur.pn * tstepB;
    if constexpr (SP2) {
        PG8_STAGE(PG8_SB(0, 0), cB, voffB); PG8_STAGE(PG8_SB(0, 1), cB + hstepB, voffB); PG8_STAGE(PG8_SA(0, 0), cA, voffA); PG8_STAGE(PG8_SA(0, 1), cA + hstepA, voffA);
        if (wr == 1) PG8_BAR;
        PG8_WAIT_V(2); PG8_BAR;
        PG8_STAGE(PG8_SB(1, 0), cB + kstep, voffB); PG8_STAGE(PG8_SA(1, 0), cA + kstep, voffA); PG8_STAGE(PG8_SB(1, 1), cB + hstepB + kstep, voffB);
        PG8_WAIT_V(6); PG8_BAR;
    }
    for (;;) {
        const bool has_next = S.next(ui + 1, nxt);
        const char* nA = has_next ? (const char*)g.A + (size_t)nxt.pm * tstepA : cA; const char* nB = has_next ? (const char*)g.Bt + (size_t)nxt.pn * tstepB : cB;
        for (int t = 0; t < nt; t += 2) {
            const bool last = (t == nt - 2);
            const char* a1 = cA + (size_t)(t + 1) * kstep;
            const char* a2 = last ? nA : cA + (size_t)(t + 2) * kstep; const char* b2 = last ? nB : cB + (size_t)(t + 2) * kstep;
            const char* a3 = a2 + kstep; const char* b3 = b2 + kstep;
            PG8_LDB(B0, 0, 0); PG8_LDB(B1, 0, 1); PG8_SCHED; PG8_LDA(At, 0, 0); PG8_STAGE(PG8_SA(1, 1), a1 + hstepA, voffA);
            PG8_WAIT_V(8); PG8_WAIT_L(0); PG8_BAR; PG8_MMA(0, 0, At, B0); PG8_MMA(0, 1, At, B1); PG8_BAR; PG8_SCHED;
            PG8_LDA(At, 0, 1); PG8_STAGE(PG8_SB(0, 0), b2, voffB); PG8_STAGE(PG8_SB(0, 1), b2 + hstepB, voffB); PG8_STAGE(PG8_SA(0, 0), a2, voffA);
            PG8_WAIT_V(8); PG8_WAIT_L(0); PG8_BAR; PG8_MMA(1, 0, At, B0); PG8_MMA(1, 1, At, B1); PG8_BAR; PG8_SCHED;
            PG8_LDB(B0, 1, 0); PG8_LDB(B1, 1, 1); PG8_SCHED; PG8_LDA(At, 1, 0); PG8_STAGE(PG8_SA(0, 1), a2 + hstepA, voffA);
            PG8_WAIT_V(8); PG8_WAIT_L(0); PG8_BAR; PG8_MMA(0, 0, At, B0); PG8_MMA(0, 1, At, B1); PG8_BAR; PG8_SCHED;
            PG8_LDA(At, 1, 1); PG8_STAGE(PG8_SB(1, 0), b3, voffB); PG8_STAGE(PG8_SB(1, 1), b3 + hstepB, voffB); PG8_STAGE(PG8_SA(1, 0), a3, voffA);
            PG8_WAIT_V(8); PG8_WAIT_L(0); PG8_BAR; PG8_MMA(1, 0, At, B0); PG8_MMA(1, 1, At, B1); PG8_BAR; PG8_SCHED;
        }
        if constexpr (ALIGN_EPI) { if (wr == 0) PG8_BAR; }
        { int l2 = threadIdx.x; asm volatile("" : "+v"(l2)); l2 &= 63; E(acc, cur, wr, wc, l2 & 15, l2 >> 4); }
        if (!has_next) break;
#pragma unroll
        for (int a = 0; a < 2; ++a)
#pragma unroll
            for (int b = 0; b < 2; ++b)
#pragma unroll
                for (int m = 0; m < 4; ++m)
#pragma unroll
                    for (int n = 0; n < 2; ++n) acc[a][b][m][n] = (f32x4){0.f, 0.f, 0.f, 0.f};
        cur = nxt; cA = nA; cB = nB; ++ui;
        if constexpr (ALIGN_EPI) { if (wr == 1) PG8_BAR; }
    }
    PG8_WAIT_V(0);
    if constexpr (!ALIGN_EPI) { if (wr == 0) PG8_BAR; }
    PG8_BAR;
#undef PG8_SA
#undef PG8_SB
#undef PG8_STAGE
#undef PG8_LDA
#undef PG8_LDB
#undef PG8_MMA
#undef PG8_WAIT_V
#undef PG8_WAIT_L
#undef PG8_BAR
#undef PG8_SCHED
}
}

struct Params {
    const float *x_prompt, *x_sample, *rel_bias, *w_qkv_a, *w_o_a, *w_dkv_b, *g_q_b, *g_kv_b, *w_uq_b, *w_ukv_b, *w_o_b, *ffn_w_in, *ffn_conv_w, *ffn_conv_b, *ffn_w_out, *ln_g, *ln_b;
    float* out; unsigned char* ws;
    int ph_lo, ph_hi;
};

__device__ __forceinline__ int rope_perm32(int i) { const int t = i >> 4, ii = i & 15; return 8 * (ii >> 2) + 4 * t + (ii & 3); }
__device__ __forceinline__ int rowmap(int mode, int n) {
    if (mode == 1) { const int h = n / 96, w = n - h * 96; return w < 64 ? n : h * 96 + 64 + rope_perm32(w - 64); }
    if (mode == 2) { return n < 640 ? n : 640 + rope_perm32(n - 640); }
    return n;
}
__device__ __forceinline__ void transpose_item(const float* W, int K, int N, bf16_t* WT, int mode, const float* kscale, LAS float* scr, int item, int lane) {
    const int nblk = N / 32, kb = item / nblk, nb = item % nblk, k0 = 64 * kb, n0 = 32 * nb;
    const int kr = lane >> 3, c4 = (lane & 7) * 4;
#pragma unroll
    for (int i = 0; i < 8; ++i) { const int kk = kr + 8 * i; f32x4 v = *(const f32x4*)(W + (size_t)(k0 + kk) * N + n0 + c4); if (kscale) v = v * kscale[k0 + kk];
        scr[kk * 33 + c4] = v.x; scr[kk * 33 + c4 + 1] = v.y; scr[kk * 33 + c4 + 2] = v.z; scr[kk * 33 + c4 + 3] = v.w; }
    asm volatile("s_waitcnt lgkmcnt(0)" ::: "memory");
    const int c = lane & 7;
#pragma unroll
    for (int j = 0; j < 4; ++j) { const int n = (lane >> 3) + 8 * j; const LAS float* s = scr + (8 * c) * 33 + n;
        u32x4 o; o.x = cvt_pk_bf16(s[0 * 33], s[1 * 33]); o.y = cvt_pk_bf16(s[2 * 33], s[3 * 33]); o.z = cvt_pk_bf16(s[4 * 33], s[5 * 33]); o.w = cvt_pk_bf16(s[6 * 33], s[7 * 33]);
        *(u32x4*)(WT + (size_t)rowmap(mode, n0 + n) * K + k0 + 8 * c) = o; }
    asm volatile("s_waitcnt lgkmcnt(0)" ::: "memory");
}
__device__ __forceinline__ int t5_bucket(int rel) {
    const int n = rel < 0 ? -rel : rel; const int ret = rel > 0 ? 16 : 0;
    if (n < 8) return ret + n;
    int large = 8 + (int)(__log2f((float)n * 0.125f) * (8.0f / 7.0f));
    if (large > 15) large = 15;
    return ret + large;
}
__device__ __forceinline__ void rope_entry(int pos, int i, float& c, float& s) {
    const double x = -(double)i * (13.287712379549449 / 16.0);
    const double fl = __builtin_floor(x), fr = (x - fl) * 0.6931471805599453;
    double e = 1.0, term = 1.0;
#pragma unroll 1
    for (int k = 1; k < 22; ++k) { term *= fr / (double)k; e += term; }
    const long long bits = (long long)(1023 + (int)fl) << 52;
    const double inv = e * __builtin_bit_cast(double, bits);
    const double ang = (double)pos * inv;
    const double kq = __builtin_rint(ang * 0.6366197723675814);
    double r = __builtin_fma(-kq, 1.5707963267948966, ang); r = __builtin_fma(-kq, 6.123233995736766e-17, r);
    const double r2 = r * r;
    double sp = r * (1.0 + r2 * (-1.0 / 6 + r2 * (1.0 / 120 + r2 * (-1.0 / 5040 + r2 * (1.0 / 362880 + r2 * (-1.0 / 39916800 + r2 * (1.0 / 6227020800.0)))))));
    double cp = 1.0 + r2 * (-0.5 + r2 * (1.0 / 24 + r2 * (-1.0 / 720 + r2 * (1.0 / 40320 + r2 * (-1.0 / 3628800 + r2 * (1.0 / 479001600.0))))));
    const int q = (int)((long long)kq & 3);
    double sv = (q == 0) ? sp : (q == 1) ? cp : (q == 2) ? -sp : -cp;
    double cv = (q == 0) ? cp : (q == 1) ? -sp : (q == 2) ? -cp : sp;
    c = (float)cv; s = (float)sv;
}

__device__ __forceinline__ float gelu_erf(float v) {
    const float av = __builtin_fabsf(v), d = av * 0.2316418882f + 1.0f, t = __builtin_amdgcn_rcpf(d);
    float q = t * 0.5307027145f + (-0.7265760135f); q = q * t + 0.7107068705f; q = q * t + (-0.142248368f); q = q * t + 0.127414796f; q = q * t;
    const float e = __builtin_amdgcn_exp2f((v * v) * (-0.72134752044f));
    const float m = v * (q * e), r = v - m;
    return v < 0.f ? m : r;
}

__device__ __forceinline__ void ln_phase(const float* x0, const float* x1, const bf16_t* Y, float* Xo, bf16_t* XBo, const float* g, const float* b, int gw, int NGW, int lane, bool wb = true) {
    f32x4 gg[4], bb[4];
#pragma unroll
    for (int j = 0; j < 4; ++j) { gg[j] = *((const f32x4*)g + lane + 64 * j); bb[j] = *((const f32x4*)b + lane + 64 * j); }
    f32x4 cx[4]; u32x2 cy[4];
#define LN_LOAD(r, vx, vy) do { const float* src_ = (r) < TP ? x0 + (size_t)(r) * DM : x1 + (size_t)((r) - TP) * DM; \
        _Pragma("unroll") for (int j = 0; j < 4; ++j) { vx[j] = *((const f32x4*)src_ + lane + 64 * j); vy[j] = *((const u32x2*)(Y + (size_t)(r) * DM) + lane + 64 * j); } } while (0)
    if (gw < T) LN_LOAD(gw, cx, cy);
    for (int r = gw; r < T; r += NGW) {
        f32x4 nx[4] = {}; u32x2 ny[4] = {};
        const int rn = r + NGW;
        if (rn < T) LN_LOAD(rn, nx, ny);
        f32x4 v[4]; float s = 0.f;
#pragma unroll
        for (int j = 0; j < 4; ++j) {
            const f32x4 yf = {__uint_as_float(cy[j].x << 16), __uint_as_float(cy[j].x & 0xffff0000u), __uint_as_float(cy[j].y << 16), __uint_as_float(cy[j].y & 0xffff0000u)};
            v[j] = cx[j] * ALPHA + yf; s += (v[j].x + v[j].y) + (v[j].z + v[j].w);
        }
        const float mean = wave_sum(s, lane) * (1.f / DM); float s2 = 0.f;
#pragma unroll
        for (int j = 0; j < 4; ++j) { v[j] = v[j] - mean; s2 += (v[j].x * v[j].x + v[j].y * v[j].y) + (v[j].z * v[j].z + v[j].w * v[j].w); }
        const float rstd = 1.f / sqrtf(wave_sum(s2, lane) * (1.f / DM) + LN_EPS);
#pragma unroll
        for (int j = 0; j < 4; ++j) {
            const f32x4 o = v[j] * rstd * gg[j] + bb[j];
            *((f32x4*)(Xo + (size_t)r * DM) + lane + 64 * j) = o;
            if (wb) { u32x2 w; w.x = cvt_pk_bf16(o.x, o.y); w.y = cvt_pk_bf16(o.z, o.w); *((u32x2*)(XBo + (size_t)r * DM) + lane + 64 * j) = w; }
        }
#pragma unroll
        for (int j = 0; j < 4; ++j) { cx[j] = nx[j]; cy[j] = ny[j]; }
    }
#undef LN_LOAD
}

__device__ __forceinline__ s16x4 tr_read(unsigned addr) { s16x4 r; asm volatile("ds_read_b64_tr_b16 %0, %1" : "=&v"(r) : "v"(addr) : "memory"); return r; }
#define MFMA32(a, b, c) __builtin_amdgcn_mfma_f32_32x32x16_bf16(a, b, c, 0, 0, 0)
__device__ __forceinline__ float xhalf_max(float v) { auto rr = __builtin_amdgcn_permlane32_swap(__float_as_uint(v), __float_as_uint(v), false, false); return fmaxf(__uint_as_float(rr[0]), __uint_as_float(rr[1])); }
__device__ __forceinline__ float xhalf_sum(float v) { auto rr = __builtin_amdgcn_permlane32_swap(__float_as_uint(v), __float_as_uint(v), false, false); return __uint_as_float(rr[0]) + __uint_as_float(rr[1]); }
__device__ __forceinline__ float max3(float a, float b, float c) { float r; asm("v_max3_f32 %0, %1, %2, %3" : "=v"(r) : "v"(a), "v"(b), "v"(c)); return r; }
__device__ __forceinline__ bf16x8 pack_p(const f32x16& p, int j2) {
    u32x4 w; w.x = cvt_pk_bf16(p[8 * j2 + 0], p[8 * j2 + 1]); w.y = cvt_pk_bf16(p[8 * j2 + 2], p[8 * j2 + 3]); w.z = cvt_pk_bf16(p[8 * j2 + 4], p[8 * j2 + 5]); w.w = cvt_pk_bf16(p[8 * j2 + 6], p[8 * j2 + 7]);
    return __builtin_bit_cast(bf16x8, w);
}
__device__ __forceinline__ void pv_tile(f32x16& o, unsigned vaddr, const bf16x8 (&pb)[4]) {
    s16x4 lo[4], hi[4];
#pragma unroll
    for (int k = 0; k < 4; ++k) { lo[k] = tr_read(vaddr + (16 * k) * 64); hi[k] = tr_read(vaddr + (16 * k + 8) * 64); }
    asm volatile("s_waitcnt lgkmcnt(0)" ::: "memory"); __builtin_amdgcn_sched_barrier(0);
#pragma unroll
    for (int k = 0; k < 4; ++k) { const bf16x8 a = (bf16x8){lo[k][0], lo[k][1], lo[k][2], lo[k][3], hi[k][0], hi[k][1], hi[k][2], hi[k][3]}; o = MFMA32(a, pb[k], o); }
}

__device__ __forceinline__ void pv_issue(unsigned vaddr, s16x4 (&lo)[4], s16x4 (&hi)[4]) {
#pragma unroll
    for (int k = 0; k < 4; ++k) { lo[k] = tr_read(vaddr + (16 * k) * 64); hi[k] = tr_read(vaddr + (16 * k + 8) * 64); }
}
__device__ __forceinline__ void pv_mma(f32x16& o, const s16x4 (&lo)[4], const s16x4 (&hi)[4], const bf16x8 (&pb)[4]) {
#pragma unroll
    for (int k = 0; k < 4; ++k) { const bf16x8 a = (bf16x8){lo[k][0], lo[k][1], lo[k][2], lo[k][3], hi[k][0], hi[k][1], hi[k][2], hi[k][3]}; o = MFMA32(a, pb[k], o); }
}
#define MLA_QK_(cur) { const LAS unsigned char* Kb_ = lds + cur * KBUF; s0 = (f32x16){}; s1 = (f32x16){}; \
            _Pragma("unroll") \
            for (int ks = 0; ks < 6; ++ks) { \
                const bf16x8 a0 = *(const LAS bf16x8*)(Kb_ + r32 * 208 + ks * 32 + hi * 16), a1 = *(const LAS bf16x8*)(Kb_ + (32 + r32) * 208 + ks * 32 + hi * 16); \
                s0 = MFMA32(a0, qf[ks], s0); s1 = MFMA32(a1, qf[ks], s1); \
            } }
#define MLA_ROWMAX_() \
            float pa = max3(s0[0], s0[1], s0[2]), pc = max3(s1[0], s1[1], s1[2]); \
            _Pragma("unroll") \
            for (int r = 3; r < 15; r += 2) { pa = max3(pa, s0[r], s0[r + 1]); pc = max3(pc, s1[r], s1[r + 1]); } \
            float pmax = max3(pa, pc, fmaxf(s0[15], s1[15])); \
            pmax = xhalf_max(pmax)
#define MLA_EXPSUM_() { \
            f32x2 ps2 = {0.f, 0.f}; \
            _Pragma("unroll") \
            for (int r = 0; r < 16; ++r) { s0[r] = __builtin_amdgcn_exp2f(s0[r]); s1[r] = __builtin_amdgcn_exp2f(s1[r]); } \
            _Pragma("unroll") \
            for (int r = 0; r < 16; r += 2) { ps2 += (f32x2){s0[r], s0[r + 1]}; ps2 += (f32x2){s1[r], s1[r + 1]}; } \
            ps = ps2.x + ps2.y; }
#define MLA_COMPUTE(cur) { \
            f32x16 s0, s1; float ps; \
            MLA_QK_(cur) \
            const unsigned va = trb + cur * VBUF; \
            s16x4 vl0[4], vh0[4]; \
            pv_issue(va, vl0, vh0);    \
            if (slow || j == 0) { \
                MLA_ROWMAX_(); \
                if (__any(pmax - m > (slow ? 8.f : 64.f)) || (j == 0 && __any(pmax < -32.f))) { \
                    const float mn = (j == 0) ? pmax : fmaxf(m, pmax), alpha = (j == 0) ? 1.f : __builtin_amdgcn_exp2f(m - mn); \
                    m = mn; l *= alpha; slow = true; \
                    _Pragma("unroll") \
                    for (int r = 0; r < 16; ++r) { o0[r] *= alpha; o1[r] *= alpha; } \
                } \
                if (slow) { \
                    _Pragma("unroll") \
                    for (int r = 0; r < 16; ++r) { s0[r] -= m; s1[r] -= m; } \
                } \
            } \
            MLA_EXPSUM_() \
            if (!slow && __any(!(ps < 1e30f))) {     \
                MLA_QK_(cur) \
                MLA_ROWMAX_(); \
                const float mn = fmaxf(m, pmax), alpha = __builtin_amdgcn_exp2f(m - mn); \
                m = mn; l *= alpha; slow = true; \
                _Pragma("unroll") \
                for (int r = 0; r < 16; ++r) { o0[r] *= alpha; o1[r] *= alpha; s0[r] -= m; s1[r] -= m; } \
                MLA_EXPSUM_() \
            } \
            l += ps; \
            bf16x8 pb[4]; \
            pb[0] = pack_p(s0, 0); pb[1] = pack_p(s0, 1); pb[2] = pack_p(s1, 0); pb[3] = pack_p(s1, 1); \
            asm volatile("s_waitcnt lgkmcnt(0)" ::: "memory"); __builtin_amdgcn_sched_barrier(0); \
            pv_mma(o0, vl0, vh0, pb); pv_tile(o1, va + 4096, pb); \
            }
__device__ __forceinline__ void attn_mla_phase(LAS unsigned char* lds, const bf16_t* QB, const bf16_t* KV, const bf16_t* KRR, bf16_t* O, int G, int bx) {
    constexpr int KBUF = 64 * 208, VBUF = 8192, VOFF = 2 * KBUF;
    int tid_ = threadIdx.x; asm volatile("" : "+v"(tid_));
    const int tid = tid_, wid = __builtin_amdgcn_readfirstlane(tid >> 6), lane = tid & 63, r32 = lane & 31, hi = lane >> 5;
    const bool xs = (G % 8) == 0;
    const int nslots = xs ? G / 8 : G, slot = xs ? bx / 8 : bx, xcd = xs ? bx % 8 : 0, npx = xs ? 16 : 128;
    const int nent = npx * 40;
    const int skey = tid >> 3, sch = tid & 7, rkey = tid >> 2, rch = tid & 3;
    const int kdst = skey * 208 + sch * 16, rdst = rkey * 208 + 128 + rch * 16, vdst = (sch >> 2) * 4096 + skey * 64 + (sch & 3) * 16;
    const unsigned trb = (unsigned)(size_t)(lds + VOFF) + (unsigned)((4 * hi + ((lane & 15) >> 2)) * 64 + 32 * ((lane >> 4) & 1) + 8 * (lane & 3));
#define MLA_DEC(LI, P) int P##pair, P##qb, P##base, P##S; \
        if ((LI) < npx * 32) { P##pair = xs ? ((LI) >> 5) * 8 + xcd : ((LI) >> 5); P##qb = (LI) & 31; P##base = (P##pair >> 4) * 8192; P##S = 8192; } \
        else { const int l2_ = (LI) - npx * 32; P##pair = xs ? (l2_ >> 3) * 8 + xcd : (l2_ >> 3); P##qb = l2_ & 7; P##base = TP + (P##pair >> 4) * 2048; P##S = 2048; } \
        const int P##h = P##pair & 15; \
        const size_t P##qrow = (size_t)P##base + P##qb * 256 + wid * 32 + r32; \
        const bf16_t* P##qsrc = QB + P##qrow * NQ + P##h * 96 + hi * 8; \
        const bf16_t* P##kn = KV + (size_t)(P##base + skey) * NKV + P##h * 128 + sch * 8; \
        const bf16_t* P##kr = KRR + (size_t)(P##base + rkey) * 32 + rch * 8
    int li = slot;
    if (li >= nent) return;
    bf16x8 qf[6]; bf16x8 ska, sva, sra = {}, skb, svb, srb = {};
    {
        MLA_DEC(li, f_);
#pragma unroll
        for (int ks = 0; ks < 6; ++ks) qf[ks] = *(const bf16x8*)(f_qsrc + ks * 16);
        ska = *(const bf16x8*)f_kn; sva = *(const bf16x8*)(f_kn + 64); if (tid < 256) sra = *(const bf16x8*)f_kr;
        *(LAS bf16x8*)(lds + kdst) = ska; *(LAS bf16x8*)(lds + VOFF + vdst) = sva; if (tid < 256) *(LAS bf16x8*)(lds + rdst) = sra;
        ska = *(const bf16x8*)(f_kn + (size_t)64 * NKV); sva = *(const bf16x8*)(f_kn + (size_t)64 * NKV + 64); if (tid < 256) sra = *(const bf16x8*)(f_kr + 64 * 32);
    }
    __syncthreads();
    for (;;) {
        MLA_DEC(li, c_);
        const int lin = li + nslots; const bool hasn = lin < nent;
        MLA_DEC(hasn ? lin : li, n_);
        const int h = c_h; const size_t qrow = c_qrow;
        f32x16 o0 = {}, o1 = {}; float m = 0.f, l = 0.f; bool slow = false;
        const int NT = c_S / 64;
        const bf16_t* kn_src = c_kn; const bf16_t* kr_src = c_kr;
#define MLA_STEP(cur, SKL, SVL, SRL, SKW, SVW, SRW) { \
            { const bool own_ = j + 2 < NT; const size_t off = (size_t)(own_ ? j + 2 : j + 2 - NT) * 64; const bf16_t* kn_ = own_ ? kn_src : n_kn; const bf16_t* kr_ = own_ ? kr_src : n_kr; \
              SKL = *(const bf16x8*)(kn_ + off * NKV); SVL = *(const bf16x8*)(kn_ + off * NKV + 64); if (tid < 256) SRL = *(const bf16x8*)(kr_ + off * 32); } \
            MLA_COMPUTE(cur) \
            *(LAS bf16x8*)(lds + ((cur) ^ 1) * KBUF + kdst) = SKW; *(LAS bf16x8*)(lds + VOFF + ((cur) ^ 1) * VBUF + vdst) = SVW; if (tid < 256) *(LAS bf16x8*)(lds + ((cur) ^ 1) * KBUF + rdst) = SRW; \
            __syncthreads(); ++j; }
        for (int j = 0; j < NT;) {
            MLA_STEP(0, skb, svb, srb, ska, sva, sra)
            MLA_STEP(1, ska, sva, sra, skb, svb, srb)
        }
#undef MLA_STEP
        if (hasn) {
#pragma unroll
            for (int ks = 0; ks < 6; ++ks) qf[ks] = *(const bf16x8*)(n_qsrc + ks * 16);
        }
        l = xhalf_sum(l);
        const float inv = 1.f / l;
        bf16_t* orow = O + qrow * DM + h * 64 + 4 * hi;
#pragma unroll
        for (int g4 = 0; g4 < 4; ++g4) {
            u32x2 w0, w1;
            w0.x = cvt_pk_bf16(o0[4 * g4] * inv, o0[4 * g4 + 1] * inv); w0.y = cvt_pk_bf16(o0[4 * g4 + 2] * inv, o0[4 * g4 + 3] * inv);
            w1.x = cvt_pk_bf16(o1[4 * g4] * inv, o1[4 * g4 + 1] * inv); w1.y = cvt_pk_bf16(o1[4 * g4 + 2] * inv, o1[4 * g4 + 3] * inv);
            *(u32x2*)(orow + 8 * g4) = w0; *(u32x2*)(orow + 32 + 8 * g4) = w1;
        }
        if (!hasn) break;
        li = lin;
    }
#undef MLA_DEC
}

#undef MLA_COMPUTE
#undef MLA_QK_
#undef MLA_ROWMAX_
#undef MLA_EXPSUM_
__device__ __forceinline__ void attn_dil_phase(LAS unsigned char* lds, const bf16_t* QKV, const float* BT, bf16_t* OG, float* LSE, int nseq, int log2S, int G, int bx) {
    constexpr int KBUF = 64 * 272, VBUF = 16384, VOFF = 2 * KBUF, TOFF = VOFF + 2 * VBUF;
    int tid_ = threadIdx.x; asm volatile("" : "+v"(tid_));
    const int tid = tid_, wid = __builtin_amdgcn_readfirstlane(tid >> 6), lane = tid & 63, r32 = lane & 31, hi = lane >> 5;
    const int S = 1 << log2S, nqb = S >> 8, nunits = nseq * 24 * nqb;
    const int key0 = tid >> 4, ch0 = tid & 15;
    const int kdst = key0 * 272 + ch0 * 16, vdst = (ch0 >> 2) * 4096 + key0 * 64 + (ch0 & 3) * 16;
    const unsigned trb = (unsigned)(size_t)(lds + VOFF) + (unsigned)((4 * hi + ((lane & 15) >> 2)) * 64 + 32 * ((lane >> 4) & 1) + 8 * (lane & 3));
    LAS float* tab = (LAS float*)(lds + TOFF);
#define DIL_DEC(uu, P) const int P##qb = (uu) % nqb; int P##rest = (uu) / nqb; const int P##h = P##rest & 7; P##rest >>= 3; const int P##g = P##rest % 3, P##seq = P##rest / 3; \
        const int P##f0 = P##qb * 256, P##rowbase = P##seq << log2S, P##tlo = (P##f0 == 0) ? 1 : 0; \
        const bf16_t* P##qsrc = QKV + ((size_t)P##rowbase + P##f0 + wid * 32 + r32) * NQKV + P##g * 3072 + P##h * 128 + hi * 8; \
        const bf16_t* P##ksrc = QKV + (long)(P##rowbase + P##f0 - 64 + key0) * NQKV + P##g * 3072 + 1024 + P##h * 128 + ch0 * 8; \
        const float* P##tsrc = BT + (P##g * 8 + P##h) * 384 + (tid < 384 ? tid : 0)
#define DIL_TILE(src, t) do { const bf16_t* p_ = (src) + (size_t)((t) * 64) * NQKV; k0r = *(const bf16x8*)p_; v0r = *(const bf16x8*)(p_ + 1024); k1r = *(const bf16x8*)(p_ + (size_t)32 * NQKV); v1r = *(const bf16x8*)(p_ + (size_t)32 * NQKV + 1024); } while (0)
    bf16x8 qn[8] = {}, k0r = {}, k1r = {}, v0r = {}, v1r = {}; float tabv = 0.f;
    if (bx < nunits) {
        DIL_DEC(bx, a_);
#pragma unroll
        for (int ks = 0; ks < 8; ++ks) qn[ks] = *(const bf16x8*)(a_qsrc + ks * 16);
        DIL_TILE(a_ksrc, a_tlo); tabv = *a_tsrc;
    }
    for (int u = bx; u < nunits; u += G) {
        DIL_DEC(u, c_);
        const int h = c_h, g = c_g, f0 = c_f0, rowbase = c_rowbase, tlo = c_tlo;
        const int sh = 2 * g, log2L = log2S - sh;
        bf16x8 qf[8];
#pragma unroll
        for (int ks = 0; ks < 8; ++ks) qf[ks] = qn[ks];
        if (tid < 384) tab[tid] = tabv;
        f32x16 o[4] = {}; float m = -1e30f, l = 0.f;
        const int thi = (f0 + 256 >= S) ? 4 : 5;
        const int wt0 = wid >> 1, myblk = (f0 + 32 * wid) >> log2L;
        const bf16_t* ksrc = c_ksrc;
        const int tbase = 128 - 32 * wid - r32 + 4 * hi;
        *(LAS bf16x8*)(lds + kdst) = k0r; *(LAS bf16x8*)(lds + kdst + 32 * 272) = k1r; *(LAS bf16x8*)(lds + VOFF + vdst) = v0r; *(LAS bf16x8*)(lds + VOFF + vdst + 32 * 64) = v1r;
        const int un = u + G; const bool hasn = un < nunits;
        DIL_DEC(hasn ? un : u, n_);
        if (hasn) {
#pragma unroll
            for (int ks = 0; ks < 8; ++ks) qn[ks] = *(const bf16x8*)(n_qsrc + ks * 16);
            tabv = *n_tsrc;
        }
        __syncthreads();
        for (int t = tlo; t <= thi; ++t) {
            const int cur = (t - tlo) & 1;
            if (t < thi) DIL_TILE(ksrc, t + 1); else if (hasn) DIL_TILE(n_ksrc, n_tlo);
            const int fk0 = f0 - 64 + 64 * t;
            if (t >= wt0 && t <= wt0 + 2 && (fk0 >> log2L) == myblk) {
                const LAS unsigned char* Kb = lds + cur * KBUF;
                f32x16 s0 = {}, s1 = {};
#pragma unroll
                for (int ks = 0; ks < 8; ++ks) {
                    const bf16x8 a0 = *(const LAS bf16x8*)(Kb + r32 * 272 + ks * 32 + hi * 16), a1 = *(const LAS bf16x8*)(Kb + (32 + r32) * 272 + ks * 32 + hi * 16);
                    s0 = MFMA32(a0, qf[ks], s0); s1 = MFMA32(a1, qf[ks], s1);
                }
                const LAS float* tb = tab + tbase + 64 * t;
#pragma unroll
                for (int r = 0; r < 16; ++r) { s0[r] += tb[(r & 3) + 8 * (r >> 2)]; s1[r] += tb[32 + (r & 3) + 8 * (r >> 2)]; }
                float pmax = s0[0];
#pragma unroll
                for (int r = 1; r < 16; ++r) pmax = fmaxf(pmax, s0[r]);
#pragma unroll
                for (int r = 0; r < 16; ++r) pmax = fmaxf(pmax, s1[r]);
                pmax = xhalf_max(pmax);
                if (__any(pmax > m + 8.f)) {
                    const float mn = fmaxf(m, pmax), alpha = __builtin_amdgcn_exp2f(m - mn);
                    m = mn; l *= alpha;
#pragma unroll
                    for (int d = 0; d < 4; ++d)
#pragma unroll
                        for (int r = 0; r < 16; ++r) o[d][r] *= alpha;
                }
                float ps = 0.f;
#pragma unroll
                for (int r = 0; r < 16; ++r) { s0[r] = __builtin_amdgcn_exp2f(s0[r] - m); s1[r] = __builtin_amdgcn_exp2f(s1[r] - m); ps += s0[r] + s1[r]; }
                l += ps;
                bf16x8 pb[4];
                pb[0] = pack_p(s0, 0); pb[1] = pack_p(s0, 1); pb[2] = pack_p(s1, 0); pb[3] = pack_p(s1, 1);
                const unsigned va = trb + cur * VBUF;
                pv_tile(o[0], va, pb); pv_tile(o[1], va + 4096, pb); pv_tile(o[2], va + 8192, pb); pv_tile(o[3], va + 12288, pb);
            }
            if (t < thi) {
                const int nb = cur ^ 1;
                *(LAS bf16x8*)(lds + nb * KBUF + kdst) = k0r; *(LAS bf16x8*)(lds + nb * KBUF + kdst + 32 * 272) = k1r;
                *(LAS bf16x8*)(lds + VOFF + nb * VBUF + vdst) = v0r; *(LAS bf16x8*)(lds + VOFF + nb * VBUF + vdst + 32 * 64) = v1r;
            }
            __syncthreads();
        }
        l = xhalf_sum(l);
        const float inv = 1.f / l;
        const int f = f0 + wid * 32 + r32, stok = ((f & ((1 << log2L) - 1)) << sh) + (f >> log2L);
        const size_t orow = (size_t)rowbase + stok;
        bf16_t* op = OG + ((size_t)g * CHUNK + orow) * DM + h * 128 + 4 * hi;
#pragma unroll
        for (int d = 0; d < 4; ++d)
#pragma unroll
            for (int g4 = 0; g4 < 4; ++g4) {
                u32x2 w; w.x = cvt_pk_bf16(o[d][4 * g4] * inv, o[d][4 * g4 + 1] * inv); w.y = cvt_pk_bf16(o[d][4 * g4 + 2] * inv, o[d][4 * g4 + 3] * inv);
                *(u32x2*)(op + 32 * d + 8 * g4) = w;
            }
        if (hi == 0) LSE[((size_t)g * CHUNK + orow) * 8 + h] = m + __log2f(l);
    }
}
#undef DIL_DEC
#undef DIL_TILE

#define XB_TMO      128
#define XB_XCNT(j)  (256  + 64 * (j))
#define XB_XSUB(j)  (1280 + 64 * (j))
#define XB_XGEN(j)  (2304 + 64 * (j))
#define XB_TOP      3328
#define XB_TOPGEN   3392
#define XCD_BAR_WORDS 3456
#define XB_SPIN_CAP (1u << 18)

__device__ __forceinline__ unsigned xb_ld(unsigned* p)              { return __hip_atomic_load(p, __ATOMIC_RELAXED, __HIP_MEMORY_SCOPE_AGENT); }
__device__ __forceinline__ unsigned xb_add(unsigned* p, unsigned v) { return __hip_atomic_fetch_add(p, v, __ATOMIC_RELAXED, __HIP_MEMORY_SCOPE_AGENT); }
__device__ __forceinline__ unsigned xb_xcc_id() { return (unsigned)__builtin_amdgcn_s_getreg((3 << 11) | 20) & 0xFu; }
#define XB_SPIN(cond, bar) do { unsigned _sp = 0; while (cond) { __builtin_amdgcn_s_sleep(1); \
    if ((++_sp & 255u) == 0u) { if (xb_ld(&(bar)[XB_TMO])) break; if (_sp > XB_SPIN_CAP) { atomicAdd(&(bar)[XB_TMO], 1u); break; } } } } while (0)

struct XcdBarrier {
    unsigned* bar; unsigned x;
    volatile LAS unsigned* st;
};

__device__ __forceinline__ XcdBarrier xcd_barrier_post(unsigned* bar, volatile LAS unsigned* st) {
    XcdBarrier b; b.bar = bar; b.x = xb_xcc_id(); b.st = st;
    if (threadIdx.x == 0) (void)xb_add(&bar[XB_XCNT(b.x)], 1u);
    return b;
}
__device__ __forceinline__ void xcd_barrier_complete(unsigned* bar, unsigned x, unsigned& nloc, unsigned& nx) {
    const unsigned G = gridDim.x * gridDim.y * gridDim.z;
    unsigned sum, cnt, mine, sp = 0u;
    for (;;) {
        sum = 0u; cnt = 0u; mine = 0u;
#pragma unroll
        for (unsigned j = 0; j < 16; ++j) { const unsigned c = xb_ld(&bar[XB_XCNT(j)]); sum += c; cnt += (c > 0u) ? 1u : 0u; mine = (j == x) ? c : mine; }
        if (sum == G) break;
        __builtin_amdgcn_s_sleep(1);
        if ((++sp & 255u) == 0u) { if (xb_ld(&bar[XB_TMO])) break; if (sp > XB_SPIN_CAP) { atomicAdd(&bar[XB_TMO], 1u); break; } }
    }
    nloc = mine > 0u ? mine : 1u; nx = cnt > 0u ? cnt : 1u;
}

__device__ __forceinline__ void xcd_barrier(const XcdBarrier& b) {
    asm volatile("s_waitcnt vmcnt(0)" ::: "memory");
    __syncthreads();
    if (threadIdx.x == 0) {
        unsigned* bar = b.bar;
        __builtin_amdgcn_s_waitcnt(0);
        unsigned nloc = b.st[0], nx = b.st[1];
        if (nloc == 0u) { xcd_barrier_complete(bar, b.x, nloc, nx); b.st[0] = nloc; b.st[1] = nx; }
        const unsigned old = xb_add(&bar[XB_XSUB(b.x)], 1u);
        const unsigned gen = old / nloc;
        if (old + 1u == (gen + 1u) * nloc) {
            __builtin_amdgcn_fence(__ATOMIC_RELEASE, "agent");
            asm volatile("s_waitcnt vmcnt(0)" ::: "memory");
            const unsigned og = xb_add(&bar[XB_TOP], 1u);
            const unsigned tg = og / nx;
            if (og + 1u == (tg + 1u) * nx) xb_add(&bar[XB_TOPGEN], 1u);
            else XB_SPIN(xb_ld(&bar[XB_TOPGEN]) == tg, bar);
            __builtin_amdgcn_fence(__ATOMIC_ACQUIRE, "agent");
            xb_add(&bar[XB_XGEN(b.x)], 1u);
            asm volatile("s_waitcnt vmcnt(0)" ::: "memory");
        } else {
            XB_SPIN(xb_ld(&bar[XB_XGEN(b.x)]) == gen, bar);
            __builtin_amdgcn_fence(__ATOMIC_ACQUIRE, "agent");
            asm volatile("s_waitcnt vmcnt(0)" ::: "memory");
        }
    }
    __syncthreads();
}

__global__ void __launch_bounds__(512, 2) mega_fwd(Params p) {
    extern __shared__ __attribute__((aligned(16))) unsigned char lds_raw[];
    LAS unsigned char* lds = (LAS unsigned char*)lds_raw;
    const int G0 = gridDim.x, bx0 = blockIdx.x;
#define PH_LOCALS PH_WS; int tid = threadIdx.x; asm volatile("" : "+v"(tid)); const int lane = tid & 63, wave = __builtin_amdgcn_readfirstlane(tid >> 6), gw = bx * 8 + wave; (void)lane; (void)gw
#define PH_WS const __attribute__((address_space(4))) Params* kp = (const __attribute__((address_space(4))) Params*)__builtin_amdgcn_kernarg_segment_ptr(); asm volatile("" : "+s"(kp)); \
        unsigned char* ws = kp->ws; float* X = kp->out; (void)X; int G = G0, bx = bx0; asm volatile("" : "+s"(G), "+s"(bx)); const int NGW = G * 8; (void)NGW
#define XB ((bf16_t*)(ws + WS_XB))
#define OB ((bf16_t*)(ws + WS_O))
#define cosT ((float*)(ws + WS_COS))
#define sinT ((float*)(ws + WS_SIN))
#define BT ((float*)(ws + WS_BT))
#define RQ ((float*)(ws + WS_RQ))
#define RKV ((float*)(ws + WS_RKV))
#define WQKV ((bf16_t*)(ws + WS_WQKV))
#define WOA ((bf16_t*)(ws + WS_WOA))
#define WDKV ((bf16_t*)(ws + WS_WDKV))
#define WUQ ((bf16_t*)(ws + WS_WUQ))
#define WUKV ((bf16_t*)(ws + WS_WUKV))
#define WOB ((bf16_t*)(ws + WS_WOB))
#define WIN ((bf16_t*)(ws + WS_WIN))
#define WOUT ((bf16_t*)(ws + WS_WOUT))
#define QKV ((bf16_t*)(ws + WS_QKV))
#define OG ((bf16_t*)(ws + WS_OG))
#define LSE ((float*)(ws + WS_LSE))
#define CB ((bf16_t*)(ws + WS_C))
#define QB ((bf16_t*)(ws + WS_QB))
#define KVB ((bf16_t*)(ws + WS_KV))
#define KRR ((bf16_t*)(ws + WS_KRR))
#define UB ((bf16_t*)(ws + WS_U))
#define Y1B ((bf16_t*)(ws + WS_S))
#define Y2B ((bf16_t*)(ws + WS_Y2))
#define HB ((bf16_t*)(ws + WS_H))
    cg::grid_group grid = cg::this_grid();
    volatile LAS unsigned* bst = (volatile LAS unsigned*)(lds + LDS_BYTES - 64);
    if (threadIdx.x == 0) { bst[0] = 0u; bst[1] = 0u; }
    __syncthreads();
    const XcdBarrier xbar = xcd_barrier_post((unsigned*)(p.ws + WS_CTL), bst);
    int ph = 0;
    const int lo = p.ph_lo, hi = p.ph_hi;
#define PH_ON (ph >= lo && ph < hi)
#ifndef MK_EN
#define MK_EN 0xffffffffu
#endif
#define EN(k) (((MK_EN) >> (k)) & 1u)
#ifndef MK_REP
#define MK_REP 0u
#endif
#define REPN(k) ((((MK_REP) >> (k)) & 1u) != 0)
#define REPN(k) ((((MK_REP) >> (k)) & 1u) != 0)
#define REP(k) for (int rep_ = 0; rep_ < ((((MK_REP) >> (k)) & 1u) ? 2 : 1); ++rep_)
#define PH_END do { if (ph >= lo && ph + 1 < hi) { if (lo < 0) grid.sync(); else xcd_barrier(xbar); } ++ph; } while (0)

    if (EN(0) && PH_ON) REP(0) {
        PH_LOCALS;
        LAS float* scr = (LAS float*)(lds + wave * 16384);
        constexpr int I_QKV = (DM / 64) * (NQKV / 32), I_O = (DM / 64) * (DM / 32), I_DKV = (DM / 64) * (672 / 32), I_UQ = (NCQ / 64) * (NQ / 32), I_UKV = (NCKV / 64) * (NKV / 32);
        constexpr int I_IN = (DM / 64) * (NFF / 32), I_OUT = (DFF / 64) * (DM / 32);
        constexpr int NITEMS = I_QKV + 2 * I_O + I_DKV + I_UQ + I_UKV + 2 * I_IN + 2 * I_OUT;
        for (int it = gw; it < NITEMS; it += NGW) {
            int r = it;
            if (r < I_QKV) { transpose_item(kp->w_qkv_a, DM, NQKV, WQKV, 0, nullptr, scr, r, lane); continue; } r -= I_QKV;
            if (r < I_O) { transpose_item(kp->w_o_a, DM, DM, WOA, 0, nullptr, scr, r, lane); continue; } r -= I_O;
            if (r < I_O) { transpose_item(kp->w_o_b, DM, DM, WOB, 0, nullptr, scr, r, lane); continue; } r -= I_O;
            if (r < I_DKV) { transpose_item(kp->w_dkv_b, DM, 672, WDKV, 2, nullptr, scr, r, lane); continue; } r -= I_DKV;
            if (r < I_UQ) { transpose_item(kp->w_uq_b, NCQ, NQ, WUQ, 1, kp->g_q_b, scr, r, lane); continue; } r -= I_UQ;
            if (r < I_UKV) { transpose_item(kp->w_ukv_b, NCKV, NKV, WUKV, 0, kp->g_kv_b, scr, r, lane); continue; } r -= I_UKV;
            if (r < 2 * I_IN) { const int ly = r / I_IN; transpose_item(kp->ffn_w_in + (size_t)ly * DM * NFF, DM, NFF, WIN + (size_t)ly * NFF * DM, 0, nullptr, scr, r - ly * I_IN, lane); continue; } r -= 2 * I_IN;
            { const int ly = r / I_OUT; transpose_item(kp->ffn_w_out + (size_t)ly * DFF * DM, DFF, DM, WOUT + (size_t)ly * DM * DFF, 0, nullptr, scr, r - ly * I_OUT, lane); }
        }
        for (int i = bx * 512 + tid; i < 96 * DM / 8; i += G * 512) *((u32x4*)(WDKV + (size_t)672 * DM) + i) = (u32x4){0u, 0u, 0u, 0u};
        for (int r = gw; r < T; r += 2 * NGW) {
            const int r2 = r + NGW; const bool h2 = r2 < T;
            const float* src = r < TP ? kp->x_prompt + (size_t)r * DM : kp->x_sample + (size_t)(r - TP) * DM;
            const float* src2 = r2 < TP ? kp->x_prompt + (size_t)r2 * DM : kp->x_sample + (size_t)((h2 ? r2 : r) - TP) * DM;
            f32x4 va[4], vb[4] = {};
#pragma unroll
            for (int j = 0; j < 4; ++j) { va[j] = *((const f32x4*)src + lane + 64 * j); if (h2) vb[j] = *((const f32x4*)src2 + lane + 64 * j); }
#pragma unroll
            for (int j = 0; j < 4; ++j) {
                u32x2 w; w.x = cvt_pk_bf16(va[j].x, va[j].y); w.y = cvt_pk_bf16(va[j].z, va[j].w);
                *((u32x2*)(XB + (size_t)r * DM) + lane + 64 * j) = w;
                if (h2) { u32x2 w2; w2.x = cvt_pk_bf16(vb[j].x, vb[j].y); w2.y = cvt_pk_bf16(vb[j].z, vb[j].w); *((u32x2*)(XB + (size_t)r2 * DM) + lane + 64 * j) = w2; }
            }
        }
        for (int i = bx * 512 + tid; i < 8192 * 16; i += G * 512) { float c, s; rope_entry(i >> 4, i & 15, c, s); cosT[i] = c; sinT[i] = s; }
        for (int i = bx * 512 + tid; i < 24 * 384; i += G * 512) {
            const int gh = i / 384, d = i % 384 - 192, g = gh >> 3;
            float v = -1e30f;
            if (d >= -64 && d <= 64) v = kp->rel_bias[t5_bucket(d * (1 << (2 * g))) * 24 + gh] * LOG2E;
            BT[i] = v;
        }
    }
    PH_END;

    {
        for (int c = 0; c < NCHUNK; ++c) {
            const int row0 = c * CHUNK, log2S = c < 4 ? 13 : 11, nseq = c < 4 ? 2 : 8;
            if (EN(1) && PH_ON) REP(1) {
                PH_WS;
                pg8::Gemm g{XB + (size_t)row0 * DM, WQKV, CHUNK, NQKV, DM, DM}; pg8::StaticOrder S; S.init(CHUNK, NQKV, G, bx);
                pg8::EpiQKV E{QKV, log2S, 0.08838834764831845f * LOG2E};
                pg8::gemm_phase<pg8::EpiQKV, pg8::StaticOrder>(lds, g, S, E);
            }
            PH_END;
            if (EN(2) && PH_ON) REP(2) { PH_WS; attn_dil_phase(lds, QKV, BT, OG, LSE, nseq, log2S, G, bx); }
            PH_END;
            if (EN(3) && PH_ON) REP(3) {   PH_LOCALS;
                for (int r = gw; r < CHUNK; r += NGW) {
                    const int h = lane >> 3;
                    const float l0 = LSE[((size_t)0 * CHUNK + r) * 8 + h], l1 = LSE[((size_t)1 * CHUNK + r) * 8 + h], l2 = LSE[((size_t)2 * CHUNK + r) * 8 + h];
                    const float mx = fmaxf(l0, fmaxf(l1, l2));
                    float w0 = __builtin_amdgcn_exp2f(l0 - mx), w1 = __builtin_amdgcn_exp2f(l1 - mx), w2 = __builtin_amdgcn_exp2f(l2 - mx);
                    const float inv = 1.f / (w0 + w1 + w2); w0 *= inv; w1 *= inv; w2 *= inv;
#pragma unroll
                    for (int j = 0; j < 2; ++j) {
                        const bf16x8 a = *((const bf16x8*)(OG + ((size_t)0 * CHUNK + r) * DM) + lane * 2 + j), b = *((const bf16x8*)(OG + ((size_t)1 * CHUNK + r) * DM) + lane * 2 + j),
                                     cc = *((const bf16x8*)(OG + ((size_t)2 * CHUNK + r) * DM) + lane * 2 + j);
                        float v[8];
#pragma unroll
                        for (int e = 0; e < 8; ++e) v[e] = w0 * bf2f((unsigned short)a[e]) + w1 * bf2f((unsigned short)b[e]) + w2 * bf2f((unsigned short)cc[e]);
                        u32x4 w; w.x = cvt_pk_bf16(v[0], v[1]); w.y = cvt_pk_bf16(v[2], v[3]); w.z = cvt_pk_bf16(v[4], v[5]); w.w = cvt_pk_bf16(v[6], v[7]);
                        *((u32x4*)(OB + (size_t)(row0 + r) * DM) + lane * 2 + j) = w;
                    }
                }
            }
            if (c + 1 < NCHUNK && MK_MULTI == 0) ++ph; else PH_END;
        }
    }
    for (int layer = 0; layer < 2; ++layer) {
        if (layer == 1) {
            if (EN(4) && PH_ON) REP(4) {
                PH_WS;
                pg8::Gemm g{XB, WDKV, T, CW, DM, DM}; pg8::StaticOrder S; S.init(T, CW, G, bx);
                pg8::EpiStore E{CB, CW, nullptr, 1.f};
                pg8::gemm_phase<pg8::EpiStore, pg8::StaticOrder>(lds, g, S, E);
            }
            PH_END;
            if (EN(5) && PH_ON) REP(5) {   PH_LOCALS;
                for (int r = gw; r < T; r += NGW) {
                    const bf16_t* crow = CB + (size_t)r * CW;
                    const bf16x8 a = *((const bf16x8*)crow + lane);
                    bf16x8 b = {}; if (lane < 20) b = *((const bf16x8*)crow + 64 + lane);
                    float fa[8], fb[8], sa = 0.f, sb = 0.f;
#pragma unroll
                    for (int e = 0; e < 8; ++e) { fa[e] = bf2f((unsigned short)a[e]); fb[e] = bf2f((unsigned short)b[e]); sa += fa[e] * fa[e]; sb += fb[e] * fb[e]; }
                    const float sq = wave_sum(lane < 48 ? sa : 0.f, lane), skv = wave_sum((lane >= 48 ? sa : 0.f) + (lane < 16 ? sb : 0.f), lane);
                    if (lane == 0) { RQ[r] = 1.f / sqrtf(sq * (1.f / NCQ) + RMS_EPS); RKV[r] = 1.f / sqrtf(skv * (1.f / NCKV) + RMS_EPS); }
                    if (lane >= 16 && lane < 20) {
                        const int j = lane - 16, pos = r < TP ? (r & 8191) : (r & 2047);
                        const f32x4 cs = *(const f32x4*)(cosT + pos * 16 + 4 * j), sn = *(const f32x4*)(sinT + pos * 16 + 4 * j);
                        float o1[4], o2[4];
#pragma unroll
                        for (int e = 0; e < 4; ++e) { o1[e] = fb[e] * cs[e] - fb[4 + e] * sn[e]; o2[e] = fb[e] * sn[e] + fb[4 + e] * cs[e]; }
                        u32x4 w; w.x = cvt_pk_bf16(o1[0], o1[1]); w.y = cvt_pk_bf16(o1[2], o1[3]); w.z = cvt_pk_bf16(o2[0], o2[1]); w.w = cvt_pk_bf16(o2[2], o2[3]);
                        *((u32x4*)(KRR + (size_t)r * 32) + j) = w;
                    }
                }
            }
            PH_END;
            if (EN(6) && PH_ON) REP(6) {
                PH_WS;
                { pg8::Gemm g{CB, WUQ, T, NQ, NCQ, CW}; pg8::StaticOrder S; S.init(T, NQ, G, bx);
                  pg8::EpiQRope E{QB, RQ, 0.10206207261596575f * LOG2E, cosT, sinT};
                  pg8::gemm_phase<pg8::EpiQRope, pg8::StaticOrder>(lds, g, S, E); }
                { pg8::Gemm g{CB + NCQ, WUKV, T, NKV, NCKV, CW}; pg8::StaticOrder S; S.init(T, NKV, G, bx);
                  pg8::EpiStore E{KVB, NKV, RKV, 1.f};
                  pg8::gemm_phase<pg8::EpiStore, pg8::StaticOrder>(lds, g, S, E); }
            }
            PH_END;
            if (EN(7) && PH_ON) REP(7) { PH_WS; attn_mla_phase(lds, QB, KVB, KRR, OB, G, bx); }
            PH_END;
        }
        if (EN(8) && PH_ON) REP(8) {
                PH_WS;
            pg8::Gemm g{OB, layer == 0 ? WOA : WOB, T, DM, DM, DM}; pg8::StaticOrder S; S.init(T, DM, G, bx);
            pg8::EpiStore E{Y1B, DM, nullptr, 1.f};
            pg8::gemm_phase<pg8::EpiStore, pg8::StaticOrder>(lds, g, S, E);
        }
        PH_END;
        if (EN(9) && PH_ON) REP(9) { PH_LOCALS; ln_phase(layer == 0 ? kp->x_prompt : X, layer == 0 ? kp->x_sample : X + (size_t)TP * DM, Y1B, (REPN(9) && rep_ == 0) ? (float*)(ws + 560 * MiB) : X, (REPN(9) && rep_ == 0) ? OB : XB, kp->ln_g + (layer * 2 + 0) * DM, kp->ln_b + (layer * 2 + 0) * DM, gw, NGW, lane); }
        PH_END;
        {
            for (int c = 0; c < 3; ++c) {
                const int row0 = c * 32768, crows = c < 2 ? 32768 : 16384, log2S = c < 2 ? 13 : 11;
                if (EN(10) && PH_ON) REP(10) {
                PH_WS;
                    pg8::Gemm g{XB + (size_t)row0 * DM, WIN + (size_t)layer * NFF * DM, crows, NFF, DM, DM}; pg8::StaticOrder S; S.init(crows, NFF, G, bx);
                    pg8::EpiStore E{HB, NFF, nullptr, 1.f};
                    pg8::gemm_phase<pg8::EpiStore, pg8::StaticOrder>(lds, g, S, E);
                }
                PH_END;
                if (EN(11) && PH_ON) REP(11) {   PH_LOCALS;
                    const float* cw = kp->ffn_conv_w + (size_t)layer * 3 * NFF; const float* cb = kp->ffn_conv_b + (size_t)layer * NFF; const bf16_t* H = HB; bf16_t* U = UB;
                    const int nitems = (crows / 8) * 11, smask = (1 << log2S) - 1;
                    for (int it = gw; it < nitems; it += NGW) {
                        const int rr = it / 11, cgp = it - rr * 11, col = (cgp * 64 + lane) * 4, r0 = rr * 8;
                        u32x2 ra[10], rg[10];
                        const bool hp = (r0 & smask) != 0, hn = ((r0 + 8) & smask) != 0;
#pragma unroll
                        for (int i = 0; i < 10; ++i) {
                            const bool ok = (i == 0) ? hp : (i == 9) ? hn : true;
                            if (ok) { ra[i] = *(const u32x2*)(H + (size_t)(r0 - 1 + i) * NFF + col); rg[i] = *(const u32x2*)(H + (size_t)(r0 - 1 + i) * NFF + DFF + col); }
                            else { ra[i] = (u32x2){0u, 0u}; rg[i] = (u32x2){0u, 0u}; }
                        }
                        f32x4 wa[3], wg[3];
#pragma unroll
                        for (int k = 0; k < 3; ++k) { wa[k] = *(const f32x4*)(cw + k * NFF + col); wg[k] = *(const f32x4*)(cw + k * NFF + DFF + col); }
                        const f32x4 ba = *(const f32x4*)(cb + col), bg = *(const f32x4*)(cb + DFF + col);
#define BF4(u) ((f32x4){__uint_as_float((u).x << 16), __uint_as_float((u).x & 0xffff0000u), __uint_as_float((u).y << 16), __uint_as_float((u).y & 0xffff0000u)})
#pragma unroll
                        for (int i = 0; i < 8; ++i) {
                            const f32x4 av = wa[0] * BF4(ra[i]) + wa[1] * BF4(ra[i + 1]) + wa[2] * BF4(ra[i + 2]) + ba;
                            const f32x4 gv = wg[0] * BF4(rg[i]) + wg[1] * BF4(rg[i + 1]) + wg[2] * BF4(rg[i + 2]) + bg;
                            u32x2 w; w.x = cvt_pk_bf16(av[0] * gelu_erf(gv[0]), av[1] * gelu_erf(gv[1])); w.y = cvt_pk_bf16(av[2] * gelu_erf(gv[2]), av[3] * gelu_erf(gv[3]));
                            *(u32x2*)(U + (size_t)(row0 + r0 + i) * DFF + col) = w;
                        }
#undef BF4
                    }
                }
                PH_END;
            }
            if (EN(12) && PH_ON) REP(12) {
                PH_WS;
                pg8::Gemm g{UB, WOUT + (size_t)layer * DM * DFF, T, DM, DFF, DFF}; pg8::StaticOrder S; S.init(T, DM, G, bx);
                pg8::EpiStore E{Y2B, DM, nullptr, 1.f};
                pg8::gemm_phase<pg8::EpiStore, pg8::StaticOrder>(lds, g, S, E);
            }
            PH_END;
            if (EN(13) && PH_ON) REP(13) { PH_LOCALS; ln_phase(X, X + (size_t)TP * DM, Y2B, (REPN(13) && rep_ == 0) ? (float*)(ws + 222 * MiB) : X, (REPN(13) && rep_ == 0) ? (bf16_t*)(ws + 822 * MiB) : XB, kp->ln_g + (layer * 2 + 1) * DM, kp->ln_b + (layer * 2 + 1) * DM, gw, NGW, lane, layer == 0); }
            PH_END;
        }
    }
#undef PH_ON
#undef PH_END
}
constexpr int N_PHASES = 1 + 15 + 2 * (2 + 8) + 4;

extern "C" void kernel_launch(void* const* d_in, const int* in_sizes, int n_in, void* d_out, int out_size, void* d_ws, size_t ws_size, hipStream_t stream) {
    static int grid = 0;
    if (grid == 0) {
        if (n_in != 17 || out_size != T * DM || ws_size < WS_END) { fprintf(stderr, "kernel_launch: unexpected shapes (n_in %d out %d ws %zu)\n", n_in, out_size, ws_size); grid = -1; return; }
        int dev = 0, cus = 0, per_cu = 0;
        if (hipGetDevice(&dev) != hipSuccess || hipDeviceGetAttribute(&cus, hipDeviceAttributeMultiprocessorCount, dev) != hipSuccess) { grid = -1; return; }
        if (hipFuncSetAttribute((const void*)mega_fwd, hipFuncAttributeMaxDynamicSharedMemorySize, LDS_BYTES) != hipSuccess) { fprintf(stderr, "kernel_launch: hipFuncSetAttribute failed\n"); grid = -1; return; }
        if (hipOccupancyMaxActiveBlocksPerMultiprocessor(&per_cu, (const void*)mega_fwd, 512, LDS_BYTES) != hipSuccess || per_cu < 1) { fprintf(stderr, "kernel_launch: occupancy query says %d\n", per_cu); per_cu = 1; }
        (void)hipGetLastError();
        grid = cus * 1;
    }
    if (grid < 0) return;
    if (hipMemsetAsync((char*)d_ws + WS_CTL, 0, CTL_BYTES, stream) != hipSuccess) { fprintf(stderr, "kernel_launch: memset failed\n"); return; }
    Params p{};
    const float** pp = (const float**)&p;
    for (int i = 0; i < 17; ++i) pp[i] = (const float*)d_in[i];
    p.out = (float*)d_out; p.ws = (unsigned char*)d_ws;
#if MK_MULTI
    for (int k = 0; k < N_PHASES; ++k) { p.ph_lo = k; p.ph_hi = k + 1; hipLaunchKernelGGL(mega_fwd, dim3(grid), dim3(512), LDS_BYTES, stream, p); }
#else
    p.ph_lo = 0; p.ph_hi = N_PHASES;
    void* args[] = {&p};
    hipError_t e = hipLaunchCooperativeKernel((const void*)mega_fwd, dim3(grid), dim3(512), args, LDS_BYTES, stream);
    if (e != hipSuccess) fprintf(stderr, "cooperative launch failed: %s (grid %d)\n", hipGetErrorString(e), grid);
#endif
}
```

```cpp
#include <hip/hip_runtime.h>
#include <hip/hip_cooperative_groups.h>
#include <cstdio>
#include <cstdint>
namespace cg = cooperative_groups;

#ifndef MK_MULTI
#define MK_MULTI 0
#endif

#define LAS __attribute__((address_space(3)))
typedef unsigned short bf16_t;
typedef short bf16x8 __attribute__((ext_vector_type(8)));
typedef short s16x4 __attribute__((ext_vector_type(4)));
typedef float f32x4 __attribute__((ext_vector_type(4)));
typedef float f32x2 __attribute__((ext_vector_type(2)));
typedef float f32x16 __attribute__((ext_vector_type(16)));
typedef unsigned u32x4 __attribute__((ext_vector_type(4)));
typedef unsigned u32x2 __attribute__((ext_vector_type(2)));

constexpr int DM = 1024, TP = 65536, TS = 16384, T = TP + TS;
constexpr int NQKV = 9216, DFF = 2816, NFF = 2 * DFF;
constexpr int CW = 768, NCQ = 384, NCKV = 256, NQ = 1536, NKV = 2048;
constexpr int CHUNK = 16384, NCHUNK = 5;
constexpr float ALPHA = 1.4142135623730951f;
constexpr float LOG2E = 1.4426950408889634f;
constexpr float LN_EPS = 1e-5f, RMS_EPS = 1e-6f;

constexpr size_t MiB = 1u << 20;
constexpr size_t WS_COS = 0, WS_SIN = 512 * 1024, WS_BT = 1 * MiB, WS_RQ = 1 * MiB + 256 * 1024, WS_RKV = 1 * MiB + 640 * 1024;
constexpr size_t WS_WQKV = 2 * MiB, WS_WOA = 20 * MiB, WS_WDKV = 22 * MiB, WS_WUQ = 24 * MiB, WS_WUKV = 25 * MiB + 512 * 1024, WS_WOB = 27 * MiB;
constexpr size_t WS_WIN = 29 * MiB, WS_WOUT = 51 * MiB;
constexpr size_t WS_XB = 62 * MiB, WS_O = 222 * MiB, WS_C = 222 * MiB, WS_S = 382 * MiB;
constexpr size_t WS_QKV = WS_S, WS_OG = WS_S + 288 * MiB, WS_LSE = WS_S + 384 * MiB;
constexpr size_t WS_U = WS_O, WS_H = WS_O + 440 * MiB, WS_Y2 = WS_H;
constexpr size_t WS_QB = WS_S, WS_KV = WS_S + 240 * MiB, WS_KRR = WS_S + 560 * MiB;
constexpr size_t WS_CTL = 1016 * MiB, CTL_BYTES = 65536;
constexpr size_t WS_END = WS_CTL + CTL_BYTES;
constexpr int LDS_BYTES = 147456;

__device__ __forceinline__ unsigned cvt_pk_bf16(float lo, float hi) { unsigned r; asm volatile("v_cvt_pk_bf16_f32 %0, %1, %2" : "=v"(r) : "v"(lo), "v"(hi)); return r; }
__device__ __forceinline__ u32x4 pack8(f32x4 v0, f32x4 v1) { u32x4 w; w.x = cvt_pk_bf16(v0[0], v0[1]); w.y = cvt_pk_bf16(v0[2], v0[3]); w.z = cvt_pk_bf16(v1[0], v1[1]); w.w = cvt_pk_bf16(v1[2], v1[3]); return w; }
__device__ __forceinline__ float bf2f(unsigned short b) { return __uint_as_float((unsigned)b << 16); }
__device__ __forceinline__ float wave_sum(float v, int lane) {
#pragma unroll
    for (int o = 1; o < 32; o <<= 1) v += __int_as_float(__builtin_amdgcn_ds_bpermute((lane ^ o) << 2, __float_as_int(v)));
    auto rr = __builtin_amdgcn_permlane32_swap(__float_as_uint(v), __float_as_uint(v), false, false);
    return __uint_as_float(rr[0]) + __uint_as_float(rr[1]);
}

namespace pg8 {
constexpr int BM = 256, BK = 64, HALF = 128, HTB = HALF * BK * 2, STAGE_BYTES = 8 * HTB, NXCD = 8, WGM = 8;
__host__ __device__ __forceinline__ int lds_byte(int r, int c) { const int st = (r >> 4) * 2 + (c >> 5), rr = r & 15, cc = c & 31, ob = rr * 64 + cc * 2; return st * 1024 + (ob ^ (((ob >> 9) & 1) << 5)); }
__host__ __device__ __forceinline__ void stage_rc(int b, int& R, int& C) { const int st = b / 1024, sb = b % 1024, swz = sb ^ (((sb >> 9) & 1) << 5); R = (st >> 1) * 16 + swz / 64; C = (st & 1) * 32 + (swz % 64) / 2; }
__host__ __device__ __forceinline__ int perm32(int rho) { const int n = rho >> 4, i = rho & 15; return 8 * (i >> 2) + 4 * n + (i & 3); }

struct Unit { int pm, pn; };
struct Gemm { const bf16_t* A; const bf16_t* Bt; int M, N, K, lda; };

struct StaticOrder {
    int nM, nN, nwg, G, c;
    __device__ void init(int M, int N, int G_, int c_) { nM = M / BM; nN = N / BM; nwg = nM * nN; G = G_; c = c_; }
    __device__ bool next(int i, Unit& u) const {
        const long L = (long)i * G + c; if (L >= nwg) return false;
        int wgid = (int)L; { const int q = nwg / NXCD, r = nwg % NXCD, xcd = wgid % NXCD, off = wgid / NXCD; wgid = (xcd < r ? xcd * (q + 1) : r * (q + 1) + (xcd - r) * q) + off; }
        const int nig = WGM * nN, gid = wgid / nig, fm = gid * WGM, gsz = (nM - fm) < WGM ? (nM - fm) : WGM;
        u.pm = fm + ((wgid % nig) % gsz); u.pn = (wgid % nig) / gsz; return true;
    }
};

struct EpiStore {
    static constexpr bool PERM = true;
    bf16_t* O; int ldc; const float* rscale; float cscale;
    __device__ __forceinline__ void operator()(const f32x4 (&acc)[2][2][4][2], const Unit& u, int wr, int wc, int fr, int fq) const {
        const int row0 = u.pm * BM + wr * 64 + fr, col0 = u.pn * BM + wc * 32 + 8 * fq;
#pragma unroll
        for (int ai = 0; ai < 2; ++ai)
#pragma unroll
            for (int m = 0; m < 4; ++m) {
                const int row = row0 + ai * HALF + m * 16;
                const float s = rscale ? rscale[row] * cscale : cscale;
                bf16_t* rowp = O + (size_t)row * ldc + col0;
#pragma unroll
                for (int bj = 0; bj < 2; ++bj) *(u32x4*)(rowp + bj * HALF) = pack8(acc[ai][bj][m][0] * s, acc[ai][bj][m][1] * s);
            }
    }
};
struct EpiQRope {
    static constexpr bool PERM = true;
    bf16_t* O; const float* rscale; float cscale; const float* cosT; const float* sinT;
    __device__ __forceinline__ void operator()(const f32x4 (&acc)[2][2][4][2], const Unit& u, int wr, int wc, int fr, int fq) const {
        const int row0 = u.pm * BM + wr * 64 + fr, col0 = u.pn * BM + wc * 32 + 8 * fq;
        int rj[2];
#pragma unroll
        for (int bj = 0; bj < 2; ++bj) { const int w = (col0 + bj * HALF) % 96; rj[bj] = (w >= 64) ? ((w - 64) >> 3) : -1; }
#pragma unroll
        for (int ai = 0; ai < 2; ++ai)
#pragma unroll
            for (int m = 0; m < 4; ++m) {
                const int row = row0 + ai * HALF + m * 16;
                const float s = rscale[row] * cscale;
                const int pos = row < TP ? (row & 8191) : (row & 2047);
                bf16_t* rowp = O + (size_t)row * NQ + col0;
#pragma unroll
                for (int bj = 0; bj < 2; ++bj) {
                    f32x4 v0 = acc[ai][bj][m][0] * s, v1 = acc[ai][bj][m][1] * s;
                    if (rj[bj] >= 0) {
                        const f32x4 cs = *(const f32x4*)(cosT + pos * 16 + 4 * rj[bj]), sn = *(const f32x4*)(sinT + pos * 16 + 4 * rj[bj]);
                        const f32x4 t1 = v0, t2 = v1; v0 = t1 * cs - t2 * sn; v1 = t1 * sn + t2 * cs;
                    }
                    *(u32x4*)(rowp + bj * HALF) = pack8(v0, v1);
                }
            }
    }
};
struct EpiQKV {
    static constexpr bool PERM = true;
    bf16_t* O; int log2S; float qscale;
    __device__ __forceinline__ void operator()(const f32x4 (&acc)[2][2][4][2], const Unit& u, int wr, int wc, int fr, int fq) const {
        const int colt = u.pn * BM, g = colt / 3072, which = (colt - g * 3072) >> 10, sh = 2 * g, log2L = log2S - sh, S = 1 << log2S;
        const float sc = (which == 0) ? qscale : 1.f;
        const int row0 = u.pm * BM + wr * 64 + fr, col0 = colt + wc * 32 + 8 * fq;
#pragma unroll
        for (int ai = 0; ai < 2; ++ai)
#pragma unroll
            for (int m = 0; m < 4; ++m) {
                const int rl = row0 + ai * HALF + m * 16, seq = rl >> log2S, s = rl & (S - 1);
                const int f = ((s & ((1 << sh) - 1)) << log2L) + (s >> sh), drow = (seq << log2S) + f;
                bf16_t* rowp = O + (size_t)drow * NQKV + col0;
#pragma unroll
                for (int bj = 0; bj < 2; ++bj) *(u32x4*)(rowp + bj * HALF) = pack8(acc[ai][bj][m][0] * sc, acc[ai][bj][m][1] * sc);
            }
    }
};
struct EpiRes {
    static constexpr bool PERM = true;
    float* X; float alpha;
    __device__ __forceinline__ void operator()(const f32x4 (&acc)[2][2][4][2], const Unit& u, int wr, int wc, int fr, int fq) const {
        const int row0 = u.pm * BM + wr * 64 + fr, col0 = u.pn * BM + wc * 32 + 8 * fq;
#pragma unroll
        for (int ai = 0; ai < 2; ++ai)
#pragma unroll
            for (int m = 0; m < 4; ++m) {
                float* rowp = X + (size_t)(row0 + ai * HALF + m * 16) * DM + col0;
#pragma unroll
                for (int bj = 0; bj < 2; ++bj) {
                    float* p = rowp + bj * HALF; const f32x4 a = *(const f32x4*)p, b = *(const f32x4*)(p + 4);
                    *(f32x4*)p = a * alpha + acc[ai][bj][m][0]; *(f32x4*)(p + 4) = b * alpha + acc[ai][bj][m][1];
                }
            }
    }
};

template <class Epi, class Sched, bool ALIGN_EPI = true, bool SP2 = true>
__device__ __forceinline__ void gemm_phase(LAS unsigned char* lds, const Gemm g, const Sched& S, const Epi& E) {
    int tid_ = threadIdx.x; asm volatile("" : "+v"(tid_));
    const int tid = tid_, wid = __builtin_amdgcn_readfirstlane(tid >> 6), lane = tid & 63, wr = wid >> 2, wc = wid & 3, fr = lane & 15, fq = lane >> 4;
    const int K = g.K, nt = K / BK, lda = g.lda;
    unsigned voffA[2], voffB[2];
#pragma unroll
    for (int i = 0; i < 2; ++i) { int R, C; stage_rc(tid * 16 + i * 8192, R, C); const int Rb = Epi::PERM ? ((R & ~31) + perm32(R & 31)) : R;
        voffA[i] = (unsigned)(R * lda + C) * 2u; voffB[i] = (unsigned)(Rb * K + C) * 2u; }
    const size_t kstep = (size_t)(BK * 2);
    const size_t hstepA = (size_t)HALF * lda * 2, hstepB = (size_t)HALF * K * 2;
    const size_t tstepA = 2 * hstepA, tstepB = 2 * hstepB;
    const unsigned ldsw = (unsigned)wid * 1024u;
    const int aoff = lds_byte(wr * 64 + fr, fq * 8), boff = lds_byte(wc * 32 + fr, fq * 8);
#define PG8_SA(b, h) (((b) * 2 + (h)) * HTB)
#define PG8_SB(b, h) ((4 + (b) * 2 + (h)) * HTB)
#define PG8_STAGE(bufoff, gbase, voff) do { _Pragma("unroll") for (int _i = 0; _i < 2; ++_i) \
        __builtin_amdgcn_global_load_lds((const unsigned*)((const char*)(gbase) + (voff)[_i]), (LAS unsigned*)(lds + (bufoff) + ldsw + _i * 8192), 16, 0, 0); } while (0)
#define PG8_LDA(dst, b, h) do { _Pragma("unroll") for (int m = 0; m < 4; ++m) _Pragma("unroll") for (int k = 0; k < 2; ++k) dst[m][k] = *(const LAS bf16x8*)(lds + PG8_SA(b, h) + aoff + m * 2048 + k * 1024); } while (0)
#define PG8_LDB(dst, b, h) do { _Pragma("unroll") for (int n = 0; n < 2; ++n) _Pragma("unroll") for (int k = 0; k < 2; ++k) dst[n][k] = *(const LAS bf16x8*)(lds + PG8_SB(b, h) + boff + n * 2048 + k * 1024); } while (0)
#define PG8_MMA(ai, bj, At, Bt) do { __builtin_amdgcn_s_setprio(1); _Pragma("unroll") for (int m = 0; m < 4; ++m) _Pragma("unroll") for (int n = 0; n < 2; ++n) _Pragma("unroll") for (int k = 0; k < 2; ++k) \
        acc[ai][bj][m][n] = __builtin_amdgcn_mfma_f32_16x16x32_bf16(Bt[n][k], At[m][k], acc[ai][bj][m][n], 0, 0, 0); __builtin_amdgcn_s_setprio(0); } while (0)
#define PG8_WAIT_V(n) asm volatile("s_waitcnt vmcnt(" #n ")" ::: "memory")
#define PG8_WAIT_L(n) asm volatile("s_waitcnt lgkmcnt(" #n ")" ::: "memory")
#define PG8_BAR __builtin_amdgcn_s_barrier()
#define PG8_SCHED __builtin_amdgcn_sched_barrier(0)
    Unit cur, nxt; int ui = 0;
    if (!S.next(0, cur)) return;
    f32x4 acc[2][2][4][2];
#pragma unroll
    for (int a = 0; a < 2; ++a)
#pragma unroll
        for (int b = 0; b < 2; ++b)
#pragma unroll
            for (int m = 0; m < 4; ++m)
#pragma unroll
                for (int n = 0; n < 2; ++n) acc[a][b][m][n] = (f32x4){0.f, 0.f, 0.f, 0.f};
    bf16x8 At[4][2], B0[2][2], B1[2][2];
    const char* cA = (const char*)g.A + (size_t)cur.pm * tstepA; const char* cB = (const char*)g.Bt + (size_t)cur.pn * tstepB;
    if constexpr (SP2) {
        PG8_STAGE(PG8_SB(0, 0), cB, voffB); PG8_STAGE(PG8_SB(0, 1), cB + hstepB, voffB); PG8_STAGE(PG8_SA(0, 0), cA, voffA); PG8_STAGE(PG8_SA(0, 1), cA + hstepA, voffA);
        if (wr == 1) PG8_BAR;
        PG8_WAIT_V(2); PG8_BAR;
        PG8_STAGE(PG8_SB(1, 0), cB + kstep, voffB); PG8_STAGE(PG8_SA(1, 0), cA + kstep, voffA); PG8_STAGE(PG8_SB(1, 1), cB + hstepB + kstep, voffB);
        PG8_WAIT_V(6); PG8_BAR;
    }
    for (;;) {
        const bool has_next = S.next(ui + 1, nxt);
        const char* nA = has_next ? (const char*)g.A + (size_t)nxt.pm * tstepA : cA; const char* nB = has_next ? (const char*)g.Bt + (size_t)nxt.pn * tstepB : cB;
        for (int t = 0; t < nt; t += 2) {
            const bool last = (t == nt - 2);
            const char* a1 = cA + (size_t)(t + 1) * kstep;
            const char* a2 = last ? nA : cA + (size_t)(t + 2) * kstep; const char* b2 = last ? nB : cB + (size_t)(t + 2) * kstep;
            const char* a3 = a2 + kstep; const char* b3 = b2 + kstep;
            PG8_LDB(B0, 0, 0); PG8_LDB(B1, 0, 1); PG8_SCHED; PG8_LDA(At, 0, 0); PG8_STAGE(PG8_SA(1, 1), a1 + hstepA, voffA);
            PG8_WAIT_V(8); PG8_WAIT_L(0); PG8_BAR; PG8_MMA(0, 0, At, B0); PG8_MMA(0, 1, At, B1); PG8_BAR; PG8_SCHED;
            PG8_LDA(At, 0, 1); PG8_STAGE(PG8_SB(0, 0), b2, voffB); PG8_STAGE(PG8_SB(0, 1), b2 + hstepB, voffB); PG8_STAGE(PG8_SA(0, 0), a2, voffA);
            PG8_WAIT_V(8); PG8_WAIT_L(0); PG8_BAR; PG8_MMA(1, 0, At, B0); PG8_MMA(1, 1, At, B1); PG8_BAR; PG8_SCHED;
            PG8_LDB(B0, 1, 0); PG8_LDB(B1, 1, 1); PG8_SCHED; PG8_LDA(At, 1, 0); PG8_STAGE(PG8_SA(0, 1), a2 + hstepA, voffA);
            PG8_WAIT_V(8); PG8_WAIT_L(0); PG8_BAR; PG8_MMA(0, 0, At, B0); PG8_MMA(0, 1, At, B1); PG8_BAR; PG8_SCHED;
            PG8_LDA(At, 1, 1); PG8_STAGE(PG8_SB(1, 0), b3, voffB); PG8_STAGE(PG8_SB(1, 1), b3 + hstepB, voffB); PG8_STAGE(PG8_SA(1, 0), a3, voffA);
            PG8_WAIT_V(8); PG8_WAIT_L(0); PG8_BAR; PG8_MMA(1, 0, At, B0); PG8_MMA(1, 1, At, B1); PG8_BAR; PG8_SCHED;
        }
        if constexpr (ALIGN_EPI) { if (wr == 0) PG8_BAR; }
        { int l2 = threadIdx.x; asm volatile("" : "+v"(l2)); l2 &= 63; E(acc, cur, wr, wc, l2 & 15, l2 >> 4); }
        if (!has_next) break;
#pragma unroll
        for (int a = 0; a < 2; ++a)
#pragma unroll
            for (int b = 0; b < 2; ++b)
#pragma unroll
                for (int m = 0; m < 4; ++m)
#pragma unroll
                    for (int n = 0; n < 2; ++n) acc[a][b][m][n] = (f32x4){0.f, 0.f, 0.f, 0.f};
        cur = nxt; cA = nA; cB = nB; ++ui;
        if constexpr (ALIGN_EPI) { if (wr == 1) PG8_BAR; }
    }
    PG8_WAIT_V(0);
    if constexpr (!ALIGN_EPI) { if (wr == 0) PG8_BAR; }
    PG8_BAR;
#undef PG8_SA
#undef PG8_SB
#undef PG8_STAGE
#undef PG8_LDA
#undef PG8_LDB
#undef PG8_MMA
#undef PG8_WAIT_V
#undef PG8_WAIT_L
#undef PG8_BAR
#undef PG8_SCHED
}
}

struct Params {
    const float *x_prompt, *x_sample, *rel_bias, *w_qkv_a, *w_o_a, *w_dkv_b, *g_q_b, *g_kv_b, *w_uq_b, *w_ukv_b, *w_o_b, *ffn_w_in, *ffn_conv_w, *ffn_conv_b, *ffn_w_out, *ln_g, *ln_b;
    float* out; unsigned char* ws;
    int ph_lo, ph_hi;
};

__device__ __forceinline__ int rope_perm32(int i) { const int t = i >> 4, ii = i & 15; return 8 * (ii >> 2) + 4 * t + (ii & 3); }
__device__ __forceinline__ int rowmap(int mode, int n) {
    if (mode == 1) { const int h = n / 96, w = n - h * 96; return w < 64 ? n : h * 96 + 64 + rope_perm32(w - 64); }
    if (mode == 2) { return n < 640 ? n : 640 + rope_perm32(n - 640); }
    return n;
}
__device__ __forceinline__ void transpose_item(const float* W, int K, int N, bf16_t* WT, int mode, const float* kscale, LAS float* scr, int item, int lane) {
    const int nblk = N / 32, kb = item / nblk, nb = item % nblk, k0 = 64 * kb, n0 = 32 * nb;
    const int kr = lane >> 3, c4 = (lane & 7) * 4;
#pragma unroll
    for (int i = 0; i < 8; ++i) { const int kk = kr + 8 * i; f32x4 v = *(const f32x4*)(W + (size_t)(k0 + kk) * N + n0 + c4); if (kscale) v = v * kscale[k0 + kk];
        scr[kk * 33 + c4] = v.x; scr[kk * 33 + c4 + 1] = v.y; scr[kk * 33 + c4 + 2] = v.z; scr[kk * 33 + c4 + 3] = v.w; }
    asm volatile("s_waitcnt lgkmcnt(0)" ::: "memory");
    const int c = lane & 7;
#pragma unroll
    for (int j = 0; j < 4; ++j) { const int n = (lane >> 3) + 8 * j; const LAS float* s = scr + (8 * c) * 33 + n;
        u32x4 o; o.x = cvt_pk_bf16(s[0 * 33], s[1 * 33]); o.y = cvt_pk_bf16(s[2 * 33], s[3 * 33]); o.z = cvt_pk_bf16(s[4 * 33], s[5 * 33]); o.w = cvt_pk_bf16(s[6 * 33], s[7 * 33]);
        *(u32x4*)(WT + (size_t)rowmap(mode, n0 + n) * K + k0 + 8 * c) = o; }
    asm volatile("s_waitcnt lgkmcnt(0)" ::: "memory");
}
__device__ __forceinline__ int t5_bucket(int rel) {
    const int n = rel < 0 ? -rel : rel; const int ret = rel > 0 ? 16 : 0;
    if (n < 8) return ret + n;
    int large = 8 + (int)(__log2f((float)n * 0.125f) * (8.0f / 7.0f));
    if (large > 15) large = 15;
    return ret + large;
}
__device__ __forceinline__ void rope_entry(int pos, int i, float& c, float& s) {
    const double x = -(double)i * (13.287712379549449 / 16.0);
    const double fl = __builtin_floor(x), fr = (x - fl) * 0.6931471805599453;
    double e = 1.0, term = 1.0;
#pragma unroll 1
    for (int k = 1; k < 22; ++k) { term *= fr / (double)k; e += term; }
    const long long bits = (long long)(1023 + (int)fl) << 52;
    const double inv = e * __builtin_bit_cast(double, bits);
    const double ang = (double)pos * inv;
    const double kq = __builtin_rint(ang * 0.6366197723675814);
    double r = __builtin_fma(-kq, 1.5707963267948966, ang); r = __builtin_fma(-kq, 6.123233995736766e-17, r);
    const double r2 = r * r;
    double sp = r * (1.0 + r2 * (-1.0 / 6 + r2 * (1.0 / 120 + r2 * (-1.0 / 5040 + r2 * (1.0 / 362880 + r2 * (-1.0 / 39916800 + r2 * (1.0 / 6227020800.0)))))));
    double cp = 1.0 + r2 * (-0.5 + r2 * (1.0 / 24 + r2 * (-1.0 / 720 + r2 * (1.0 / 40320 + r2 * (-1.0 / 3628800 + r2 * (1.0 / 479001600.0))))));
    const int q = (int)((long long)kq & 3);
    double sv = (q == 0) ? sp : (q == 1) ? cp : (q == 2) ? -sp : -cp;
    double cv = (q == 0) ? cp : (q == 1) ? -sp : (q == 2) ? -cp : sp;
    c = (float)cv; s = (float)sv;
}

__device__ __forceinline__ float gelu_erf(float v) {
    const float av = __builtin_fabsf(v), d = av * 0.2316418882f + 1.0f, t = __builtin_amdgcn_rcpf(d);
    float q = t * 0.5307027145f + (-0.7265760135f); q = q * t + 0.7107068705f; q = q * t + (-0.142248368f); q = q * t + 0.127414796f; q = q * t;
    const float e = __builtin_amdgcn_exp2f((v * v) * (-0.72134752044f));
    const float m = v * (q * e), r = v - m;
    return v < 0.f ? m : r;
}

__device__ __forceinline__ void ln_phase(const float* x0, const float* x1, const bf16_t* Y, float* Xo, bf16_t* XBo, const float* g, const float* b, int gw, int NGW, int lane, bool wb = true) {
    f32x4 gg[4], bb[4];
#pragma unroll
    for (int j = 0; j < 4; ++j) { gg[j] = *((const f32x4*)g + lane + 64 * j); bb[j] = *((const f32x4*)b + lane + 64 * j); }
    f32x4 cx[4]; u32x2 cy[4];
#define LN_LOAD(r, vx, vy) do { const float* src_ = (r) < TP ? x0 + (size_t)(r) * DM : x1 + (size_t)((r) - TP) * DM; \
        _Pragma("unroll") for (int j = 0; j < 4; ++j) { vx[j] = *((const f32x4*)src_ + lane + 64 * j); vy[j] = *((const u32x2*)(Y + (size_t)(r) * DM) + lane + 64 * j); } } while (0)
    if (gw < T) LN_LOAD(gw, cx, cy);
    for (int r = gw; r < T; r += NGW) {
        f32x4 nx[4] = {}; u32x2 ny[4] = {};
        const int rn = r + NGW;
        if (rn < T) LN_LOAD(rn, nx, ny);
        f32x4 v[4]; float s = 0.f;
#pragma unroll
        for (int j = 0; j < 4; ++j) {
            const f32x4 yf = {__uint_as_float(cy[j].x << 16), __uint_as_float(cy[j].x & 0xffff0000u), __uint_as_float(cy[j].y << 16), __uint_as_float(cy[j].y & 0xffff0000u)};
            v[j] = cx[j] * ALPHA + yf; s += (v[j].x + v[j].y) + (v[j].z + v[j].w);
        }
        const float mean = wave_sum(s, lane) * (1.f / DM); float s2 = 0.f;
#pragma unroll
        for (int j = 0; j < 4; ++j) { v[j] = v[j] - mean; s2 += (v[j].x * v[j].x + v[j].y * v[j].y) + (v[j].z * v[j].z + v[j].w * v[j].w); }
        const float rstd = 1.f / sqrtf(wave_sum(s2, lane) * (1.f / DM) + LN_EPS);
#pragma unroll
        for (int j = 0; j < 4; ++j) {
            const f32x4 o = v[j] * rstd * gg[j] + bb[j];
            *((f32x4*)(Xo + (size_t)r * DM) + lane + 64 * j) = o;
            if (wb) { u32x2 w; w.x = cvt_pk_bf16(o.x, o.y); w.y = cvt_pk_bf16(o.z, o.w); *((u32x2*)(XBo + (size_t)r * DM) + lane + 64 * j) = w; }
        }
#pragma unroll
        for (int j = 0; j < 4; ++j) { cx[j] = nx[j]; cy[j] = ny[j]; }
    }
#undef LN_LOAD
}

__device__ __forceinline__ s16x4 tr_read(unsigned addr) { s16x4 r; asm volatile("ds_read_b64_tr_b16 %0, %1" : "=&v"(r) : "v"(addr) : "memory"); return r; }
#define MFMA32(a, b, c) __builtin_amdgcn_mfma_f32_32x32x16_bf16(a, b, c, 0, 0, 0)
__device__ __forceinline__ float xhalf_max(float v) { auto rr = __builtin_amdgcn_permlane32_swap(__float_as_uint(v), __float_as_uint(v), false, false); return fmaxf(__uint_as_float(rr[0]), __uint_as_float(rr[1])); }
__device__ __forceinline__ float xhalf_sum(float v) { auto rr = __builtin_amdgcn_permlane32_swap(__float_as_uint(v), __float_as_uint(v), false, false); return __uint_as_float(rr[0]) + __uint_as_float(rr[1]); }
__device__ __forceinline__ float max3(float a, float b, float c) { float r; asm("v_max3_f32 %0, %1, %2, %3" : "=v"(r) : "v"(a), "v"(b), "v"(c)); return r; }
__device__ __forceinline__ bf16x8 pack_p(const f32x16& p, int j2) {
    u32x4 w; w.x = cvt_pk_bf16(p[8 * j2 + 0], p[8 * j2 + 1]); w.y = cvt_pk_bf16(p[8 * j2 + 2], p[8 * j2 + 3]); w.z = cvt_pk_bf16(p[8 * j2 + 4], p[8 * j2 + 5]); w.w = cvt_pk_bf16(p[8 * j2 + 6], p[8 * j2 + 7]);
    return __builtin_bit_cast(bf16x8, w);
}
__device__ __forceinline__ void pv_tile(f32x16& o, unsigned vaddr, const bf16x8 (&pb)[4]) {
    s16x4 lo[4], hi[4];
#pragma unroll
    for (int k = 0; k < 4; ++k) { lo[k] = tr_read(vaddr + (16 * k) * 64); hi[k] = tr_read(vaddr + (16 * k + 8) * 64); }
    asm volatile("s_waitcnt lgkmcnt(0)" ::: "memory"); __builtin_amdgcn_sched_barrier(0);
#pragma unroll
    for (int k = 0; k < 4; ++k) { const bf16x8 a = (bf16x8){lo[k][0], lo[k][1], lo[k][2], lo[k][3], hi[k][0], hi[k][1], hi[k][2], hi[k][3]}; o = MFMA32(a, pb[k], o); }
}

__device__ __forceinline__ void pv_issue(unsigned vaddr, s16x4 (&lo)[4], s16x4 (&hi)[4]) {
#pragma unroll
    for (int k = 0; k < 4; ++k) { lo[k] = tr_read(vaddr + (16 * k) * 64); hi[k] = tr_read(vaddr + (16 * k + 8) * 64); }
}
__device__ __forceinline__ void pv_mma(f32x16& o, const s16x4 (&lo)[4], const s16x4 (&hi)[4], const bf16x8 (&pb)[4]) {
#pragma unroll
    for (int k = 0; k < 4; ++k) { const bf16x8 a = (bf16x8){lo[k][0], lo[k][1], lo[k][2], lo[k][3], hi[k][0], hi[k][1], hi[k][2], hi[k][3]}; o = MFMA32(a, pb[k], o); }
}
#define MLA_QK_(cur) { const LAS unsigned char* Kb_ = lds + cur * KBUF; s0 = (f32x16){}; s1 = (f32x16){}; \
            _Pragma("unroll") \
            for (int ks = 0; ks < 6; ++ks) { \
                const bf16x8 a0 = *(const LAS bf16x8*)(Kb_ + r32 * 208 + ks * 32 + hi * 16), a1 = *(const LAS bf16x8*)(Kb_ + (32 + r32) * 208 + ks * 32 + hi * 16); \
                s0 = MFMA32(a0, qf[ks], s0); s1 = MFMA32(a1, qf[ks], s1); \
            } }
#define MLA_ROWMAX_() \
            float pa = max3(s0[0], s0[1], s0[2]), pc = max3(s1[0], s1[1], s1[2]); \
            _Pragma("unroll") \
            for (int r = 3; r < 15; r += 2) { pa = max3(pa, s0[r], s0[r + 1]); pc = max3(pc, s1[r], s1[r + 1]); } \
            float pmax = max3(pa, pc, fmaxf(s0[15], s1[15])); \
            pmax = xhalf_max(pmax)
#define MLA_EXPSUM_() { \
            f32x2 pa2 = {0.f, 0.f}, pb2 = {0.f, 0.f}, pc2 = {0.f, 0.f}, pd2 = {0.f, 0.f};     \
            _Pragma("unroll") \
            for (int r = 0; r < 16; ++r) { s0[r] = __builtin_amdgcn_exp2f(s0[r]); s1[r] = __builtin_amdgcn_exp2f(s1[r]); } \
            _Pragma("unroll") \
            for (int r = 0; r < 16; r += 4) { pa2 += (f32x2){s0[r], s0[r + 1]}; pb2 += (f32x2){s0[r + 2], s0[r + 3]}; pc2 += (f32x2){s1[r], s1[r + 1]}; pd2 += (f32x2){s1[r + 2], s1[r + 3]}; } \
            { const f32x2 t2 = (pa2 + pb2) + (pc2 + pd2); ps = t2.x + t2.y; } }
#define MLA_COMPUTE(cur) { \
            f32x16 s0, s1; float ps; \
            MLA_QK_(cur) \
            const unsigned va = trb + cur * VBUF; \
            s16x4 vl0[4], vh0[4]; \
            pv_issue(va, vl0, vh0);    \
            if (slow || j == 0) { \
                MLA_ROWMAX_(); \
                if (__any(pmax - m > (slow ? 8.f : 64.f)) || (j == 0 && __any(pmax < -32.f))) { \
                    const float mn = (j == 0) ? pmax : fmaxf(m, pmax), alpha = (j == 0) ? 1.f : __builtin_amdgcn_exp2f(m - mn); \
                    m = mn; l *= alpha; slow = true; \
                    _Pragma("unroll") \
                    for (int r = 0; r < 16; ++r) { o0[r] *= alpha; o1[r] *= alpha; } \
                } \
                if (slow) { \
                    _Pragma("unroll") \
                    for (int r = 0; r < 16; ++r) { s0[r] -= m; s1[r] -= m; } \
                } \
            } \
            MLA_EXPSUM_() \
            if (!slow && __any(!(ps < 1e30f))) {     \
                MLA_QK_(cur) \
                MLA_ROWMAX_(); \
                const float mn = fmaxf(m, pmax), alpha = __builtin_amdgcn_exp2f(m - mn); \
                m = mn; l *= alpha; slow = true; \
                _Pragma("unroll") \
                for (int r = 0; r < 16; ++r) { o0[r] *= alpha; o1[r] *= alpha; s0[r] -= m; s1[r] -= m; } \
                MLA_EXPSUM_() \
            } \
            l += ps; \
            bf16x8 pb[4]; \
            pb[0] = pack_p(s0, 0); pb[1] = pack_p(s0, 1); pb[2] = pack_p(s1, 0); pb[3] = pack_p(s1, 1); \
            asm volatile("s_waitcnt lgkmcnt(0)" ::: "memory"); __builtin_amdgcn_sched_barrier(0); \
            pv_mma(o0, vl0, vh0, pb); pv_tile(o1, va + 4096, pb); \
            }
__device__ __forceinline__ void attn_mla_phase(LAS unsigned char* lds, const bf16_t* QB, const bf16_t* KV, const bf16_t* KRR, bf16_t* O, int G, int bx) {
    constexpr int KBUF = 64 * 208, VBUF = 8192, VOFF = 2 * KBUF;
    int tid_ = threadIdx.x; asm volatile("" : "+v"(tid_));
    const int tid = tid_, wid = __builtin_amdgcn_readfirstlane(tid >> 6), lane = tid & 63, r32 = lane & 31, hi = lane >> 5;
    const bool xs = (G % 8) == 0;
    const int nslots = xs ? G / 8 : G, slot = xs ? bx / 8 : bx, xcd = xs ? bx % 8 : 0, npx = xs ? 16 : 128;
    const int nent = npx * 40;
    const int skey = tid >> 3, sch = tid & 7, rkey = tid >> 2, rch = tid & 3;
    const int kdst = skey * 208 + sch * 16, rdst = rkey * 208 + 128 + rch * 16, vdst = (sch >> 2) * 4096 + skey * 64 + (sch & 3) * 16;
    const unsigned trb = (unsigned)(size_t)(lds + VOFF) + (unsigned)((4 * hi + ((lane & 15) >> 2)) * 64 + 32 * ((lane >> 4) & 1) + 8 * (lane & 3));
#define MLA_DEC(LI, P) int P##pair, P##qb, P##base, P##S; \
        if ((LI) < npx * 32) { P##pair = xs ? ((LI) >> 5) * 8 + xcd : ((LI) >> 5); P##qb = (LI) & 31; P##base = (P##pair >> 4) * 8192; P##S = 8192; } \
        else { const int l2_ = (LI) - npx * 32; P##pair = xs ? (l2_ >> 3) * 8 + xcd : (l2_ >> 3); P##qb = l2_ & 7; P##base = TP + (P##pair >> 4) * 2048; P##S = 2048; } \
        const int P##h = P##pair & 15; \
        const size_t P##qrow = (size_t)P##base + P##qb * 256 + wid * 32 + r32; \
        const bf16_t* P##qsrc = QB + P##qrow * NQ + P##h * 96 + hi * 8; \
        const bf16_t* P##kn = KV + (size_t)(P##base + skey) * NKV + P##h * 128 + sch * 8; \
        const bf16_t* P##kr = KRR + (size_t)(P##base + rkey) * 32 + rch * 8
    int li = slot;
    if (li >= nent) return;
    bf16x8 qf[6]; bf16x8 ska, sva, sra = {}, skb, svb, srb = {};
    {
        MLA_DEC(li, f_);
#pragma unroll
        for (int ks = 0; ks < 6; ++ks) qf[ks] = *(const bf16x8*)(f_qsrc + ks * 16);
        ska = *(const bf16x8*)f_kn; sva = *(const bf16x8*)(f_kn + 64); if (tid < 256) sra = *(const bf16x8*)f_kr;
        *(LAS bf16x8*)(lds + kdst) = ska; *(LAS bf16x8*)(lds + VOFF + vdst) = sva; if (tid < 256) *(LAS bf16x8*)(lds + rdst) = sra;
        ska = *(const bf16x8*)(f_kn + (size_t)64 * NKV); sva = *(const bf16x8*)(f_kn + (size_t)64 * NKV + 64); if (tid < 256) sra = *(const bf16x8*)(f_kr + 64 * 32);
    }
    __syncthreads();
    for (;;) {
        MLA_DEC(li, c_);
        const int lin = li + nslots; const bool hasn = lin < nent;
        MLA_DEC(hasn ? lin : li, n_);
        const int h = c_h; const size_t qrow = c_qrow;
        f32x16 o0 = {}, o1 = {}; float m = 0.f, l = 0.f; bool slow = false;
        const int NT = c_S / 64;
        const bf16_t* kn_src = c_kn; const bf16_t* kr_src = c_kr;
#define MLA_STEP(cur, SKL, SVL, SRL, SKW, SVW, SRW) { \
            { const bool own_ = j + 2 < NT; const size_t off = (size_t)(own_ ? j + 2 : j + 2 - NT) * 64; const bf16_t* kn_ = own_ ? kn_src : n_kn; const bf16_t* kr_ = own_ ? kr_src : n_kr; \
              SKL = *(const bf16x8*)(kn_ + off * NKV); SVL = *(const bf16x8*)(kn_ + off * NKV + 64); if (tid < 256) SRL = *(const bf16x8*)(kr_ + off * 32); } \
            MLA_COMPUTE(cur) \
            *(LAS bf16x8*)(lds + ((cur) ^ 1) * KBUF + kdst) = SKW; *(LAS bf16x8*)(lds + VOFF + ((cur) ^ 1) * VBUF + vdst) = SVW; if (tid < 256) *(LAS bf16x8*)(lds + ((cur) ^ 1) * KBUF + rdst) = SRW; \
            __syncthreads(); ++j; }
        for (int j = 0; j < NT;) {
            MLA_STEP(0, skb, svb, srb, ska, sva, sra)
            MLA_STEP(1, ska, sva, sra, skb, svb, srb)
        }
#undef MLA_STEP
        if (hasn) {
#pragma unroll
            for (int ks = 0; ks < 6; ++ks) qf[ks] = *(const bf16x8*)(n_qsrc + ks * 16);
        }
        l = xhalf_sum(l);
        const float inv = 1.f / l;
        bf16_t* orow = O + qrow * DM + h * 64 + 4 * hi;
#pragma unroll
        for (int g4 = 0; g4 < 4; ++g4) {
            u32x2 w0, w1;
            w0.x = cvt_pk_bf16(o0[4 * g4] * inv, o0[4 * g4 + 1] * inv); w0.y = cvt_pk_bf16(o0[4 * g4 + 2] * inv, o0[4 * g4 + 3] * inv);
            w1.x = cvt_pk_bf16(o1[4 * g4] * inv, o1[4 * g4 + 1] * inv); w1.y = cvt_pk_bf16(o1[4 * g4 + 2] * inv, o1[4 * g4 + 3] * inv);
            *(u32x2*)(orow + 8 * g4) = w0; *(u32x2*)(orow + 32 + 8 * g4) = w1;
        }
        if (!hasn) break;
        li = lin;
    }
#undef MLA_DEC
}

#undef MLA_COMPUTE
#undef MLA_QK_
#undef MLA_ROWMAX_
#undef MLA_EXPSUM_
__device__ __forceinline__ void attn_dil_phase(LAS unsigned char* lds, const bf16_t* QKV, const float* BT, bf16_t* OG, float* LSE, int nseq, int log2S, int G, int bx) {
    constexpr int KBUF = 64 * 272, VBUF = 16384, VOFF = 2 * KBUF, TOFF = VOFF + 2 * VBUF;
    int tid_ = threadIdx.x; asm volatile("" : "+v"(tid_));
    const int tid = tid_, wid = __builtin_amdgcn_readfirstlane(tid >> 6), lane = tid & 63, r32 = lane & 31, hi = lane >> 5;
    const int S = 1 << log2S, nqb = S >> 8, nunits = nseq * 24 * nqb;
    const int key0 = tid >> 4, ch0 = tid & 15;
    const int kdst = key0 * 272 + ch0 * 16, vdst = (ch0 >> 2) * 4096 + key0 * 64 + (ch0 & 3) * 16;
    const unsigned trb = (unsigned)(size_t)(lds + VOFF) + (unsigned)((4 * hi + ((lane & 15) >> 2)) * 64 + 32 * ((lane >> 4) & 1) + 8 * (lane & 3));
    LAS float* tab = (LAS float*)(lds + TOFF);
#define DIL_DEC(uu, P) const int P##qb = (uu) % nqb; int P##rest = (uu) / nqb; const int P##h = P##rest & 7; P##rest >>= 3; const int P##g = P##rest % 3, P##seq = P##rest / 3; \
        const int P##f0 = P##qb * 256, P##rowbase = P##seq << log2S, P##tlo = (P##f0 == 0) ? 1 : 0; \
        const bf16_t* P##qsrc = QKV + ((size_t)P##rowbase + P##f0 + wid * 32 + r32) * NQKV + P##g * 3072 + P##h * 128 + hi * 8; \
        const bf16_t* P##ksrc = QKV + (long)(P##rowbase + P##f0 - 64 + key0) * NQKV + P##g * 3072 + 1024 + P##h * 128 + ch0 * 8; \
        const float* P##tsrc = BT + (P##g * 8 + P##h) * 384 + (tid < 384 ? tid : 0)
#define DIL_TILE(src, t) do { const bf16_t* p_ = (src) + (size_t)((t) * 64) * NQKV; k0r = *(const bf16x8*)p_; v0r = *(const bf16x8*)(p_ + 1024); k1r = *(const bf16x8*)(p_ + (size_t)32 * NQKV); v1r = *(const bf16x8*)(p_ + (size_t)32 * NQKV + 1024); } while (0)
    bf16x8 qn[8] = {}, k0r = {}, k1r = {}, v0r = {}, v1r = {}; float tabv = 0.f;
    if (bx < nunits) {
        DIL_DEC(bx, a_);
#pragma unroll
        for (int ks = 0; ks < 8; ++ks) qn[ks] = *(const bf16x8*)(a_qsrc + ks * 16);
        DIL_TILE(a_ksrc, a_tlo); tabv = *a_tsrc;
    }
    for (int u = bx; u < nunits; u += G) {
        DIL_DEC(u, c_);
        const int h = c_h, g = c_g, f0 = c_f0, rowbase = c_rowbase, tlo = c_tlo;
        const int sh = 2 * g, log2L = log2S - sh;
        bf16x8 qf[8];
#pragma unroll
        for (int ks = 0; ks < 8; ++ks) qf[ks] = qn[ks];
        if (tid < 384) tab[tid] = tabv;
        f32x16 o[4] = {}; float m = -1e30f, l = 0.f;
        const int thi = (f0 + 256 >= S) ? 4 : 5;
        const int wt0 = wid >> 1, myblk = (f0 + 32 * wid) >> log2L;
        const bf16_t* ksrc = c_ksrc;
        const int tbase = 128 - 32 * wid - r32 + 4 * hi;
        *(LAS bf16x8*)(lds + kdst) = k0r; *(LAS bf16x8*)(lds + kdst + 32 * 272) = k1r; *(LAS bf16x8*)(lds + VOFF + vdst) = v0r; *(LAS bf16x8*)(lds + VOFF + vdst + 32 * 64) = v1r;
        const int un = u + G; const bool hasn = un < nunits;
        DIL_DEC(hasn ? un : u, n_);
        if (hasn) {
#pragma unroll
            for (int ks = 0; ks < 8; ++ks) qn[ks] = *(const bf16x8*)(n_qsrc + ks * 16);
            tabv = *n_tsrc;
        }
        __syncthreads();
        for (int t = tlo; t <= thi; ++t) {
            const int cur = (t - tlo) & 1;
            if (t < thi) DIL_TILE(ksrc, t + 1); else if (hasn) DIL_TILE(n_ksrc, n_tlo);
            const int fk0 = f0 - 64 + 64 * t;
            if (t >= wt0 && t <= wt0 + 2 && (fk0 >> log2L) == myblk) {
                const LAS unsigned char* Kb = lds + cur * KBUF;
                f32x16 s0 = {}, s1 = {};
#pragma unroll
                for (int ks = 0; ks < 8; ++ks) {
                    const bf16x8 a0 = *(const LAS bf16x8*)(Kb + r32 * 272 + ks * 32 + hi * 16), a1 = *(const LAS bf16x8*)(Kb + (32 + r32) * 272 + ks * 32 + hi * 16);
                    s0 = MFMA32(a0, qf[ks], s0); s1 = MFMA32(a1, qf[ks], s1);
                }
                const LAS float* tb = tab + tbase + 64 * t;
#pragma unroll
                for (int r = 0; r < 16; ++r) { s0[r] += tb[(r & 3) + 8 * (r >> 2)]; s1[r] += tb[32 + (r & 3) + 8 * (r >> 2)]; }
                float pmax = s0[0];
#pragma unroll
                for (int r = 1; r < 16; ++r) pmax = fmaxf(pmax, s0[r]);
#pragma unroll
                for (int r = 0; r < 16; ++r) pmax = fmaxf(pmax, s1[r]);
                pmax = xhalf_max(pmax);
                if (__any(pmax > m + 8.f)) {
                    const float mn = fmaxf(m, pmax), alpha = __builtin_amdgcn_exp2f(m - mn);
                    m = mn; l *= alpha;
#pragma unroll
                    for (int d = 0; d < 4; ++d)
#pragma unroll
                        for (int r = 0; r < 16; ++r) o[d][r] *= alpha;
                }
                float ps = 0.f;
#pragma unroll
                for (int r = 0; r < 16; ++r) { s0[r] = __builtin_amdgcn_exp2f(s0[r] - m); s1[r] = __builtin_amdgcn_exp2f(s1[r] - m); ps += s0[r] + s1[r]; }
                l += ps;
                bf16x8 pb[4];
                pb[0] = pack_p(s0, 0); pb[1] = pack_p(s0, 1); pb[2] = pack_p(s1, 0); pb[3] = pack_p(s1, 1);
                const unsigned va = trb + cur * VBUF;
                pv_tile(o[0], va, pb); pv_tile(o[1], va + 4096, pb); pv_tile(o[2], va + 8192, pb); pv_tile(o[3], va + 12288, pb);
            }
            if (t < thi) {
                const int nb = cur ^ 1;
                *(LAS bf16x8*)(lds + nb * KBUF + kdst) = k0r; *(LAS bf16x8*)(lds + nb * KBUF + kdst + 32 * 272) = k1r;
                *(LAS bf16x8*)(lds + VOFF + nb * VBUF + vdst) = v0r; *(LAS bf16x8*)(lds + VOFF + nb * VBUF + vdst + 32 * 64) = v1r;
            }
            __syncthreads();
        }
        l = xhalf_sum(l);
        const float inv = 1.f / l;
        const int f = f0 + wid * 32 + r32, stok = ((f & ((1 << log2L) - 1)) << sh) + (f >> log2L);
        const size_t orow = (size_t)rowbase + stok;
        bf16_t* op = OG + ((size_t)g * CHUNK + orow) * DM + h * 128 + 4 * hi;
#pragma unroll
        for (int d = 0; d < 4; ++d)
#pragma unroll
            for (int g4 = 0; g4 < 4; ++g4) {
                u32x2 w; w.x = cvt_pk_bf16(o[d][4 * g4] * inv, o[d][4 * g4 + 1] * inv); w.y = cvt_pk_bf16(o[d][4 * g4 + 2] * inv, o[d][4 * g4 + 3] * inv);
                *(u32x2*)(op + 32 * d + 8 * g4) = w;
            }
        if (hi == 0) LSE[((size_t)g * CHUNK + orow) * 8 + h] = m + __log2f(l);
    }
}
#undef DIL_DEC
#undef DIL_TILE

#define XB_TMO      128
#define XB_XCNT(j)  (256  + 64 * (j))
#define XB_XSUB(j)  (1280 + 64 * (j))
#define XB_XGEN(j)  (2304 + 64 * (j))
#define XB_TOP      3328
#define XB_TOPGEN   3392
#define XCD_BAR_WORDS 3456
#define XB_SPIN_CAP (1u << 18)

__device__ __forceinline__ unsigned xb_ld(unsigned* p)              { return __hip_atomic_load(p, __ATOMIC_RELAXED, __HIP_MEMORY_SCOPE_AGENT); }
__device__ __forceinline__ unsigned xb_add(unsigned* p, unsigned v) { return __hip_atomic_fetch_add(p, v, __ATOMIC_RELAXED, __HIP_MEMORY_SCOPE_AGENT); }
__device__ __forceinline__ unsigned xb_xcc_id() { return (unsigned)__builtin_amdgcn_s_getreg((3 << 11) | 20) & 0xFu; }
#define XB_SPIN(cond, bar) do { unsigned _sp = 0; while (cond) { __builtin_amdgcn_s_sleep(1); \
    if ((++_sp & 255u) == 0u) { if (xb_ld(&(bar)[XB_TMO])) break; if (_sp > XB_SPIN_CAP) { atomicAdd(&(bar)[XB_TMO], 1u); break; } } } } while (0)

struct XcdBarrier {
    unsigned* bar; unsigned x;
    volatile LAS unsigned* st;
};

__device__ __forceinline__ XcdBarrier xcd_barrier_post(unsigned* bar, volatile LAS unsigned* st) {
    XcdBarrier b; b.bar = bar; b.x = xb_xcc_id(); b.st = st;
    if (threadIdx.x == 0) (void)xb_add(&bar[XB_XCNT(b.x)], 1u);
    return b;
}
__device__ __forceinline__ void xcd_barrier_complete(unsigned* bar, unsigned x, unsigned& nloc, unsigned& nx) {
    const unsigned G = gridDim.x * gridDim.y * gridDim.z;
    unsigned sum, cnt, mine, sp = 0u;
    for (;;) {
        sum = 0u; cnt = 0u; mine = 0u;
#pragma unroll
        for (unsigned j = 0; j < 16; ++j) { const unsigned c = xb_ld(&bar[XB_XCNT(j)]); sum += c; cnt += (c > 0u) ? 1u : 0u; mine = (j == x) ? c : mine; }
        if (sum == G) break;
        __builtin_amdgcn_s_sleep(1);
        if ((++sp & 255u) == 0u) { if (xb_ld(&bar[XB_TMO])) break; if (sp > XB_SPIN_CAP) { atomicAdd(&bar[XB_TMO], 1u); break; } }
    }
    nloc = mine > 0u ? mine : 1u; nx = cnt > 0u ? cnt : 1u;
}

__device__ __forceinline__ void xcd_barrier(const XcdBarrier& b) {
    asm volatile("s_waitcnt vmcnt(0)" ::: "memory");
    __syncthreads();
    if (threadIdx.x == 0) {
        unsigned* bar = b.bar;
        __builtin_amdgcn_s_waitcnt(0);
        unsigned nloc = b.st[0], nx = b.st[1];
        if (nloc == 0u) { xcd_barrier_complete(bar, b.x, nloc, nx); b.st[0] = nloc; b.st[1] = nx; }
        const unsigned old = xb_add(&bar[XB_XSUB(b.x)], 1u);
        const unsigned gen = old / nloc;
        if (old + 1u == (gen + 1u) * nloc) {
            __builtin_amdgcn_fence(__ATOMIC_RELEASE, "agent");
            asm volatile("s_waitcnt vmcnt(0)" ::: "memory");
            const unsigned og = xb_add(&bar[XB_TOP], 1u);
            const unsigned tg = og / nx;
            if (og + 1u == (tg + 1u) * nx) xb_add(&bar[XB_TOPGEN], 1u);
            else XB_SPIN(xb_ld(&bar[XB_TOPGEN]) == tg, bar);
            __builtin_amdgcn_fence(__ATOMIC_ACQUIRE, "agent");
            xb_add(&bar[XB_XGEN(b.x)], 1u);
            asm volatile("s_waitcnt vmcnt(0)" ::: "memory");
        } else {
            XB_SPIN(xb_ld(&bar[XB_XGEN(b.x)]) == gen, bar);
            __builtin_amdgcn_fence(__ATOMIC_ACQUIRE, "agent");
            asm volatile("s_waitcnt vmcnt(0)" ::: "memory");
        }
    }
    __syncthreads();
}

__global__ void __launch_bounds__(512, 2) mega_fwd(Params p) {
    extern __shared__ __attribute__((aligned(16))) unsigned char lds_raw[];
    LAS unsigned char* lds = (LAS unsigned char*)lds_raw;
    const int G0 = gridDim.x, bx0 = blockIdx.x;
#define PH_LOCALS PH_WS; int tid = threadIdx.x; asm volatile("" : "+v"(tid)); const int lane = tid & 63, wave = __builtin_amdgcn_readfirstlane(tid >> 6), gw = bx * 8 + wave; (void)lane; (void)gw
#define PH_WS const __attribute__((address_space(4))) Params* kp = (const __attribute__((address_space(4))) Params*)__builtin_amdgcn_kernarg_segment_ptr(); asm volatile("" : "+s"(kp)); \
        unsigned char* ws = kp->ws; float* X = kp->out; (void)X; int G = G0, bx = bx0; asm volatile("" : "+s"(G), "+s"(bx)); const int NGW = G * 8; (void)NGW
#define XB ((bf16_t*)(ws + WS_XB))
#define OB ((bf16_t*)(ws + WS_O))
#define cosT ((float*)(ws + WS_COS))
#define sinT ((float*)(ws + WS_SIN))
#define BT ((float*)(ws + WS_BT))
#define RQ ((float*)(ws + WS_RQ))
#define RKV ((float*)(ws + WS_RKV))
#define WQKV ((bf16_t*)(ws + WS_WQKV))
#define WOA ((bf16_t*)(ws + WS_WOA))
#define WDKV ((bf16_t*)(ws + WS_WDKV))
#define WUQ ((bf16_t*)(ws + WS_WUQ))
#define WUKV ((bf16_t*)(ws + WS_WUKV))
#define WOB ((bf16_t*)(ws + WS_WOB))
#define WIN ((bf16_t*)(ws + WS_WIN))
#define WOUT ((bf16_t*)(ws + WS_WOUT))
#define QKV ((bf16_t*)(ws + WS_QKV))
#define OG ((bf16_t*)(ws + WS_OG))
#define LSE ((float*)(ws + WS_LSE))
#define CB ((bf16_t*)(ws + WS_C))
#define QB ((bf16_t*)(ws + WS_QB))
#define KVB ((bf16_t*)(ws + WS_KV))
#define KRR ((bf16_t*)(ws + WS_KRR))
#define UB ((bf16_t*)(ws + WS_U))
#define Y1B ((bf16_t*)(ws + WS_S))
#define Y2B ((bf16_t*)(ws + WS_Y2))
#define HB ((bf16_t*)(ws + WS_H))
    cg::grid_group grid = cg::this_grid();
    volatile LAS unsigned* bst = (volatile LAS unsigned*)(lds + LDS_BYTES - 64);
    if (threadIdx.x == 0) { bst[0] = 0u; bst[1] = 0u; }
    __syncthreads();
    const XcdBarrier xbar = xcd_barrier_post((unsigned*)(p.ws + WS_CTL), bst);
    int ph = 0;
    const int lo = p.ph_lo, hi = p.ph_hi;
#define PH_ON (ph >= lo && ph < hi)
#ifndef MK_EN
#define MK_EN 0xffffffffu
#endif
#define EN(k) (((MK_EN) >> (k)) & 1u)
#ifndef MK_REP
#define MK_REP 0u
#endif
#define REPN(k) ((((MK_REP) >> (k)) & 1u) != 0)
#define REPN(k) ((((MK_REP) >> (k)) & 1u) != 0)
#define REP(k) for (int rep_ = 0; rep_ < ((((MK_REP) >> (k)) & 1u) ? 2 : 1); ++rep_)
#define PH_END do { if (ph >= lo && ph + 1 < hi) { if (lo < 0) grid.sync(); else xcd_barrier(xbar); } ++ph; } while (0)

    if (EN(0) && PH_ON) REP(0) {
        PH_LOCALS;
        LAS float* scr = (LAS float*)(lds + wave * 16384);
        constexpr int I_QKV = (DM / 64) * (NQKV / 32), I_O = (DM / 64) * (DM / 32), I_DKV = (DM / 64) * (672 / 32), I_UQ = (NCQ / 64) * (NQ / 32), I_UKV = (NCKV / 64) * (NKV / 32);
        constexpr int I_IN = (DM / 64) * (NFF / 32), I_OUT = (DFF / 64) * (DM / 32);
        constexpr int NITEMS = I_QKV + 2 * I_O + I_DKV + I_UQ + I_UKV + 2 * I_IN + 2 * I_OUT;
        for (int it = gw; it < NITEMS; it += NGW) {
            int r = it;
            if (r < I_QKV) { transpose_item(kp->w_qkv_a, DM, NQKV, WQKV, 0, nullptr, scr, r, lane); continue; } r -= I_QKV;
            if (r < I_O) { transpose_item(kp->w_o_a, DM, DM, WOA, 0, nullptr, scr, r, lane); continue; } r -= I_O;
            if (r < I_O) { transpose_item(kp->w_o_b, DM, DM, WOB, 0, nullptr, scr, r, lane); continue; } r -= I_O;
            if (r < I_DKV) { transpose_item(kp->w_dkv_b, DM, 672, WDKV, 2, nullptr, scr, r, lane); continue; } r -= I_DKV;
            if (r < I_UQ) { transpose_item(kp->w_uq_b, NCQ, NQ, WUQ, 1, kp->g_q_b, scr, r, lane); continue; } r -= I_UQ;
            if (r < I_UKV) { transpose_item(kp->w_ukv_b, NCKV, NKV, WUKV, 0, kp->g_kv_b, scr, r, lane); continue; } r -= I_UKV;
            if (r < 2 * I_IN) { const int ly = r / I_IN; transpose_item(kp->ffn_w_in + (size_t)ly * DM * NFF, DM, NFF, WIN + (size_t)ly * NFF * DM, 0, nullptr, scr, r - ly * I_IN, lane); continue; } r -= 2 * I_IN;
            { const int ly = r / I_OUT; transpose_item(kp->ffn_w_out + (size_t)ly * DFF * DM, DFF, DM, WOUT + (size_t)ly * DM * DFF, 0, nullptr, scr, r - ly * I_OUT, lane); }
        }
        for (int i = bx * 512 + tid; i < 96 * DM / 8; i += G * 512) *((u32x4*)(WDKV + (size_t)672 * DM) + i) = (u32x4){0u, 0u, 0u, 0u};
        for (int r = gw; r < T; r += 2 * NGW) {
            const int r2 = r + NGW; const bool h2 = r2 < T;
            const float* src = r < TP ? kp->x_prompt + (size_t)r * DM : kp->x_sample + (size_t)(r - TP) * DM;
            const float* src2 = r2 < TP ? kp->x_prompt + (size_t)r2 * DM : kp->x_sample + (size_t)((h2 ? r2 : r) - TP) * DM;
            f32x4 va[4], vb[4] = {};
#pragma unroll
            for (int j = 0; j < 4; ++j) { va[j] = *((const f32x4*)src + lane + 64 * j); if (h2) vb[j] = *((const f32x4*)src2 + lane + 64 * j); }
#pragma unroll
            for (int j = 0; j < 4; ++j) {
                u32x2 w; w.x = cvt_pk_bf16(va[j].x, va[j].y); w.y = cvt_pk_bf16(va[j].z, va[j].w);
                *((u32x2*)(XB + (size_t)r * DM) + lane + 64 * j) = w;
                if (h2) { u32x2 w2; w2.x = cvt_pk_bf16(vb[j].x, vb[j].y); w2.y = cvt_pk_bf16(vb[j].z, vb[j].w); *((u32x2*)(XB + (size_t)r2 * DM) + lane + 64 * j) = w2; }
            }
        }
        for (int i = bx * 512 + tid; i < 8192 * 16; i += G * 512) { float c, s; rope_entry(i >> 4, i & 15, c, s); cosT[i] = c; sinT[i] = s; }
        for (int i = bx * 512 + tid; i < 24 * 384; i += G * 512) {
            const int gh = i / 384, d = i % 384 - 192, g = gh >> 3;
            float v = -1e30f;
            if (d >= -64 && d <= 64) v = kp->rel_bias[t5_bucket(d * (1 << (2 * g))) * 24 + gh] * LOG2E;
            BT[i] = v;
        }
    }
    PH_END;

    {
        for (int c = 0; c < NCHUNK; ++c) {
            const int row0 = c * CHUNK, log2S = c < 4 ? 13 : 11, nseq = c < 4 ? 2 : 8;
            if (EN(1) && PH_ON) REP(1) {
                PH_WS;
                pg8::Gemm g{XB + (size_t)row0 * DM, WQKV, CHUNK, NQKV, DM, DM}; pg8::StaticOrder S; S.init(CHUNK, NQKV, G, bx);
                pg8::EpiQKV E{QKV, log2S, 0.08838834764831845f * LOG2E};
                pg8::gemm_phase<pg8::EpiQKV, pg8::StaticOrder>(lds, g, S, E);
            }
            PH_END;
            if (EN(2) && PH_ON) REP(2) { PH_WS; attn_dil_phase(lds, QKV, BT, OG, LSE, nseq, log2S, G, bx); }
            PH_END;
            if (EN(3) && PH_ON) REP(3) {   PH_LOCALS;
                for (int r = gw; r < CHUNK; r += NGW) {
                    const int h = lane >> 3;
                    const float l0 = LSE[((size_t)0 * CHUNK + r) * 8 + h], l1 = LSE[((size_t)1 * CHUNK + r) * 8 + h], l2 = LSE[((size_t)2 * CHUNK + r) * 8 + h];
                    const float mx = fmaxf(l0, fmaxf(l1, l2));
                    float w0 = __builtin_amdgcn_exp2f(l0 - mx), w1 = __builtin_amdgcn_exp2f(l1 - mx), w2 = __builtin_amdgcn_exp2f(l2 - mx);
                    const float inv = 1.f / (w0 + w1 + w2); w0 *= inv; w1 *= inv; w2 *= inv;
#pragma unroll
                    for (int j = 0; j < 2; ++j) {
                        const bf16x8 a = *((const bf16x8*)(OG + ((size_t)0 * CHUNK + r) * DM) + lane * 2 + j), b = *((const bf16x8*)(OG + ((size_t)1 * CHUNK + r) * DM) + lane * 2 + j),
                                     cc = *((const bf16x8*)(OG + ((size_t)2 * CHUNK + r) * DM) + lane * 2 + j);
                        float v[8];
#pragma unroll
                        for (int e = 0; e < 8; ++e) v[e] = w0 * bf2f((unsigned short)a[e]) + w1 * bf2f((unsigned short)b[e]) + w2 * bf2f((unsigned short)cc[e]);
                        u32x4 w; w.x = cvt_pk_bf16(v[0], v[1]); w.y = cvt_pk_bf16(v[2], v[3]); w.z = cvt_pk_bf16(v[4], v[5]); w.w = cvt_pk_bf16(v[6], v[7]);
                        *((u32x4*)(OB + (size_t)(row0 + r) * DM) + lane * 2 + j) = w;
                    }
                }
            }
            if (c + 1 < NCHUNK && MK_MULTI == 0) ++ph; else PH_END;
        }
    }
    for (int layer = 0; layer < 2; ++layer) {
        if (layer == 1) {
            if (EN(4) && PH_ON) REP(4) {
                PH_WS;
                pg8::Gemm g{XB, WDKV, T, CW, DM, DM}; pg8::StaticOrder S; S.init(T, CW, G, bx);
                pg8::EpiStore E{CB, CW, nullptr, 1.f};
                pg8::gemm_phase<pg8::EpiStore, pg8::StaticOrder>(lds, g, S, E);
            }
            PH_END;
            if (EN(5) && PH_ON) REP(5) {   PH_LOCALS;
                for (int r = gw; r < T; r += NGW) {
                    const bf16_t* crow = CB + (size_t)r * CW;
                    const bf16x8 a = *((const bf16x8*)crow + lane);
                    bf16x8 b = {}; if (lane < 20) b = *((const bf16x8*)crow + 64 + lane);
                    float fa[8], fb[8], sa = 0.f, sb = 0.f;
#pragma unroll
                    for (int e = 0; e < 8; ++e) { fa[e] = bf2f((unsigned short)a[e]); fb[e] = bf2f((unsigned short)b[e]); sa += fa[e] * fa[e]; sb += fb[e] * fb[e]; }
                    const float sq = wave_sum(lane < 48 ? sa : 0.f, lane), skv = wave_sum((lane >= 48 ? sa : 0.f) + (lane < 16 ? sb : 0.f), lane);
                    if (lane == 0) { RQ[r] = 1.f / sqrtf(sq * (1.f / NCQ) + RMS_EPS); RKV[r] = 1.f / sqrtf(skv * (1.f / NCKV) + RMS_EPS); }
                    if (lane >= 16 && lane < 20) {
                        const int j = lane - 16, pos = r < TP ? (r & 8191) : (r & 2047);
                        const f32x4 cs = *(const f32x4*)(cosT + pos * 16 + 4 * j), sn = *(const f32x4*)(sinT + pos * 16 + 4 * j);
                        float o1[4], o2[4];
#pragma unroll
                        for (int e = 0; e < 4; ++e) { o1[e] = fb[e] * cs[e] - fb[4 + e] * sn[e]; o2[e] = fb[e] * sn[e] + fb[4 + e] * cs[e]; }
                        u32x4 w; w.x = cvt_pk_bf16(o1[0], o1[1]); w.y = cvt_pk_bf16(o1[2], o1[3]); w.z = cvt_pk_bf16(o2[0], o2[1]); w.w = cvt_pk_bf16(o2[2], o2[3]);
                        *((u32x4*)(KRR + (size_t)r * 32) + j) = w;
                    }
                }
            }
            PH_END;
            if (EN(6) && PH_ON) REP(6) {
                PH_WS;
                { pg8::Gemm g{CB, WUQ, T, NQ, NCQ, CW}; pg8::StaticOrder S; S.init(T, NQ, G, bx);
                  pg8::EpiQRope E{QB, RQ, 0.10206207261596575f * LOG2E, cosT, sinT};
                  pg8::gemm_phase<pg8::EpiQRope, pg8::StaticOrder>(lds, g, S, E); }
                { pg8::Gemm g{CB + NCQ, WUKV, T, NKV, NCKV, CW}; pg8::StaticOrder S; S.init(T, NKV, G, bx);
                  pg8::EpiStore E{KVB, NKV, RKV, 1.f};
                  pg8::gemm_phase<pg8::EpiStore, pg8::StaticOrder>(lds, g, S, E); }
            }
            PH_END;
            if (EN(7) && PH_ON) REP(7) { PH_WS; attn_mla_phase(lds, QB, KVB, KRR, OB, G, bx); }
            PH_END;
        }
        if (EN(8) && PH_ON) REP(8) {
                PH_WS;
            pg8::Gemm g{OB, layer == 0 ? WOA : WOB, T, DM, DM, DM}; pg8::StaticOrder S; S.init(T, DM, G, bx);
            pg8::EpiStore E{Y1B, DM, nullptr, 1.f};
            pg8::gemm_phase<pg8::EpiStore, pg8::StaticOrder>(lds, g, S, E);
        }
        PH_END;
        if (EN(9) && PH_ON) REP(9) { PH_LOCALS; ln_phase(layer == 0 ? kp->x_prompt : X, layer == 0 ? kp->x_sample : X + (size_t)TP * DM, Y1B, (REPN(9) && rep_ == 0) ? (float*)(ws + 560 * MiB) : X, (REPN(9) && rep_ == 0) ? OB : XB, kp->ln_g + (layer * 2 + 0) * DM, kp->ln_b + (layer * 2 + 0) * DM, gw, NGW, lane); }
        PH_END;
        {
            for (int c = 0; c < 3; ++c) {
                const int row0 = c * 32768, crows = c < 2 ? 32768 : 16384, log2S = c < 2 ? 13 : 11;
                if (EN(10) && PH_ON) REP(10) {
                PH_WS;
                    pg8::Gemm g{XB + (size_t)row0 * DM, WIN + (size_t)layer * NFF * DM, crows, NFF, DM, DM}; pg8::StaticOrder S; S.init(crows, NFF, G, bx);
                    pg8::EpiStore E{HB, NFF, nullptr, 1.f};
                    pg8::gemm_phase<pg8::EpiStore, pg8::StaticOrder>(lds, g, S, E);
                }
                PH_END;
                if (EN(11) && PH_ON) REP(11) {   PH_LOCALS;
                    const float* cw = kp->ffn_conv_w + (size_t)layer * 3 * NFF; const float* cb = kp->ffn_conv_b + (size_t)layer * NFF; const bf16_t* H = HB; bf16_t* U = UB;
                    const int nitems = (crows / 8) * 11, smask = (1 << log2S) - 1;
                    for (int it = gw; it < nitems; it += NGW) {
                        const int rr = it / 11, cgp = it - rr * 11, col = (cgp * 64 + lane) * 4, r0 = rr * 8;
                        u32x2 ra[10], rg[10];
                        const bool hp = (r0 & smask) != 0, hn = ((r0 + 8) & smask) != 0;
#pragma unroll
                        for (int i = 0; i < 10; ++i) {
                            const bool ok = (i == 0) ? hp : (i == 9) ? hn : true;
                            if (ok) { ra[i] = *(const u32x2*)(H + (size_t)(r0 - 1 + i) * NFF + col); rg[i] = *(const u32x2*)(H + (size_t)(r0 - 1 + i) * NFF + DFF + col); }
                            else { ra[i] = (u32x2){0u, 0u}; rg[i] = (u32x2){0u, 0u}; }
                        }
                        f32x4 wa[3], wg[3];
#pragma unroll
                        for (int k = 0; k < 3; ++k) { wa[k] = *(const f32x4*)(cw + k * NFF + col); wg[k] = *(const f32x4*)(cw + k * NFF + DFF + col); }
                        const f32x4 ba = *(const f32x4*)(cb + col), bg = *(const f32x4*)(cb + DFF + col);
#define BF4(u) ((f32x4){__uint_as_float((u).x << 16), __uint_as_float((u).x & 0xffff0000u), __uint_as_float((u).y << 16), __uint_as_float((u).y & 0xffff0000u)})
#pragma unroll
                        for (int i = 0; i < 8; ++i) {
                            const f32x4 av = wa[0] * BF4(ra[i]) + wa[1] * BF4(ra[i + 1]) + wa[2] * BF4(ra[i + 2]) + ba;
                            const f32x4 gv = wg[0] * BF4(rg[i]) + wg[1] * BF4(rg[i + 1]) + wg[2] * BF4(rg[i + 2]) + bg;
                            u32x2 w; w.x = cvt_pk_bf16(av[0] * gelu_erf(gv[0]), av[1] * gelu_erf(gv[1])); w.y = cvt_pk_bf16(av[2] * gelu_erf(gv[2]), av[3] * gelu_erf(gv[3]));
                            *(u32x2*)(U + (size_t)(row0 + r0 + i) * DFF + col) = w;
                        }
#undef BF4
                    }
                }
                PH_END;
            }
            if (EN(12) && PH_ON) REP(12) {
                PH_WS;
                pg8::Gemm g{UB, WOUT + (size_t)layer * DM * DFF, T, DM, DFF, DFF}; pg8::StaticOrder S; S.init(T, DM, G, bx);
                pg8::EpiStore E{Y2B, DM, nullptr, 1.f};
                pg8::gemm_phase<pg8::EpiStore, pg8::StaticOrder>(lds, g, S, E);
            }
            PH_END;
            if (EN(13) && PH_ON) REP(13) { PH_LOCALS; ln_phase(X, X + (size_t)TP * DM, Y2B, (REPN(13) && rep_ == 0) ? (float*)(ws + 222 * MiB) : X, (REPN(13) && rep_ == 0) ? (bf16_t*)(ws + 822 * MiB) : XB, kp->ln_g + (layer * 2 + 1) * DM, kp->ln_b + (layer * 2 + 1) * DM, gw, NGW, lane, layer == 0); }
            PH_END;
        }
    }
#undef PH_ON
#undef PH_END
}
constexpr int N_PHASES = 1 + 15 + 2 * (2 + 8) + 4;

extern "C" void kernel_launch(void* const* d_in, const int* in_sizes, int n_in, void* d_out, int out_size, void* d_ws, size_t ws_size, hipStream_t stream) {
    static int grid = 0;
    if (grid == 0) {
        if (n_in != 17 || out_size != T * DM || ws_size < WS_END) { fprintf(stderr, "kernel_launch: unexpected shapes (n_in %d out %d ws %zu)\n", n_in, out_size, ws_size); grid = -1; return; }
        int dev = 0, cus = 0, per_cu = 0;
        if (hipGetDevice(&dev) != hipSuccess || hipDeviceGetAttribute(&cus, hipDeviceAttributeMultiprocessorCount, dev) != hipSuccess) { grid = -1; return; }
        if (hipFuncSetAttribute((const void*)mega_fwd, hipFuncAttributeMaxDynamicSharedMemorySize, LDS_BYTES) != hipSuccess) { fprintf(stderr, "kernel_launch: hipFuncSetAttribute failed\n"); grid = -1; return; }
        if (hipOccupancyMaxActiveBlocksPerMultiprocessor(&per_cu, (const void*)mega_fwd, 512, LDS_BYTES) != hipSuccess || per_cu < 1) { fprintf(stderr, "kernel_launch: occupancy query says %d\n", per_cu); per_cu = 1; }
        (void)hipGetLastError();
        grid = cus * 1;
    }
    if (grid < 0) return;
    if (hipMemsetAsync((char*)d_ws + WS_CTL, 0, CTL_BYTES, stream) != hipSuccess) { fprintf(stderr, "kernel_launch: memset failed\n"); return; }
    Params p{};
    const float** pp = (const float**)&p;
    for (int i = 0; i < 17; ++i) pp[i] = (const float*)d_in[i];
    p.out = (float*)d_out; p.ws = (unsigned char*)d_ws;
#if MK_MULTI
    for (int k = 0; k < N_PHASES; ++k) { p.ph_lo = k; p.ph_hi = k + 1; hipLaunchKernelGGL(mega_fwd, dim3(grid), dim3(512), LDS_BYTES, stream, p); }
#else
    p.ph_lo = 0; p.ph_hi = N_PHASES;
    void* args[] = {&p};
    hipError_t e = hipLaunchCooperativeKernel((const void*)mega_fwd, dim3(grid), dim3(512), args, LDS_BYTES, stream);
    if (e != hipSuccess) fprintf(stderr, "cooperative launch failed: %s (grid %d)\n", hipGetErrorString(e), grid);
#endif
}
```

```cpp
#include <hip/hip_runtime.h>
#include <hip/hip_cooperative_groups.h>
#include <cstdio>
#include <cstdint>
namespace cg = cooperative_groups;

#ifndef MK_MULTI
#define MK_MULTI 0
#endif

#define LAS __attribute__((address_space(3)))
typedef unsigned short bf16_t;
typedef short bf16x8 __attribute__((ext_vector_type(8)));
typedef short s16x4 __attribute__((ext_vector_type(4)));
typedef float f32x4 __attribute__((ext_vector_type(4)));
typedef float f32x2 __attribute__((ext_vector_type(2)));
typedef float f32x16 __attribute__((ext_vector_type(16)));
typedef unsigned u32x4 __attribute__((ext_vector_type(4)));
typedef unsigned u32x2 __attribute__((ext_vector_type(2)));

constexpr int DM = 1024, TP = 65536, TS = 16384, T = TP + TS;
constexpr int NQKV = 9216, DFF = 2816, NFF = 2 * DFF;
constexpr int CW = 768, NCQ = 384, NCKV = 256, NQ = 1536, NKV = 2048;
constexpr int CHUNK = 16384, NCHUNK = 5;
constexpr float ALPHA = 1.4142135623730951f;
constexpr float LOG2E = 1.4426950408889634f;
constexpr float LN_EPS = 1e-5f, RMS_EPS = 1e-6f;

constexpr size_t MiB = 1u << 20;
constexpr size_t WS_COS = 0, WS_SIN = 512 * 1024, WS_BT = 1 * MiB, WS_RQ = 1 * MiB + 256 * 1024, WS_RKV = 1 * MiB + 640 * 1024;
constexpr size_t WS_WQKV = 2 * MiB, WS_WOA = 20 * MiB, WS_WDKV = 22 * MiB, WS_WUQ = 24 * MiB, WS_WUKV = 25 * MiB + 512 * 1024, WS_WOB = 27 * MiB;
constexpr size_t WS_WIN = 29 * MiB, WS_WOUT = 51 * MiB;
constexpr size_t WS_XB = 62 * MiB, WS_O = 222 * MiB, WS_C = 222 * MiB, WS_S = 382 * MiB;
constexpr size_t WS_QKV = WS_S, WS_OG = WS_S + 288 * MiB, WS_LSE = WS_S + 384 * MiB;
constexpr size_t WS_U = WS_O, WS_H = WS_O + 440 * MiB, WS_Y2 = WS_H;
constexpr size_t WS_QB = WS_S, WS_KV = WS_S + 240 * MiB, WS_KRR = WS_S + 560 * MiB;
constexpr size_t WS_CTL = 1016 * MiB, CTL_BYTES = 65536;
constexpr size_t WS_END = WS_CTL + CTL_BYTES;
constexpr int LDS_BYTES = 147456;

__device__ __forceinline__ unsigned cvt_pk_bf16(float lo, float hi) { unsigned r; asm volatile("v_cvt_pk_bf16_f32 %0, %1, %2" : "=v"(r) : "v"(lo), "v"(hi)); return r; }
__device__ __forceinline__ u32x4 pack8(f32x4 v0, f32x4 v1) { u32x4 w; w.x = cvt_pk_bf16(v0[0], v0[1]); w.y = cvt_pk_bf16(v0[2], v0[3]); w.z = cvt_pk_bf16(v1[0], v1[1]); w.w = cvt_pk_bf16(v1[2], v1[3]); return w; }
__device__ __forceinline__ float bf2f(unsigned short b) { return __uint_as_float((unsigned)b << 16); }
__device__ __forceinline__ float wave_sum(float v, int lane) {
#pragma unroll
    for (int o = 1; o < 32; o <<= 1) v += __int_as_float(__builtin_amdgcn_ds_bpermute((lane ^ o) << 2, __float_as_int(v)));
    auto rr = __builtin_amdgcn_permlane32_swap(__float_as_uint(v), __float_as_uint(v), false, false);
    return __uint_as_float(rr[0]) + __uint_as_float(rr[1]);
}

namespace pg8 {
constexpr int BM = 256, BK = 64, HALF = 128, HTB = HALF * BK * 2, STAGE_BYTES = 8 * HTB, NXCD = 8, WGM = 8;
__host__ __device__ __forceinline__ int lds_byte(int r, int c) { const int st = (r >> 4) * 2 + (c >> 5), rr = r & 15, cc = c & 31, ob = rr * 64 + cc * 2; return st * 1024 + (ob ^ (((ob >> 9) & 1) << 5)); }
__host__ __device__ __forceinline__ void stage_rc(int b, int& R, int& C) { const int st = b / 1024, sb = b % 1024, swz = sb ^ (((sb >> 9) & 1) << 5); R = (st >> 1) * 16 + swz / 64; C = (st & 1) * 32 + (swz % 64) / 2; }
__host__ __device__ __forceinline__ int perm32(int rho) { const int n = rho >> 4, i = rho & 15; return 8 * (i >> 2) + 4 * n + (i & 3); }

struct Unit { int pm, pn; };
struct Gemm { const bf16_t* A; const bf16_t* Bt; int M, N, K, lda; };

struct StaticOrder {
    int nM, nN, nwg, G, c;
    __device__ void init(int M, int N, int G_, int c_) { nM = M / BM; nN = N / BM; nwg = nM * nN; G = G_; c = c_; }
    __device__ bool next(int i, Unit& u) const {
        const long L = (long)i * G + c; if (L >= nwg) return false;
        int wgid = (int)L; { const int q = nwg / NXCD, r = nwg % NXCD, xcd = wgid % NXCD, off = wgid / NXCD; wgid = (xcd < r ? xcd * (q + 1) : r * (q + 1) + (xcd - r) * q) + off; }
        const int nig = WGM * nN, gid = wgid / nig, fm = gid * WGM, gsz = (nM - fm) < WGM ? (nM - fm) : WGM;
        u.pm = fm + ((wgid % nig) % gsz); u.pn = (wgid % nig) / gsz; return true;
    }
};

struct EpiStore {
    static constexpr bool PERM = true;
    bf16_t* O; int ldc; const float* rscale; float cscale;
    __device__ __forceinline__ void operator()(const f32x4 (&acc)[2][2][4][2], const Unit& u, int wr, int wc, int fr, int fq) const {
        const int row0 = u.pm * BM + wr * 64 + fr, col0 = u.pn * BM + wc * 32 + 8 * fq;
#pragma unroll
        for (int ai = 0; ai < 2; ++ai)
#pragma unroll
            for (int m = 0; m < 4; ++m) {
                const int row = row0 + ai * HALF + m * 16;
                const float s = rscale ? rscale[row] * cscale : cscale;
                bf16_t* rowp = O + (size_t)row * ldc + col0;
#pragma unroll
                for (int bj = 0; bj < 2; ++bj) *(u32x4*)(rowp + bj * HALF) = pack8(acc[ai][bj][m][0] * s, acc[ai][bj][m][1] * s);
            }
    }
};
struct EpiQRope {
    static constexpr bool PERM = true;
    bf16_t* O; const float* rscale; float cscale; const float* cosT; const float* sinT;
    __device__ __forceinline__ void operator()(const f32x4 (&acc)[2][2][4][2], const Unit& u, int wr, int wc, int fr, int fq) const {
        const int row0 = u.pm * BM + wr * 64 + fr, col0 = u.pn * BM + wc * 32 + 8 * fq;
        int rj[2];
#pragma unroll
        for (int bj = 0; bj < 2; ++bj) { const int w = (col0 + bj * HALF) % 96; rj[bj] = (w >= 64) ? ((w - 64) >> 3) : -1; }
#pragma unroll
        for (int ai = 0; ai < 2; ++ai)
#pragma unroll
            for (int m = 0; m < 4; ++m) {
                const int row = row0 + ai * HALF + m * 16;
                const float s = rscale[row] * cscale;
                const int pos = row < TP ? (row & 8191) : (row & 2047);
                bf16_t* rowp = O + (size_t)row * NQ + col0;
#pragma unroll
                for (int bj = 0; bj < 2; ++bj) {
                    f32x4 v0 = acc[ai][bj][m][0] * s, v1 = acc[ai][bj][m][1] * s;
                    if (rj[bj] >= 0) {
                        const f32x4 cs = *(const f32x4*)(cosT + pos * 16 + 4 * rj[bj]), sn = *(const f32x4*)(sinT + pos * 16 + 4 * rj[bj]);
                        const f32x4 t1 = v0, t2 = v1; v0 = t1 * cs - t2 * sn; v1 = t1 * sn + t2 * cs;
                    }
                    *(u32x4*)(rowp + bj * HALF) = pack8(v0, v1);
                }
            }
    }
};
struct EpiQKV {
    static constexpr bool PERM = true;
    bf16_t* O; int log2S; float qscale;
    __device__ __forceinline__ void operator()(const f32x4 (&acc)[2][2][4][2], const Unit& u, int wr, int wc, int fr, int fq) const {
        const int colt = u.pn * BM, g = colt / 3072, which = (colt - g * 3072) >> 10, sh = 2 * g, log2L = log2S - sh, S = 1 << log2S;
        const float sc = (which == 0) ? qscale : 1.f;
        const int row0 = u.pm * BM + wr * 64 + fr, col0 = colt + wc * 32 + 8 * fq;
#pragma unroll
        for (int ai = 0; ai < 2; ++ai)
#pragma unroll
            for (int m = 0; m < 4; ++m) {
                const int rl = row0 + ai * HALF + m * 16, seq = rl >> log2S, s = rl & (S - 1);
                const int f = ((s & ((1 << sh) - 1)) << log2L) + (s >> sh), drow = (seq << log2S) + f;
                bf16_t* rowp = O + (size_t)drow * NQKV + col0;
#pragma unroll
                for (int bj = 0; bj < 2; ++bj) *(u32x4*)(rowp + bj * HALF) = pack8(acc[ai][bj][m][0] * sc, acc[ai][bj][m][1] * sc);
            }
    }
};
struct EpiRes {
    static constexpr bool PERM = true;
    float* X; float alpha;
    __device__ __forceinline__ void operator()(const f32x4 (&acc)[2][2][4][2], const Unit& u, int wr, int wc, int fr, int fq) const {
        const int row0 = u.pm * BM + wr * 64 + fr, col0 = u.pn * BM + wc * 32 + 8 * fq;
#pragma unroll
        for (int ai = 0; ai < 2; ++ai)
#pragma unroll
            for (int m = 0; m < 4; ++m) {
                float* rowp = X + (size_t)(row0 + ai * HALF + m * 16) * DM + col0;
#pragma unroll
                for (int bj = 0; bj < 2; ++bj) {
                    float* p = rowp + bj * HALF; const f32x4 a = *(const f32x4*)p, b = *(const f32x4*)(p + 4);
                    *(f32x4*)p = a * alpha + acc[ai][bj][m][0]; *(f32x4*)(p + 4) = b * alpha + acc[ai][bj][m][1];
                }
            }
    }
};

template <class Epi, class Sched, bool ALIGN_EPI = true, bool SP2 = true>
__device__ __forceinline__ void gemm_phase(LAS unsigned char* lds, const Gemm g, const Sched& S, const Epi& E) {
    int tid_ = threadIdx.x; asm volatile("" : "+v"(tid_));
    const int tid = tid_, wid = __builtin_amdgcn_readfirstlane(tid >> 6), lane = tid & 63, wr = wid >> 2, wc = wid & 3, fr = lane & 15, fq = lane >> 4;
    const int K = g.K, nt = K / BK, lda = g.lda;
    unsigned voffA[2], voffB[2];
#pragma unroll
    for (int i = 0; i < 2; ++i) { int R, C; stage_rc(tid * 16 + i * 8192, R, C); const int Rb = Epi::PERM ? ((R & ~31) + perm32(R & 31)) : R;
        voffA[i] = (unsigned)(R * lda + C) * 2u; voffB[i] = (unsigned)(Rb * K + C) * 2u; }
    const size_t kstep = (size_t)(BK * 2);
    const size_t hstepA = (size_t)HALF * lda * 2, hstepB = (size_t)HALF * K * 2;
    const size_t tstepA = 2 * hstepA, tstepB = 2 * hstepB;
    const unsigned ldsw = (unsigned)wid * 1024u;
    const int aoff = lds_byte(wr * 64 + fr, fq * 8), boff = lds_byte(wc * 32 + fr, fq * 8);
#define PG8_SA(b, h) (((b) * 2 + (h)) * HTB)
#define PG8_SB(b, h) ((4 + (b) * 2 + (h)) * HTB)
#define PG8_STAGE(bufoff, gbase, voff) do { _Pragma("unroll") for (int _i = 0; _i < 2; ++_i) \
        __builtin_amdgcn_global_load_lds((const unsigned*)((const char*)(gbase) + (voff)[_i]), (LAS unsigned*)(lds + (bufoff) + ldsw + _i * 8192), 16, 0, 0); } while (0)
#define PG8_LDA(dst, b, h) do { _Pragma("unroll") for (int m = 0; m < 4; ++m) _Pragma("unroll") for (int k = 0; k < 2; ++k) dst[m][k] = *(const LAS bf16x8*)(lds + PG8_SA(b, h) + aoff + m * 2048 + k * 1024); } while (0)
#define PG8_LDB(dst, b, h) do { _Pragma("unroll") for (int n = 0; n < 2; ++n) _Pragma("unroll") for (int k = 0; k < 2; ++k) dst[n][k] = *(const LAS bf16x8*)(lds + PG8_SB(b, h) + boff + n * 2048 + k * 1024); } while (0)
#define PG8_MMA(ai, bj, At, Bt) do { __builtin_amdgcn_s_setprio(1); _Pragma("unroll") for (int m = 0; m < 4; ++m) _Pragma("unroll") for (int n = 0; n < 2; ++n) _Pragma("unroll") for (int k = 0; k < 2; ++k) \
        acc[ai][bj][m][n] = __builtin_amdgcn_mfma_f32_16x16x32_bf16(Bt[n][k], At[m][k], acc[ai][bj][m][n], 0, 0, 0); __builtin_amdgcn_s_setprio(0); } while (0)
#define PG8_WAIT_V(n) asm volatile("s_waitcnt vmcnt(" #n ")" ::: "memory")
#define PG8_WAIT_L(n) asm volatile("s_waitcnt lgkmcnt(" #n ")" ::: "memory")
#define PG8_BAR __builtin_amdgcn_s_barrier()
#define PG8_SCHED __builtin_amdgcn_sched_barrier(0)
    Unit cur, nxt; int ui = 0;
    if (!S.next(0, cur)) return;
    f32x4 acc[2][2][4][2];
#pragma unroll
    for (int a = 0; a < 2; ++a)
#pragma unroll
        for (int b = 0; b < 2; ++b)
#pragma unroll
            for (int m = 0; m < 4; ++m)
#pragma unroll
                for (int n = 0; n < 2; ++n) acc[a][b][m][n] = (f32x4){0.f, 0.f, 0.f, 0.f};
    bf16x8 At[4][2], B0[2][2], B1[2][2];
    const char* cA = (const char*)g.A + (size_t)cur.pm * tstepA; const char* cB = (const char*)g.Bt + (size_t)cur.pn * tstepB;
    if constexpr (SP2) {
        PG8_STAGE(PG8_SB(0, 0), cB, voffB); PG8_STAGE(PG8_SB(0, 1), cB + hstepB, voffB); PG8_STAGE(PG8_SA(0, 0), cA, voffA); PG8_STAGE(PG8_SA(0, 1), cA + hstepA, voffA);
        if (wr == 1) PG8_BAR;
        PG8_WAIT_V(2); PG8_BAR;
        PG8_STAGE(PG8_SB(1, 0), cB + kstep, voffB); PG8_STAGE(PG8_SA(1, 0), cA + kstep, voffA); PG8_STAGE(PG8_SB(1, 1), cB + hstepB + kstep, voffB);
        PG8_WAIT_V(6); PG8_BAR;
    }
    for (;;) {
        const bool has_next = S.next(ui + 1, nxt);
        const char* nA = has_next ? (const char*)g.A + (size_t)nxt.pm * tstepA : cA; const char* nB = has_next ? (const char*)g.Bt + (size_t)nxt.pn * tstepB : cB;
        for (int t = 0; t < nt; t += 2) {
            const bool last = (t == nt - 2);
            const char* a1 = cA + (size_t)(t + 1) * kstep;
            const char* a2 = last ? nA : cA + (size_t)(t + 2) * kstep; const char* b2 = last ? nB : cB + (size_t)(t + 2) * kstep;
            const char* a3 = a2 + kstep; const char* b3 = b2 + kstep;
            PG8_LDB(B0, 0, 0); PG8_LDB(B1, 0, 1); PG8_SCHED; PG8_LDA(At, 0, 0); PG8_STAGE(PG8_SA(1, 1), a1 + hstepA, voffA);
            PG8_WAIT_V(8); PG8_WAIT_L(0); PG8_BAR; PG8_MMA(0, 0, At, B0); PG8_MMA(0, 1, At, B1); PG8_BAR; PG8_SCHED;
            PG8_LDA(At, 0, 1); PG8_STAGE(PG8_SB(0, 0), b2, voffB); PG8_STAGE(PG8_SB(0, 1), b2 + hstepB, voffB); PG8_STAGE(PG8_SA(0, 0), a2, voffA);
            PG8_WAIT_V(8); PG8_WAIT_L(0); PG8_BAR; PG8_MMA(1, 0, At, B0); PG8_MMA(1, 1, At, B1); PG8_BAR; PG8_SCHED;
            PG8_LDB(B0, 1, 0); PG8_LDB(B1, 1, 1); PG8_SCHED; PG8_LDA(At, 1, 0); PG8_STAGE(PG8_SA(0, 1), a2 + hstepA, voffA);
            PG8_WAIT_V(8); PG8_WAIT_L(0); PG8_BAR; PG8_MMA(0, 0, At, B0); PG8_MMA(0, 1, At, B1); PG8_BAR; PG8_SCHED;
            PG8_LDA(At, 1, 1); PG8_STAGE(PG8_SB(1, 0), b3, voffB); PG8_STAGE(PG8_SB(1, 1), b3 + hstepB, voffB); PG8_STAGE(PG8_SA(1, 0), a3, voffA);
            PG8_WAIT_V(8); PG8_WAIT_L(0); PG8_BAR; PG8_MMA(1, 0, At, B0); PG8_MMA(1, 1, At, B1); PG8_BAR; PG8_SCHED;
        }
        if constexpr (ALIGN_EPI) { if (wr == 0) PG8_BAR; }
        { int l2 = threadIdx.x; asm volatile("" : "+v"(l2)); l2 &= 63; E(acc, cur, wr, wc, l2 & 15, l2 >> 4); }
        if (!has_next) break;
#pragma unroll
        for (int a = 0; a < 2; ++a)
#pragma unroll
            for (int b = 0; b < 2; ++b)
#pragma unroll
                for (int m = 0; m < 4; ++m)
#pragma unroll
                    for (int n = 0; n < 2; ++n) acc[a][b][m][n] = (f32x4){0.f, 0.f, 0.f, 0.f};
        cur = nxt; cA = nA; cB = nB; ++ui;
        if constexpr (ALIGN_EPI) { if (wr == 1) PG8_BAR; }
    }
    PG8_WAIT_V(0);
    if constexpr (!ALIGN_EPI) { if (wr == 0) PG8_BAR; }
    PG8_BAR;
#undef PG8_SA
#undef PG8_SB
#undef PG8_STAGE
#undef PG8_LDA
#undef PG8_LDB
#undef PG8_MMA
#undef PG8_WAIT_V
#undef PG8_WAIT_L
#undef PG8_BAR
#undef PG8_SCHED
}
}

struct Params {
    const float *x_prompt, *x_sample, *rel_bias, *w_qkv_a, *w_o_a, *w_dkv_b, *g_q_b, *g_kv_b, *w_uq_b, *w_ukv_b, *w_o_b, *ffn_w_in, *ffn_conv_w, *ffn_conv_b, *ffn_w_out, *ln_g, *ln_b;
    float* out; unsigned char* ws;
    int ph_lo, ph_hi;
};

__device__ __forceinline__ int rope_perm32(int i) { const int t = i >> 4, ii = i & 15; return 8 * (ii >> 2) + 4 * t + (ii & 3); }
__device__ __forceinline__ int rowmap(int mode, int n) {
    if (mode == 1) { const int h = n / 96, w = n - h * 96; return w < 64 ? n : h * 96 + 64 + rope_perm32(w - 64); }
    if (mode == 2) { return n < 640 ? n : 640 + rope_perm32(n - 640); }
    return n;
}
__device__ __forceinline__ void transpose_item(const float* W, int K, int N, bf16_t* WT, int mode, const float* kscale, LAS float* scr, int item, int lane) {
    const int nblk = N / 32, kb = item / nblk, nb = item % nblk, k0 = 64 * kb, n0 = 32 * nb;
    const int kr = lane >> 3, c4 = (lane & 7) * 4;
#pragma unroll
    for (int i = 0; i < 8; ++i) { const int kk = kr + 8 * i; f32x4 v = *(const f32x4*)(W + (size_t)(k0 + kk) * N + n0 + c4); if (kscale) v = v * kscale[k0 + kk];
        scr[kk * 33 + c4] = v.x; scr[kk * 33 + c4 + 1] = v.y; scr[kk * 33 + c4 + 2] = v.z; scr[kk * 33 + c4 + 3] = v.w; }
    asm volatile("s_waitcnt lgkmcnt(0)" ::: "memory");
    const int c = lane & 7;
#pragma unroll
    for (int j = 0; j < 4; ++j) { const int n = (lane >> 3) + 8 * j; const LAS float* s = scr + (8 * c) * 33 + n;
        u32x4 o; o.x = cvt_pk_bf16(s[0 * 33], s[1 * 33]); o.y = cvt_pk_bf16(s[2 * 33], s[3 * 33]); o.z = cvt_pk_bf16(s[4 * 33], s[5 * 33]); o.w = cvt_pk_bf16(s[6 * 33], s[7 * 33]);
        *(u32x4*)(WT + (size_t)rowmap(mode, n0 + n) * K + k0 + 8 * c) = o; }
    asm volatile("s_waitcnt lgkmcnt(0)" ::: "memory");
}
__device__ __forceinline__ int t5_bucket(int rel) {
    const int n = rel < 0 ? -rel : rel; const int ret = rel > 0 ? 16 : 0;
    if (n < 8) return ret + n;
    int large = 8 + (int)(__log2f((float)n * 0.125f) * (8.0f / 7.0f));
    if (large > 15) large = 15;
    return ret + large;
}
__device__ __forceinline__ void rope_entry(int pos, int i, float& c, float& s) {
    const double x = -(double)i * (13.287712379549449 / 16.0);
    const double fl = __builtin_floor(x), fr = (x - fl) * 0.6931471805599453;
    double e = 1.0, term = 1.0;
#pragma unroll 1
    for (int k = 1; k < 22; ++k) { term *= fr / (double)k; e += term; }
    const long long bits = (long long)(1023 + (int)fl) << 52;
    const double inv = e * __builtin_bit_cast(double, bits);
    const double ang = (double)pos * inv;
    const double kq = __builtin_rint(ang * 0.6366197723675814);
    double r = __builtin_fma(-kq, 1.5707963267948966, ang); r = __builtin_fma(-kq, 6.123233995736766e-17, r);
    const double r2 = r * r;
    double sp = r * (1.0 + r2 * (-1.0 / 6 + r2 * (1.0 / 120 + r2 * (-1.0 / 5040 + r2 * (1.0 / 362880 + r2 * (-1.0 / 39916800 + r2 * (1.0 / 6227020800.0)))))));
    double cp = 1.0 + r2 * (-0.5 + r2 * (1.0 / 24 + r2 * (-1.0 / 720 + r2 * (1.0 / 40320 + r2 * (-1.0 / 3628800 + r2 * (1.0 / 479001600.0))))));
    const int q = (int)((long long)kq & 3);
    double sv = (q == 0) ? sp : (q == 1) ? cp : (q == 2) ? -sp : -cp;
    double cv = (q == 0) ? cp : (q == 1) ? -sp : (q == 2) ? -cp : sp;
    c = (float)cv; s = (float)sv;
}

__device__ __forceinline__ float gelu_erf(float v) {
    const float av = __builtin_fabsf(v), d = av * 0.2316418882f + 1.0f, t = __builtin_amdgcn_rcpf(d);
    float q = t * 0.5307027145f + (-0.7265760135f); q = q * t + 0.7107068705f; q = q * t + (-0.142248368f); q = q * t + 0.127414796f; q = q * t;
    const float e = __builtin_amdgcn_exp2f((v * v) * (-0.72134752044f));
    const float m = v * (q * e), r = v - m;
    return v < 0.f ? m : r;
}

__device__ __forceinline__ void ln_phase(const float* x0, const float* x1, const bf16_t* Y, float* Xo, bf16_t* XBo, const float* g, const float* b, int gw, int NGW, int lane, bool wb = true) {
    f32x4 gg[4], bb[4];
#pragma unroll
    for (int j = 0; j < 4; ++j) { gg[j] = *((const f32x4*)g + lane + 64 * j); bb[j] = *((const f32x4*)b + lane + 64 * j); }
    f32x4 cx[4]; u32x2 cy[4];
#define LN_LOAD(r, vx, vy) do { const float* src_ = (r) < TP ? x0 + (size_t)(r) * DM : x1 + (size_t)((r) - TP) * DM; \
        _Pragma("unroll") for (int j = 0; j < 4; ++j) { vx[j] = *((const f32x4*)src_ + lane + 64 * j); vy[j] = *((const u32x2*)(Y + (size_t)(r) * DM) + lane + 64 * j); } } while (0)
    if (gw < T) LN_LOAD(gw, cx, cy);
    for (int r = gw; r < T; r += NGW) {
        f32x4 nx[4] = {}; u32x2 ny[4] = {};
        const int rn = r + NGW;
        if (rn < T) LN_LOAD(rn, nx, ny);
        f32x4 v[4]; float s = 0.f;
#pragma unroll
        for (int j = 0; j < 4; ++j) {
            const f32x4 yf = {__uint_as_float(cy[j].x << 16), __uint_as_float(cy[j].x & 0xffff0000u), __uint_as_float(cy[j].y << 16), __uint_as_float(cy[j].y & 0xffff0000u)};
            v[j] = cx[j] * ALPHA + yf; s += (v[j].x + v[j].y) + (v[j].z + v[j].w);
        }
        const float mean = wave_sum(s, lane) * (1.f / DM); float s2 = 0.f;
#pragma unroll
        for (int j = 0; j < 4; ++j) { v[j] = v[j] - mean; s2 += (v[j].x * v[j].x + v[j].y * v[j].y) + (v[j].z * v[j].z + v[j].w * v[j].w); }
        const float rstd = 1.f / sqrtf(wave_sum(s2, lane) * (1.f / DM) + LN_EPS);
#pragma unroll
        for (int j = 0; j < 4; ++j) {
            const f32x4 o = v[j] * rstd * gg[j] + bb[j];
            *((f32x4*)(Xo + (size_t)r * DM) + lane + 64 * j) = o;
            if (wb) { u32x2 w; w.x = cvt_pk_bf16(o.x, o.y); w.y = cvt_pk_bf16(o.z, o.w); *((u32x2*)(XBo + (size_t)r * DM) + lane + 64 * j) = w; }
        }
#pragma unroll
        for (int j = 0; j < 4; ++j) { cx[j] = nx[j]; cy[j] = ny[j]; }
    }
#undef LN_LOAD
}

__device__ __forceinline__ s16x4 tr_read(unsigned addr) { s16x4 r; asm volatile("ds_read_b64_tr_b16 %0, %1" : "=&v"(r) : "v"(addr) : "memory"); return r; }
#define MFMA32(a, b, c) __builtin_amdgcn_mfma_f32_32x32x16_bf16(a, b, c, 0, 0, 0)
__device__ __forceinline__ float xhalf_max(float v) { auto rr = __builtin_amdgcn_permlane32_swap(__float_as_uint(v), __float_as_uint(v), false, false); return fmaxf(__uint_as_float(rr[0]), __uint_as_float(rr[1])); }
__device__ __forceinline__ float xhalf_sum(float v) { auto rr = __builtin_amdgcn_permlane32_swap(__float_as_uint(v), __float_as_uint(v), false, false); return __uint_as_float(rr[0]) + __uint_as_float(rr[1]); }
__device__ __forceinline__ float max3(float a, float b, float c) { float r; asm("v_max3_f32 %0, %1, %2, %3" : "=v"(r) : "v"(a), "v"(b), "v"(c)); return r; }
__device__ __forceinline__ bf16x8 pack_p(const f32x16& p, int j2) {
    u32x4 w; w.x = cvt_pk_bf16(p[8 * j2 + 0], p[8 * j2 + 1]); w.y = cvt_pk_bf16(p[8 * j2 + 2], p[8 * j2 + 3]); w.z = cvt_pk_bf16(p[8 * j2 + 4], p[8 * j2 + 5]); w.w = cvt_pk_bf16(p[8 * j2 + 6], p[8 * j2 + 7]);
    return __builtin_bit_cast(bf16x8, w);
}
__device__ __forceinline__ void pv_tile(f32x16& o, unsigned vaddr, const bf16x8 (&pb)[4]) {
    s16x4 lo[4], hi[4];
#pragma unroll
    for (int k = 0; k < 4; ++k) { lo[k] = tr_read(vaddr + (16 * k) * 64); hi[k] = tr_read(vaddr + (16 * k + 8) * 64); }
    asm volatile("s_waitcnt lgkmcnt(0)" ::: "memory"); __builtin_amdgcn_sched_barrier(0);
#pragma unroll
    for (int k = 0; k < 4; ++k) { const bf16x8 a = (bf16x8){lo[k][0], lo[k][1], lo[k][2], lo[k][3], hi[k][0], hi[k][1], hi[k][2], hi[k][3]}; o = MFMA32(a, pb[k], o); }
}

__device__ __forceinline__ void pv_issue(unsigned vaddr, s16x4 (&lo)[4], s16x4 (&hi)[4]) {
#pragma unroll
    for (int k = 0; k < 4; ++k) { lo[k] = tr_read(vaddr + (16 * k) * 64); hi[k] = tr_read(vaddr + (16 * k + 8) * 64); }
}
__device__ __forceinline__ void pv_mma(f32x16& o, const s16x4 (&lo)[4], const s16x4 (&hi)[4], const bf16x8 (&pb)[4]) {
#pragma unroll
    for (int k = 0; k < 4; ++k) { const bf16x8 a = (bf16x8){lo[k][0], lo[k][1], lo[k][2], lo[k][3], hi[k][0], hi[k][1], hi[k][2], hi[k][3]}; o = MFMA32(a, pb[k], o); }
}
#define MLA_QK_(cur) { const LAS unsigned char* Kb_ = lds + cur * KBUF; s0 = (f32x16){}; s1 = (f32x16){}; \
            _Pragma("unroll") \
            for (int ks = 0; ks < 6; ++ks) { \
                const bf16x8 a0 = *(const LAS bf16x8*)(Kb_ + r32 * 208 + ks * 32 + hi * 16), a1 = *(const LAS bf16x8*)(Kb_ + (32 + r32) * 208 + ks * 32 + hi * 16); \
                s0 = MFMA32(a0, qf[ks], s0); s1 = MFMA32(a1, qf[ks], s1); \
            } }
#define MLA_ROWMAX_() \
            float pa = max3(s0[0], s0[1], s0[2]), pc = max3(s1[0], s1[1], s1[2]); \
            _Pragma("unroll") \
            for (int r = 3; r < 15; r += 2) { pa = max3(pa, s0[r], s0[r + 1]); pc = max3(pc, s1[r], s1[r + 1]); } \
            float pmax = max3(pa, pc, fmaxf(s0[15], s1[15])); \
            pmax = xhalf_max(pmax)
#define MLA_EXPSUM_() { \
            f32x2 pa2 = {0.f, 0.f}, pb2 = {0.f, 0.f}, pc2 = {0.f, 0.f}, pd2 = {0.f, 0.f};     \
            _Pragma("unroll") \
            for (int r = 0; r < 16; ++r) { s0[r] = __builtin_amdgcn_exp2f(s0[r]); s1[r] = __builtin_amdgcn_exp2f(s1[r]); } \
            _Pragma("unroll") \
            for (int r = 0; r < 16; r += 4) { pa2 += (f32x2){s0[r], s0[r + 1]}; pb2 += (f32x2){s0[r + 2], s0[r + 3]}; pc2 += (f32x2){s1[r], s1[r + 1]}; pd2 += (f32x2){s1[r + 2], s1[r + 3]}; } \
            { const f32x2 t2 = (pa2 + pb2) + (pc2 + pd2); ps = t2.x + t2.y; } }
#define MLA_COMPUTE(cur) { \
            f32x16 s0, s1; float ps; \
            MLA_QK_(cur) \
            const unsigned va = trb + cur * VBUF; \
            s16x4 vl0[4], vh0[4]; \
            pv_issue(va, vl0, vh0);    \
            if (slow || j == 0) { \
                MLA_ROWMAX_(); \
                if (__any(pmax - m > (slow ? 8.f : 64.f)) || (j == 0 && __any(pmax < -32.f))) { \
                    const float mn = (j == 0) ? pmax : fmaxf(m, pmax), alpha = (j == 0) ? 1.f : __builtin_amdgcn_exp2f(m - mn); \
                    m = mn; l *= alpha; slow = true; \
                    _Pragma("unroll") \
                    for (int r = 0; r < 16; ++r) { o0[r] *= alpha; o1[r] *= alpha; } \
                } \
                if (slow) { \
                    _Pragma("unroll") \
                    for (int r = 0; r < 16; ++r) { s0[r] -= m; s1[r] -= m; } \
                } \
            } \
            MLA_EXPSUM_() \
            bf16x8 pb[4]; \
            pb[0] = pack_p(s0, 0); pb[1] = pack_p(s0, 1); pb[2] = pack_p(s1, 0); pb[3] = pack_p(s1, 1);     \
            if (!slow && __any(!(ps < 1e30f))) {     \
                MLA_QK_(cur) \
                MLA_ROWMAX_(); \
                const float mn = fmaxf(m, pmax), alpha = __builtin_amdgcn_exp2f(m - mn); \
                m = mn; l *= alpha; slow = true; \
                _Pragma("unroll") \
                for (int r = 0; r < 16; ++r) { o0[r] *= alpha; o1[r] *= alpha; s0[r] -= m; s1[r] -= m; } \
                MLA_EXPSUM_() \
                pb[0] = pack_p(s0, 0); pb[1] = pack_p(s0, 1); pb[2] = pack_p(s1, 0); pb[3] = pack_p(s1, 1); \
            } \
            l += ps; \
            asm volatile("s_waitcnt lgkmcnt(0)" ::: "memory"); __builtin_amdgcn_sched_barrier(0); \
            pv_mma(o0, vl0, vh0, pb); pv_tile(o1, va + 4096, pb); \
            }
__device__ __forceinline__ void attn_mla_phase(LAS unsigned char* lds, const bf16_t* QB, const bf16_t* KV, const bf16_t* KRR, bf16_t* O, int G, int bx) {
    constexpr int KBUF = 64 * 208, VBUF = 8192, VOFF = 2 * KBUF;
    int tid_ = threadIdx.x; asm volatile("" : "+v"(tid_));
    const int tid = tid_, wid = __builtin_amdgcn_readfirstlane(tid >> 6), lane = tid & 63, r32 = lane & 31, hi = lane >> 5;
    const bool xs = (G % 8) == 0;
    const int nslots = xs ? G / 8 : G, slot = xs ? bx / 8 : bx, xcd = xs ? bx % 8 : 0, npx = xs ? 16 : 128;
    const int nent = npx * 40;
    const int skey = tid >> 3, sch = tid & 7, rkey = tid >> 2, rch = tid & 3;
    const int kdst = skey * 208 + sch * 16, rdst = rkey * 208 + 128 + rch * 16, vdst = (sch >> 2) * 4096 + skey * 64 + (sch & 3) * 16;
    const unsigned trb = (unsigned)(size_t)(lds + VOFF) + (unsigned)((4 * hi + ((lane & 15) >> 2)) * 64 + 32 * ((lane >> 4) & 1) + 8 * (lane & 3));
#define MLA_DEC(LI, P) int P##pair, P##qb, P##base, P##S; \
        if ((LI) < npx * 32) { P##pair = xs ? ((LI) >> 5) * 8 + xcd : ((LI) >> 5); P##qb = (LI) & 31; P##base = (P##pair >> 4) * 8192; P##S = 8192; } \
        else { const int l2_ = (LI) - npx * 32; P##pair = xs ? (l2_ >> 3) * 8 + xcd : (l2_ >> 3); P##qb = l2_ & 7; P##base = TP + (P##pair >> 4) * 2048; P##S = 2048; } \
        const int P##h = P##pair & 15; \
        const size_t P##qrow = (size_t)P##base + P##qb * 256 + wid * 32 + r32; \
        const bf16_t* P##qsrc = QB + P##qrow * NQ + P##h * 96 + hi * 8; \
        const bf16_t* P##kn = KV + (size_t)(P##base + skey) * NKV + P##h * 128 + sch * 8; \
        const bf16_t* P##kr = KRR + (size_t)(P##base + rkey) * 32 + rch * 8
    int li = slot;
    if (li >= nent) return;
    bf16x8 qf[6]; bf16x8 ska, sva, sra = {}, skb, svb, srb = {};
    {
        MLA_DEC(li, f_);
#pragma unroll
        for (int ks = 0; ks < 6; ++ks) qf[ks] = *(const bf16x8*)(f_qsrc + ks * 16);
        ska = *(const bf16x8*)f_kn; sva = *(const bf16x8*)(f_kn + 64); if (tid < 256) sra = *(const bf16x8*)f_kr;
        *(LAS bf16x8*)(lds + kdst) = ska; *(LAS bf16x8*)(lds + VOFF + vdst) = sva; if (tid < 256) *(LAS bf16x8*)(lds + rdst) = sra;
        ska = *(const bf16x8*)(f_kn + (size_t)64 * NKV); sva = *(const bf16x8*)(f_kn + (size_t)64 * NKV + 64); if (tid < 256) sra = *(const bf16x8*)(f_kr + 64 * 32);
    }
    __syncthreads();
    for (;;) {
        MLA_DEC(li, c_);
        const int lin = li + nslots; const bool hasn = lin < nent;
        MLA_DEC(hasn ? lin : li, n_);
        const int h = c_h; const size_t qrow = c_qrow;
        f32x16 o0 = {}, o1 = {}; float m = 0.f, l = 0.f; bool slow = false;
        const int NT = c_S / 64;
        const bf16_t* kn_src = c_kn; const bf16_t* kr_src = c_kr;
#define MLA_STEP(cur, SKL, SVL, SRL, SKW, SVW, SRW) { \
            { const bool own_ = j + 2 < NT; const size_t off = (size_t)(own_ ? j + 2 : j + 2 - NT) * 64; const bf16_t* kn_ = own_ ? kn_src : n_kn; const bf16_t* kr_ = own_ ? kr_src : n_kr; \
              SKL = *(const bf16x8*)(kn_ + off * NKV); SVL = *(const bf16x8*)(kn_ + off * NKV + 64); if (tid < 256) SRL = *(const bf16x8*)(kr_ + off * 32); } \
            MLA_COMPUTE(cur) \
            *(LAS bf16x8*)(lds + ((cur) ^ 1) * KBUF + kdst) = SKW; *(LAS bf16x8*)(lds + VOFF + ((cur) ^ 1) * VBUF + vdst) = SVW; if (tid < 256) *(LAS bf16x8*)(lds + ((cur) ^ 1) * KBUF + rdst) = SRW; \
            __syncthreads(); ++j; }
        for (int j = 0; j < NT;) {
            MLA_STEP(0, skb, svb, srb, ska, sva, sra)
            MLA_STEP(1, ska, sva, sra, skb, svb, srb)
        }
#undef MLA_STEP
        if (hasn) {
#pragma unroll
            for (int ks = 0; ks < 6; ++ks) qf[ks] = *(const bf16x8*)(n_qsrc + ks * 16);
        }
        l = xhalf_sum(l);
        const float inv = 1.f / l;
        bf16_t* orow = O + qrow * DM + h * 64 + 4 * hi;
#pragma unroll
        for (int g4 = 0; g4 < 4; ++g4) {
            u32x2 w0, w1;
            w0.x = cvt_pk_bf16(o0[4 * g4] * inv, o0[4 * g4 + 1] * inv); w0.y = cvt_pk_bf16(o0[4 * g4 + 2] * inv, o0[4 * g4 + 3] * inv);
            w1.x = cvt_pk_bf16(o1[4 * g4] * inv, o1[4 * g4 + 1] * inv); w1.y = cvt_pk_bf16(o1[4 * g4 + 2] * inv, o1[4 * g4 + 3] * inv);
            *(u32x2*)(orow + 8 * g4) = w0; *(u32x2*)(orow + 32 + 8 * g4) = w1;
        }
        if (!hasn) break;
        li = lin;
    }
#undef MLA_DEC
}

#undef MLA_COMPUTE
#undef MLA_QK_
#undef MLA_ROWMAX_
#undef MLA_EXPSUM_
__device__ __forceinline__ void attn_dil_phase(LAS unsigned char* lds, const bf16_t* QKV, const float* BT, bf16_t* OG, float* LSE, int nseq, int log2S, int G, int bx) {
    constexpr int KBUF = 64 * 272, VBUF = 16384, VOFF = 2 * KBUF, TOFF = VOFF + 2 * VBUF;
    int tid_ = threadIdx.x; asm volatile("" : "+v"(tid_));
    const int tid = tid_, wid = __builtin_amdgcn_readfirstlane(tid >> 6), lane = tid & 63, r32 = lane & 31, hi = lane >> 5;
    const int S = 1 << log2S, nqb = S >> 8, nunits = nseq * 24 * nqb;
    const int key0 = tid >> 4, ch0 = tid & 15;
    const int kdst = key0 * 272 + ch0 * 16, vdst = (ch0 >> 2) * 4096 + key0 * 64 + (ch0 & 3) * 16;
    const unsigned trb = (unsigned)(size_t)(lds + VOFF) + (unsigned)((4 * hi + ((lane & 15) >> 2)) * 64 + 32 * ((lane >> 4) & 1) + 8 * (lane & 3));
    LAS float* tab = (LAS float*)(lds + TOFF);
#define DIL_DEC(uu, P) const int P##qb = (uu) % nqb; int P##rest = (uu) / nqb; const int P##h = P##rest & 7; P##rest >>= 3; const int P##g = P##rest % 3, P##seq = P##rest / 3; \
        const int P##f0 = P##qb * 256, P##rowbase = P##seq << log2S, P##tlo = (P##f0 == 0) ? 1 : 0; \
        const bf16_t* P##qsrc = QKV + ((size_t)P##rowbase + P##f0 + wid * 32 + r32) * NQKV + P##g * 3072 + P##h * 128 + hi * 8; \
        const bf16_t* P##ksrc = QKV + (long)(P##rowbase + P##f0 - 64 + key0) * NQKV + P##g * 3072 + 1024 + P##h * 128 + ch0 * 8; \
        const float* P##tsrc = BT + (P##g * 8 + P##h) * 384 + (tid < 384 ? tid : 0)
#define DIL_TILE(src, t) do { const bf16_t* p_ = (src) + (size_t)((t) * 64) * NQKV; k0r = *(const bf16x8*)p_; v0r = *(const bf16x8*)(p_ + 1024); k1r = *(const bf16x8*)(p_ + (size_t)32 * NQKV); v1r = *(const bf16x8*)(p_ + (size_t)32 * NQKV + 1024); } while (0)
    bf16x8 qn[8] = {}, k0r = {}, k1r = {}, v0r = {}, v1r = {}; float tabv = 0.f;
    if (bx < nunits) {
        DIL_DEC(bx, a_);
#pragma unroll
        for (int ks = 0; ks < 8; ++ks) qn[ks] = *(const bf16x8*)(a_qsrc + ks * 16);
        DIL_TILE(a_ksrc, a_tlo); tabv = *a_tsrc;
    }
    for (int u = bx; u < nunits; u += G) {
        DIL_DEC(u, c_);
        const int h = c_h, g = c_g, f0 = c_f0, rowbase = c_rowbase, tlo = c_tlo;
        const int sh = 2 * g, log2L = log2S - sh;
        bf16x8 qf[8];
#pragma unroll
        for (int ks = 0; ks < 8; ++ks) qf[ks] = qn[ks];
        if (tid < 384) tab[tid] = tabv;
        f32x16 o[4] = {}; float m = -1e30f, l = 0.f;
        const int thi = (f0 + 256 >= S) ? 4 : 5;
        const int wt0 = wid >> 1, myblk = (f0 + 32 * wid) >> log2L;
        const bf16_t* ksrc = c_ksrc;
        const int tbase = 128 - 32 * wid - r32 + 4 * hi;
        *(LAS bf16x8*)(lds + kdst) = k0r; *(LAS bf16x8*)(lds + kdst + 32 * 272) = k1r; *(LAS bf16x8*)(lds + VOFF + vdst) = v0r; *(LAS bf16x8*)(lds + VOFF + vdst + 32 * 64) = v1r;
        const int un = u + G; const bool hasn = un < nunits;
        DIL_DEC(hasn ? un : u, n_);
        if (hasn) {
#pragma unroll
            for (int ks = 0; ks < 8; ++ks) qn[ks] = *(const bf16x8*)(n_qsrc + ks * 16);
            tabv = *n_tsrc;
        }
        __syncthreads();
        for (int t = tlo; t <= thi; ++t) {
            const int cur = (t - tlo) & 1;
            if (t < thi) DIL_TILE(ksrc, t + 1); else if (hasn) DIL_TILE(n_ksrc, n_tlo);
            const int fk0 = f0 - 64 + 64 * t;
            if (t >= wt0 && t <= wt0 + 2 && (fk0 >> log2L) == myblk) {
                const LAS unsigned char* Kb = lds + cur * KBUF;
                f32x16 s0 = {}, s1 = {};
#pragma unroll
                for (int ks = 0; ks < 8; ++ks) {
                    const bf16x8 a0 = *(const LAS bf16x8*)(Kb + r32 * 272 + ks * 32 + hi * 16), a1 = *(const LAS bf16x8*)(Kb + (32 + r32) * 272 + ks * 32 + hi * 16);
                    s0 = MFMA32(a0, qf[ks], s0); s1 = MFMA32(a1, qf[ks], s1);
                }
                const LAS float* tb = tab + tbase + 64 * t;
#pragma unroll
                for (int r = 0; r < 16; ++r) { s0[r] += tb[(r & 3) + 8 * (r >> 2)]; s1[r] += tb[32 + (r & 3) + 8 * (r >> 2)]; }
                float pmax = s0[0];
#pragma unroll
                for (int r = 1; r < 16; ++r) pmax = fmaxf(pmax, s0[r]);
#pragma unroll
                for (int r = 0; r < 16; ++r) pmax = fmaxf(pmax, s1[r]);
                pmax = xhalf_max(pmax);
                if (__any(pmax > m + 8.f)) {
                    const float mn = fmaxf(m, pmax), alpha = __builtin_amdgcn_exp2f(m - mn);
                    m = mn; l *= alpha;
#pragma unroll
                    for (int d = 0; d < 4; ++d)
#pragma unroll
                        for (int r = 0; r < 16; ++r) o[d][r] *= alpha;
                }
                float ps = 0.f;
#pragma unroll
                for (int r = 0; r < 16; ++r) { s0[r] = __builtin_amdgcn_exp2f(s0[r] - m); s1[r] = __builtin_amdgcn_exp2f(s1[r] - m); ps += s0[r] + s1[r]; }
                l += ps;
                bf16x8 pb[4];
                pb[0] = pack_p(s0, 0); pb[1] = pack_p(s0, 1); pb[2] = pack_p(s1, 0); pb[3] = pack_p(s1, 1);
                const unsigned va = trb + cur * VBUF;
                pv_tile(o[0], va, pb); pv_tile(o[1], va + 4096, pb); pv_tile(o[2], va + 8192, pb); pv_tile(o[3], va + 12288, pb);
            }
            if (t < thi) {
                const int nb = cur ^ 1;
                *(LAS bf16x8*)(lds + nb * KBUF + kdst) = k0r; *(LAS bf16x8*)(lds + nb * KBUF + kdst + 32 * 272) = k1r;
                *(LAS bf16x8*)(lds + VOFF + nb * VBUF + vdst) = v0r; *(LAS bf16x8*)(lds + VOFF + nb * VBUF + vdst + 32 * 64) = v1r;
            }
            __syncthreads();
        }
        l = xhalf_sum(l);
        const float inv = 1.f / l;
        const int f = f0 + wid * 32 + r32, stok = ((f & ((1 << log2L) - 1)) << sh) + (f >> log2L);
        const size_t orow = (size_t)rowbase + stok;
        bf16_t* op = OG + ((size_t)g * CHUNK + orow) * DM + h * 128 + 4 * hi;
#pragma unroll
        for (int d = 0; d < 4; ++d)
#pragma unroll
            for (int g4 = 0; g4 < 4; ++g4) {
                u32x2 w; w.x = cvt_pk_bf16(o[d][4 * g4] * inv, o[d][4 * g4 + 1] * inv); w.y = cvt_pk_bf16(o[d][4 * g4 + 2] * inv, o[d][4 * g4 + 3] * inv);
                *(u32x2*)(op + 32 * d + 8 * g4) = w;
            }
        if (hi == 0) LSE[((size_t)g * CHUNK + orow) * 8 + h] = m + __log2f(l);
    }
}
#undef DIL_DEC
#undef DIL_TILE

#define XB_TMO      128
#define XB_XCNT(j)  (256  + 64 * (j))
#define XB_XSUB(j)  (1280 + 64 * (j))
#define XB_XGEN(j)  (2304 + 64 * (j))
#define XB_TOP      3328
#define XB_TOPGEN   3392
#define XCD_BAR_WORDS 3456
#define XB_SPIN_CAP (1u << 18)

__device__ __forceinline__ unsigned xb_ld(unsigned* p)              { return __hip_atomic_load(p, __ATOMIC_RELAXED, __HIP_MEMORY_SCOPE_AGENT); }
__device__ __forceinline__ unsigned xb_add(unsigned* p, unsigned v) { return __hip_atomic_fetch_add(p, v, __ATOMIC_RELAXED, __HIP_MEMORY_SCOPE_AGENT); }
__device__ __forceinline__ unsigned xb_xcc_id() { return (unsigned)__builtin_amdgcn_s_getreg((3 << 11) | 20) & 0xFu; }
#define XB_SPIN(cond, bar) do { unsigned _sp = 0; while (cond) { __builtin_amdgcn_s_sleep(1); \
    if ((++_sp & 255u) == 0u) { if (xb_ld(&(bar)[XB_TMO])) break; if (_sp > XB_SPIN_CAP) { atomicAdd(&(bar)[XB_TMO], 1u); break; } } } } while (0)

struct XcdBarrier {
    unsigned* bar; unsigned x;
    volatile LAS unsigned* st;
};

__device__ __forceinline__ XcdBarrier xcd_barrier_post(unsigned* bar, volatile LAS unsigned* st) {
    XcdBarrier b; b.bar = bar; b.x = xb_xcc_id(); b.st = st;
    if (threadIdx.x == 0) (void)xb_add(&bar[XB_XCNT(b.x)], 1u);
    return b;
}
__device__ __forceinline__ void xcd_barrier_complete(unsigned* bar, unsigned x, unsigned& nloc, unsigned& nx) {
    const unsigned G = gridDim.x * gridDim.y * gridDim.z;
    unsigned sum, cnt, mine, sp = 0u;
    for (;;) {
        sum = 0u; cnt = 0u; mine = 0u;
#pragma unroll
        for (unsigned j = 0; j < 16; ++j) { const unsigned c = xb_ld(&bar[XB_XCNT(j)]); sum += c; cnt += (c > 0u) ? 1u : 0u; mine = (j == x) ? c : mine; }
        if (sum == G) break;
        __builtin_amdgcn_s_sleep(1);
        if ((++sp & 255u) == 0u) { if (xb_ld(&bar[XB_TMO])) break; if (sp > XB_SPIN_CAP) { atomicAdd(&bar[XB_TMO], 1u); break; } }
    }
    nloc = mine > 0u ? mine : 1u; nx = cnt > 0u ? cnt : 1u;
}

__device__ __forceinline__ void xcd_barrier(const XcdBarrier& b) {
    asm volatile("s_waitcnt vmcnt(0)" ::: "memory");
    __syncthreads();
    if (threadIdx.x == 0) {
        unsigned* bar = b.bar;
        __builtin_amdgcn_s_waitcnt(0);
        unsigned nloc = b.st[0], nx = b.st[1];
        if (nloc == 0u) { xcd_barrier_complete(bar, b.x, nloc, nx); b.st[0] = nloc; b.st[1] = nx; }
        const unsigned old = xb_add(&bar[XB_XSUB(b.x)], 1u);
        const unsigned gen = old / nloc;
        if (old + 1u == (gen + 1u) * nloc) {
            __builtin_amdgcn_fence(__ATOMIC_RELEASE, "agent");
            asm volatile("s_waitcnt vmcnt(0)" ::: "memory");
            const unsigned og = xb_add(&bar[XB_TOP], 1u);
            const unsigned tg = og / nx;
            if (og + 1u == (tg + 1u) * nx) xb_add(&bar[XB_TOPGEN], 1u);
            else XB_SPIN(xb_ld(&bar[XB_TOPGEN]) == tg, bar);
            __builtin_amdgcn_fence(__ATOMIC_ACQUIRE, "agent");
            xb_add(&bar[XB_XGEN(b.x)], 1u);
            asm volatile("s_waitcnt vmcnt(0)" ::: "memory");
        } else {
            XB_SPIN(xb_ld(&bar[XB_XGEN(b.x)]) == gen, bar);
            __builtin_amdgcn_fence(__ATOMIC_ACQUIRE, "agent");
            asm volatile("s_waitcnt vmcnt(0)" ::: "memory");
        }
    }
    __syncthreads();
}

__global__ void __launch_bounds__(512, 2) mega_fwd(Params p) {
    extern __shared__ __attribute__((aligned(16))) unsigned char lds_raw[];
    LAS unsigned char* lds = (LAS unsigned char*)lds_raw;
    const int G0 = gridDim.x, bx0 = blockIdx.x;
#define PH_LOCALS PH_WS; int tid = threadIdx.x; asm volatile("" : "+v"(tid)); const int lane = tid & 63, wave = __builtin_amdgcn_readfirstlane(tid >> 6), gw = bx * 8 + wave; (void)lane; (void)gw
#define PH_WS const __attribute__((address_space(4))) Params* kp = (const __attribute__((address_space(4))) Params*)__builtin_amdgcn_kernarg_segment_ptr(); asm volatile("" : "+s"(kp)); \
        unsigned char* ws = kp->ws; float* X = kp->out; (void)X; int G = G0, bx = bx0; asm volatile("" : "+s"(G), "+s"(bx)); const int NGW = G * 8; (void)NGW
#define XB ((bf16_t*)(ws + WS_XB))
#define OB ((bf16_t*)(ws + WS_O))
#define cosT ((float*)(ws + WS_COS))
#define sinT ((float*)(ws + WS_SIN))
#define BT ((float*)(ws + WS_BT))
#define RQ ((float*)(ws + WS_RQ))
#define RKV ((float*)(ws + WS_RKV))
#define WQKV ((bf16_t*)(ws + WS_WQKV))
#define WOA ((bf16_t*)(ws + WS_WOA))
#define WDKV ((bf16_t*)(ws + WS_WDKV))
#define WUQ ((bf16_t*)(ws + WS_WUQ))
#define WUKV ((bf16_t*)(ws + WS_WUKV))
#define WOB ((bf16_t*)(ws + WS_WOB))
#define WIN ((bf16_t*)(ws + WS_WIN))
#define WOUT ((bf16_t*)(ws + WS_WOUT))
#define QKV ((bf16_t*)(ws + WS_QKV))
#define OG ((bf16_t*)(ws + WS_OG))
#define LSE ((float*)(ws + WS_LSE))
#define CB ((bf16_t*)(ws + WS_C))
#define QB ((bf16_t*)(ws + WS_QB))
#define KVB ((bf16_t*)(ws + WS_KV))
#define KRR ((bf16_t*)(ws + WS_KRR))
#define UB ((bf16_t*)(ws + WS_U))
#define Y1B ((bf16_t*)(ws + WS_S))
#define Y2B ((bf16_t*)(ws + WS_Y2))
#define HB ((bf16_t*)(ws + WS_H))
    cg::grid_group grid = cg::this_grid();
    volatile LAS unsigned* bst = (volatile LAS unsigned*)(lds + LDS_BYTES - 64);
    if (threadIdx.x == 0) { bst[0] = 0u; bst[1] = 0u; }
    __syncthreads();
    const XcdBarrier xbar = xcd_barrier_post((unsigned*)(p.ws + WS_CTL), bst);
    int ph = 0;
    const int lo = p.ph_lo, hi = p.ph_hi;
#define PH_ON (ph >= lo && ph < hi)
#ifndef MK_EN
#define MK_EN 0xffffffffu
#endif
#define EN(k) (((MK_EN) >> (k)) & 1u)
#ifndef MK_REP
#define MK_REP 0u
#endif
#define REPN(k) ((((MK_REP) >> (k)) & 1u) != 0)
#define REPN(k) ((((MK_REP) >> (k)) & 1u) != 0)
#define REP(k) for (int rep_ = 0; rep_ < ((((MK_REP) >> (k)) & 1u) ? 2 : 1); ++rep_)
#define PH_END do { if (ph >= lo && ph + 1 < hi) { if (lo < 0) grid.sync(); else xcd_barrier(xbar); } ++ph; } while (0)

    if (EN(0) && PH_ON) REP(0) {
        PH_LOCALS;
        LAS float* scr = (LAS float*)(lds + wave * 16384);
        constexpr int I_QKV = (DM / 64) * (NQKV / 32), I_O = (DM / 64) * (DM / 32), I_DKV = (DM / 64) * (672 / 32), I_UQ = (NCQ / 64) * (NQ / 32), I_UKV = (NCKV / 64) * (NKV / 32);
        constexpr int I_IN = (DM / 64) * (NFF / 32), I_OUT = (DFF / 64) * (DM / 32);
        constexpr int NITEMS = I_QKV + 2 * I_O + I_DKV + I_UQ + I_UKV + 2 * I_IN + 2 * I_OUT;
        for (int it = gw; it < NITEMS; it += NGW) {
            int r = it;
            if (r < I_QKV) { transpose_item(kp->w_qkv_a, DM, NQKV, WQKV, 0, nullptr, scr, r, lane); continue; } r -= I_QKV;
            if (r < I_O) { transpose_item(kp->w_o_a, DM, DM, WOA, 0, nullptr, scr, r, lane); continue; } r -= I_O;
            if (r < I_O) { transpose_item(kp->w_o_b, DM, DM, WOB, 0, nullptr, scr, r, lane); continue; } r -= I_O;
            if (r < I_DKV) { transpose_item(kp->w_dkv_b, DM, 672, WDKV, 2, nullptr, scr, r, lane); continue; } r -= I_DKV;
            if (r < I_UQ) { transpose_item(kp->w_uq_b, NCQ, NQ, WUQ, 1, kp->g_q_b, scr, r, lane); continue; } r -= I_UQ;
            if (r < I_UKV) { transpose_item(kp->w_ukv_b, NCKV, NKV, WUKV, 0, kp->g_kv_b, scr, r, lane); continue; } r -= I_UKV;
            if (r < 2 * I_IN) { const int ly = r / I_IN; transpose_item(kp->ffn_w_in + (size_t)ly * DM * NFF, DM, NFF, WIN + (size_t)ly * NFF * DM, 0, nullptr, scr, r - ly * I_IN, lane); continue; } r -= 2 * I_IN;
            { const int ly = r / I_OUT; transpose_item(kp->ffn_w_out + (size_t)ly * DFF * DM, DFF, DM, WOUT + (size_t)ly * DM * DFF, 0, nullptr, scr, r - ly * I_OUT, lane); }
        }
        for (int i = bx * 512 + tid; i < 96 * DM / 8; i += G * 512) *((u32x4*)(WDKV + (size_t)672 * DM) + i) = (u32x4){0u, 0u, 0u, 0u};
        for (int r = gw; r < T; r += 2 * NGW) {
            const int r2 = r + NGW; const bool h2 = r2 < T;
            const float* src = r < TP ? kp->x_prompt + (size_t)r * DM : kp->x_sample + (size_t)(r - TP) * DM;
            const float* src2 = r2 < TP ? kp->x_prompt + (size_t)r2 * DM : kp->x_sample + (size_t)((h2 ? r2 : r) - TP) * DM;
            f32x4 va[4], vb[4] = {};
#pragma unroll
            for (int j = 0; j < 4; ++j) { va[j] = *((const f32x4*)src + lane + 64 * j); if (h2) vb[j] = *((const f32x4*)src2 + lane + 64 * j); }
#pragma unroll
            for (int j = 0; j < 4; ++j) {
                u32x2 w; w.x = cvt_pk_bf16(va[j].x, va[j].y); w.y = cvt_pk_bf16(va[j].z, va[j].w);
                *((u32x2*)(XB + (size_t)r * DM) + lane + 64 * j) = w;
                if (h2) { u32x2 w2; w2.x = cvt_pk_bf16(vb[j].x, vb[j].y); w2.y = cvt_pk_bf16(vb[j].z, vb[j].w); *((u32x2*)(XB + (size_t)r2 * DM) + lane + 64 * j) = w2; }
            }
        }
        for (int i = bx * 512 + tid; i < 8192 * 16; i += G * 512) { float c, s; rope_entry(i >> 4, i & 15, c, s); cosT[i] = c; sinT[i] = s; }
        for (int i = bx * 512 + tid; i < 24 * 384; i += G * 512) {
            const int gh = i / 384, d = i % 384 - 192, g = gh >> 3;
            float v = -1e30f;
            if (d >= -64 && d <= 64) v = kp->rel_bias[t5_bucket(d * (1 << (2 * g))) * 24 + gh] * LOG2E;
            BT[i] = v;
        }
    }
    PH_END;

    {
        for (int c = 0; c < NCHUNK; ++c) {
            const int row0 = c * CHUNK, log2S = c < 4 ? 13 : 11, nseq = c < 4 ? 2 : 8;
            if (EN(1) && PH_ON) REP(1) {
                PH_WS;
                pg8::Gemm g{XB + (size_t)row0 * DM, WQKV, CHUNK, NQKV, DM, DM}; pg8::StaticOrder S; S.init(CHUNK, NQKV, G, bx);
                pg8::EpiQKV E{QKV, log2S, 0.08838834764831845f * LOG2E};
                pg8::gemm_phase<pg8::EpiQKV, pg8::StaticOrder>(lds, g, S, E);
            }
            PH_END;
            if (EN(2) && PH_ON) REP(2) { PH_WS; attn_dil_phase(lds, QKV, BT, OG, LSE, nseq, log2S, G, bx); }
            PH_END;
            if (EN(3) && PH_ON) REP(3) {   PH_LOCALS;
                for (int r = gw; r < CHUNK; r += NGW) {
                    const int h = lane >> 3;
                    const float l0 = LSE[((size_t)0 * CHUNK + r) * 8 + h], l1 = LSE[((size_t)1 * CHUNK + r) * 8 + h], l2 = LSE[((size_t)2 * CHUNK + r) * 8 + h];
                    const float mx = fmaxf(l0, fmaxf(l1, l2));
                    float w0 = __builtin_amdgcn_exp2f(l0 - mx), w1 = __builtin_amdgcn_exp2f(l1 - mx), w2 = __builtin_amdgcn_exp2f(l2 - mx);
                    const float inv = 1.f / (w0 + w1 + w2); w0 *= inv; w1 *= inv; w2 *= inv;
#pragma unroll
                    for (int j = 0; j < 2; ++j) {
                        const bf16x8 a = *((const bf16x8*)(OG + ((size_t)0 * CHUNK + r) * DM) + lane * 2 + j), b = *((const bf16x8*)(OG + ((size_t)1 * CHUNK + r) * DM) + lane * 2 + j),
                                     cc = *((const bf16x8*)(OG + ((size_t)2 * CHUNK + r) * DM) + lane * 2 + j);
                        float v[8];
#pragma unroll
                        for (int e = 0; e < 8; ++e) v[e] = w0 * bf2f((unsigned short)a[e]) + w1 * bf2f((unsigned short)b[e]) + w2 * bf2f((unsigned short)cc[e]);
                        u32x4 w; w.x = cvt_pk_bf16(v[0], v[1]); w.y = cvt_pk_bf16(v[2], v[3]); w.z = cvt_pk_bf16(v[4], v[5]); w.w = cvt_pk_bf16(v[6], v[7]);
                        *((u32x4*)(OB + (size_t)(row0 + r) * DM) + lane * 2 + j) = w;
                    }
                }
            }
            if (c + 1 < NCHUNK && MK_MULTI == 0) ++ph; else PH_END;
        }
    }
    for (int layer = 0; layer < 2; ++layer) {
        if (layer == 1) {
            if (EN(4) && PH_ON) REP(4) {
                PH_WS;
                pg8::Gemm g{XB, WDKV, T, CW, DM, DM}; pg8::StaticOrder S; S.init(T, CW, G, bx);
                pg8::EpiStore E{CB, CW, nullptr, 1.f};
                pg8::gemm_phase<pg8::EpiStore, pg8::StaticOrder>(lds, g, S, E);
            }
            PH_END;
            if (EN(5) && PH_ON) REP(5) {   PH_LOCALS;
                for (int r = gw; r < T; r += NGW) {
                    const bf16_t* crow = CB + (size_t)r * CW;
                    const bf16x8 a = *((const bf16x8*)crow + lane);
                    bf16x8 b = {}; if (lane < 20) b = *((const bf16x8*)crow + 64 + lane);
                    float fa[8], fb[8], sa = 0.f, sb = 0.f;
#pragma unroll
                    for (int e = 0; e < 8; ++e) { fa[e] = bf2f((unsigned short)a[e]); fb[e] = bf2f((unsigned short)b[e]); sa += fa[e] * fa[e]; sb += fb[e] * fb[e]; }
                    const float sq = wave_sum(lane < 48 ? sa : 0.f, lane), skv = wave_sum((lane >= 48 ? sa : 0.f) + (lane < 16 ? sb : 0.f), lane);
                    if (lane == 0) { RQ[r] = 1.f / sqrtf(sq * (1.f / NCQ) + RMS_EPS); RKV[r] = 1.f / sqrtf(skv * (1.f / NCKV) + RMS_EPS); }
                    if (lane >= 16 && lane < 20) {
                        const int j = lane - 16, pos = r < TP ? (r & 8191) : (r & 2047);
                        const f32x4 cs = *(const f32x4*)(cosT + pos * 16 + 4 * j), sn = *(const f32x4*)(sinT + pos * 16 + 4 * j);
                        float o1[4], o2[4];
#pragma unroll
                        for (int e = 0; e < 4; ++e) { o1[e] = fb[e] * cs[e] - fb[4 + e] * sn[e]; o2[e] = fb[e] * sn[e] + fb[4 + e] * cs[e]; }
                        u32x4 w; w.x = cvt_pk_bf16(o1[0], o1[1]); w.y = cvt_pk_bf16(o1[2], o1[3]); w.z = cvt_pk_bf16(o2[0], o2[1]); w.w = cvt_pk_bf16(o2[2], o2[3]);
                        *((u32x4*)(KRR + (size_t)r * 32) + j) = w;
                    }
                }
            }
            PH_END;
            if (EN(6) && PH_ON) REP(6) {
                PH_WS;
                { pg8::Gemm g{CB, WUQ, T, NQ, NCQ, CW}; pg8::StaticOrder S; S.init(T, NQ, G, bx);
                  pg8::EpiQRope E{QB, RQ, 0.10206207261596575f * LOG2E, cosT, sinT};
                  pg8::gemm_phase<pg8::EpiQRope, pg8::StaticOrder>(lds, g, S, E); }
                { pg8::Gemm g{CB + NCQ, WUKV, T, NKV, NCKV, CW}; pg8::StaticOrder S; S.init(T, NKV, G, bx);
                  pg8::EpiStore E{KVB, NKV, RKV, 1.f};
                  pg8::gemm_phase<pg8::EpiStore, pg8::StaticOrder>(lds, g, S, E); }
            }
            PH_END;
            if (EN(7) && PH_ON) REP(7) { PH_WS; attn_mla_phase(lds, QB, KVB, KRR, OB, G, bx); }
            PH_END;
        }
        if (EN(8) && PH_ON) REP(8) {
                PH_WS;
            pg8::Gemm g{OB, layer == 0 ? WOA : WOB, T, DM, DM, DM}; pg8::StaticOrder S; S.init(T, DM, G, bx);
            pg8::EpiStore E{Y1B, DM, nullptr, 1.f};
            pg8::gemm_phase<pg8::EpiStore, pg8::StaticOrder>(lds, g, S, E);
        }
        PH_END;
        if (EN(9) && PH_ON) REP(9) { PH_LOCALS; ln_phase(layer == 0 ? kp->x_prompt : X, layer == 0 ? kp->x_sample : X + (size_t)TP * DM, Y1B, (REPN(9) && rep_ == 0) ? (float*)(ws + 560 * MiB) : X, (REPN(9) && rep_ == 0) ? OB : XB, kp->ln_g + (layer * 2 + 0) * DM, kp->ln_b + (layer * 2 + 0) * DM, gw, NGW, lane); }
        PH_END;
        {
            for (int c = 0; c < 3; ++c) {
                const int row0 = c * 32768, crows = c < 2 ? 32768 : 16384, log2S = c < 2 ? 13 : 11;
                if (EN(10) && PH_ON) REP(10) {
                PH_WS;
                    pg8::Gemm g{XB + (size_t)row0 * DM, WIN + (size_t)layer * NFF * DM, crows, NFF, DM, DM}; pg8::StaticOrder S; S.init(crows, NFF, G, bx);
                    pg8::EpiStore E{HB, NFF, nullptr, 1.f};
                    pg8::gemm_phase<pg8::EpiStore, pg8::StaticOrder>(lds, g, S, E);
                }
                PH_END;
                if (EN(11) && PH_ON) REP(11) {   PH_LOCALS;
                    const float* cw = kp->ffn_conv_w + (size_t)layer * 3 * NFF; const float* cb = kp->ffn_conv_b + (size_t)layer * NFF; const bf16_t* H = HB; bf16_t* U = UB;
                    const int nitems = (crows / 8) * 11, smask = (1 << log2S) - 1;
                    for (int it = gw; it < nitems; it += NGW) {
                        const int rr = it / 11, cgp = it - rr * 11, col = (cgp * 64 + lane) * 4, r0 = rr * 8;
                        u32x2 ra[10], rg[10];
                        const bool hp = (r0 & smask) != 0, hn = ((r0 + 8) & smask) != 0;
#pragma unroll
                        for (int i = 0; i < 10; ++i) {
                            const bool ok = (i == 0) ? hp : (i == 9) ? hn : true;
                            if (ok) { ra[i] = *(const u32x2*)(H + (size_t)(r0 - 1 + i) * NFF + col); rg[i] = *(const u32x2*)(H + (size_t)(r0 - 1 + i) * NFF + DFF + col); }
                            else { ra[i] = (u32x2){0u, 0u}; rg[i] = (u32x2){0u, 0u}; }
                        }
                        f32x4 wa[3], wg[3];
#pragma unroll
                        for (int k = 0; k < 3; ++k) { wa[k] = *(const f32x4*)(cw + k * NFF + col); wg[k] = *(const f32x4*)(cw + k * NFF + DFF + col); }
                        const f32x4 ba = *(const f32x4*)(cb + col), bg = *(const f32x4*)(cb + DFF + col);
#define BF4(u) ((f32x4){__uint_as_float((u).x << 16), __uint_as_float((u).x & 0xffff0000u), __uint_as_float((u).y << 16), __uint_as_float((u).y & 0xffff0000u)})
#pragma unroll
                        for (int i = 0; i < 8; ++i) {
                            const f32x4 av = wa[0] * BF4(ra[i]) + wa[1] * BF4(ra[i + 1]) + wa[2] * BF4(ra[i + 2]) + ba;
                            const f32x4 gv = wg[0] * BF4(rg[i]) + wg[1] * BF4(rg[i + 1]) + wg[2] * BF4(rg[i + 2]) + bg;
                            u32x2 w; w.x = cvt_pk_bf16(av[0] * gelu_erf(gv[0]), av[1] * gelu_erf(gv[1])); w.y = cvt_pk_bf16(av[2] * gelu_erf(gv[2]), av[3] * gelu_erf(gv[3]));
                            *(u32x2*)(U + (size_t)(row0 + r0 + i) * DFF + col) = w;
                        }
#undef BF4
                    }
                }
                PH_END;
            }
            if (EN(12) && PH_ON) REP(12) {
                PH_WS;
                pg8::Gemm g{UB, WOUT + (size_t)layer * DM * DFF, T, DM, DFF, DFF}; pg8::StaticOrder S; S.init(T, DM, G, bx);
                pg8::EpiStore E{Y2B, DM, nullptr, 1.f};
                pg8::gemm_phase<pg8::EpiStore, pg8::StaticOrder>(lds, g, S, E);
            }
            PH_END;
            if (EN(13) && PH_ON) REP(13) { PH_LOCALS; ln_phase(X, X + (size_t)TP * DM, Y2B, (REPN(13) && rep_ == 0) ? (float*)(ws + 222 * MiB) : X, (REPN(13) && rep_ == 0) ? (bf16_t*)(ws + 822 * MiB) : XB, kp->ln_g + (layer * 2 + 1) * DM, kp->ln_b + (layer * 2 + 1) * DM, gw, NGW, lane, layer == 0); }
            PH_END;
        }
    }
#undef PH_ON
#undef PH_END
}
constexpr int N_PHASES = 1 + 15 + 2 * (2 + 8) + 4;

extern "C" void kernel_launch(void* const* d_in, const int* in_sizes, int n_in, void* d_out, int out_size, void* d_ws, size_t ws_size, hipStream_t stream) {
    static int grid = 0;
    if (grid == 0) {
        if (n_in != 17 || out_size != T * DM || ws_size < WS_END) { fprintf(stderr, "kernel_launch: unexpected shapes (n_in %d out %d ws %zu)\n", n_in, out_size, ws_size); grid = -1; return; }
        int dev = 0, cus = 0, per_cu = 0;
        if (hipGetDevice(&dev) != hipSuccess || hipDeviceGetAttribute(&cus, hipDeviceAttributeMultiprocessorCount, dev) != hipSuccess) { grid = -1; return; }
        if (hipFuncSetAttribute((const void*)mega_fwd, hipFuncAttributeMaxDynamicSharedMemorySize, LDS_BYTES) != hipSuccess) { fprintf(stderr, "kernel_launch: hipFuncSetAttribute failed\n"); grid = -1; return; }
        if (hipOccupancyMaxActiveBlocksPerMultiprocessor(&per_cu, (const void*)mega_fwd, 512, LDS_BYTES) != hipSuccess || per_cu < 1) { fprintf(stderr, "kernel_launch: occupancy query says %d\n", per_cu); per_cu = 1; }
        (void)hipGetLastError();
        grid = cus * 1;
    }
    if (grid < 0) return;
    if (hipMemsetAsync((char*)d_ws + WS_CTL, 0, CTL_BYTES, stream) != hipSuccess) { fprintf(stderr, "kernel_launch: memset failed\n"); return; }
    Params p{};
    const float** pp = (const float**)&p;
    for (int i = 0; i < 17; ++i) pp[i] = (const float*)d_in[i];
    p.out = (float*)d_out; p.ws = (unsigned char*)d_ws;
#if MK_MULTI
    for (int k = 0; k < N_PHASES; ++k) { p.ph_lo = k; p.ph_hi = k + 1; hipLaunchKernelGGL(mega_fwd, dim3(grid), dim3(512), LDS_BYTES, stream, p); }
#else
    p.ph_lo = 0; p.ph_hi = N_PHASES;
    void* args[] = {&p};
    hipError_t e = hipLaunchCooperativeKernel((const void*)mega_fwd, dim3(grid), dim3(512), args, LDS_BYTES, stream);
    if (e != hipSuccess) fprintf(stderr, "cooperative launch failed: %s (grid %d)\n", hipGetErrorString(e), grid);
#endif
}
```

```cpp
#include <hip/hip_runtime.h>
#include <hip/hip_cooperative_groups.h>
#include <cstdio>
#include <cstdint>
namespace cg = cooperative_groups;

#ifndef MK_MULTI
#define MK_MULTI 0
#endif

#define LAS __attribute__((address_space(3)))
typedef unsigned short bf16_t;
typedef short bf16x8 __attribute__((ext_vector_type(8)));
typedef short s16x4 __attribute__((ext_vector_type(4)));
typedef float f32x4 __attribute__((ext_vector_type(4)));
typedef float f32x2 __attribute__((ext_vector_type(2)));
typedef float f32x16 __attribute__((ext_vector_type(16)));
typedef unsigned u32x4 __attribute__((ext_vector_type(4)));
typedef unsigned u32x2 __attribute__((ext_vector_type(2)));

constexpr int DM = 1024, TP = 65536, TS = 16384, T = TP + TS;
constexpr int NQKV = 9216, DFF = 2816, NFF = 2 * DFF;
constexpr int CW = 768, NCQ = 384, NCKV = 256, NQ = 1536, NKV = 2048;
constexpr int CHUNK = 16384, NCHUNK = 5;
constexpr float ALPHA = 1.4142135623730951f;
constexpr float LOG2E = 1.4426950408889634f;
constexpr float LN_EPS = 1e-5f, RMS_EPS = 1e-6f;

constexpr size_t MiB = 1u << 20;
constexpr size_t WS_COS = 0, WS_SIN = 512 * 1024, WS_BT = 1 * MiB, WS_RQ = 1 * MiB + 256 * 1024, WS_RKV = 1 * MiB + 640 * 1024;
constexpr size_t WS_WQKV = 2 * MiB, WS_WOA = 20 * MiB, WS_WDKV = 22 * MiB, WS_WUQ = 24 * MiB, WS_WUKV = 25 * MiB + 512 * 1024, WS_WOB = 27 * MiB;
constexpr size_t WS_WIN = 29 * MiB, WS_WOUT = 51 * MiB;
constexpr size_t WS_XB = 62 * MiB, WS_O = 222 * MiB, WS_C = 222 * MiB, WS_S = 382 * MiB;
constexpr size_t WS_QKV = WS_S, WS_OG = WS_S + 288 * MiB, WS_LSE = WS_S + 384 * MiB;
constexpr size_t WS_U = WS_O, WS_H = WS_O + 440 * MiB, WS_Y2 = WS_H;
constexpr size_t WS_QB = WS_S, WS_KV = WS_S + 240 * MiB, WS_KRR = WS_S + 560 * MiB;
constexpr size_t WS_CTL = 1016 * MiB, CTL_BYTES = 65536;
constexpr size_t WS_END = WS_CTL + CTL_BYTES;
constexpr int LDS_BYTES = 147456;

__device__ __forceinline__ unsigned cvt_pk_bf16(float lo, float hi) { unsigned r; asm volatile("v_cvt_pk_bf16_f32 %0, %1, %2" : "=v"(r) : "v"(lo), "v"(hi)); return r; }
__device__ __forceinline__ u32x4 pack8(f32x4 v0, f32x4 v1) { u32x4 w; w.x = cvt_pk_bf16(v0[0], v0[1]); w.y = cvt_pk_bf16(v0[2], v0[3]); w.z = cvt_pk_bf16(v1[0], v1[1]); w.w = cvt_pk_bf16(v1[2], v1[3]); return w; }
__device__ __forceinline__ float bf2f(unsigned short b) { return __uint_as_float((unsigned)b << 16); }
__device__ __forceinline__ float wave_sum(float v, int lane) {
#pragma unroll
    for (int o = 1; o < 32; o <<= 1) v += __int_as_float(__builtin_amdgcn_ds_bpermute((lane ^ o) << 2, __float_as_int(v)));
    auto rr = __builtin_amdgcn_permlane32_swap(__float_as_uint(v), __float_as_uint(v), false, false);
    return __uint_as_float(rr[0]) + __uint_as_float(rr[1]);
}

namespace pg8 {
constexpr int BM = 256, BK = 64, HALF = 128, HTB = HALF * BK * 2, STAGE_BYTES = 8 * HTB, NXCD = 8, WGM = 8;
__host__ __device__ __forceinline__ int lds_byte(int r, int c) { const int st = (r >> 4) * 2 + (c >> 5), rr = r & 15, cc = c & 31, ob = rr * 64 + cc * 2; return st * 1024 + (ob ^ (((ob >> 9) & 1) << 5)); }
__host__ __device__ __forceinline__ void stage_rc(int b, int& R, int& C) { const int st = b / 1024, sb = b % 1024, swz = sb ^ (((sb >> 9) & 1) << 5); R = (st >> 1) * 16 + swz / 64; C = (st & 1) * 32 + (swz % 64) / 2; }
__host__ __device__ __forceinline__ int perm32(int rho) { const int n = rho >> 4, i = rho & 15; return 8 * (i >> 2) + 4 * n + (i & 3); }

struct Unit { int pm, pn; };
struct Gemm { const bf16_t* A; const bf16_t* Bt; int M, N, K, lda; };

struct StaticOrder {
    int nM, nN, nwg, G, c;
    __device__ void init(int M, int N, int G_, int c_) { nM = M / BM; nN = N / BM; nwg = nM * nN; G = G_; c = c_; }
    __device__ bool next(int i, Unit& u) const {
        const long L = (long)i * G + c; if (L >= nwg) return false;
        int wgid = (int)L; { const int q = nwg / NXCD, r = nwg % NXCD, xcd = wgid % NXCD, off = wgid / NXCD; wgid = (xcd < r ? xcd * (q + 1) : r * (q + 1) + (xcd - r) * q) + off; }
        const int nig = WGM * nN, gid = wgid / nig, fm = gid * WGM, gsz = (nM - fm) < WGM ? (nM - fm) : WGM;
        u.pm = fm + ((wgid % nig) % gsz); u.pn = (wgid % nig) / gsz; return true;
    }
};

struct EpiStore {
    static constexpr bool PERM = true;
    bf16_t* O; int ldc; const float* rscale; float cscale;
    __device__ __forceinline__ void operator()(const f32x4 (&acc)[2][2][4][2], const Unit& u, int wr, int wc, int fr, int fq) const {
        const int row0 = u.pm * BM + wr * 64 + fr, col0 = u.pn * BM + wc * 32 + 8 * fq;
#pragma unroll
        for (int ai = 0; ai < 2; ++ai)
#pragma unroll
            for (int m = 0; m < 4; ++m) {
                const int row = row0 + ai * HALF + m * 16;
                const float s = rscale ? rscale[row] * cscale : cscale;
                bf16_t* rowp = O + (size_t)row * ldc + col0;
#pragma unroll
                for (int bj = 0; bj < 2; ++bj) *(u32x4*)(rowp + bj * HALF) = pack8(acc[ai][bj][m][0] * s, acc[ai][bj][m][1] * s);
            }
    }
};
struct EpiQRope {
    static constexpr bool PERM = true;
    bf16_t* O; const float* rscale; float cscale; const float* cosT; const float* sinT;
    __device__ __forceinline__ void operator()(const f32x4 (&acc)[2][2][4][2], const Unit& u, int wr, int wc, int fr, int fq) const {
        const int row0 = u.pm * BM + wr * 64 + fr, col0 = u.pn * BM + wc * 32 + 8 * fq;
        int rj[2];
#pragma unroll
        for (int bj = 0; bj < 2; ++bj) { const int w = (col0 + bj * HALF) % 96; rj[bj] = (w >= 64) ? ((w - 64) >> 3) : -1; }
#pragma unroll
        for (int ai = 0; ai < 2; ++ai)
#pragma unroll
            for (int m = 0; m < 4; ++m) {
                const int row = row0 + ai * HALF + m * 16;
                const float s = rscale[row] * cscale;
                const int pos = row < TP ? (row & 8191) : (row & 2047);
                bf16_t* rowp = O + (size_t)row * NQ + col0;
#pragma unroll
                for (int bj = 0; bj < 2; ++bj) {
                    f32x4 v0 = acc[ai][bj][m][0] * s, v1 = acc[ai][bj][m][1] * s;
                    if (rj[bj] >= 0) {
                        const f32x4 cs = *(const f32x4*)(cosT + pos * 16 + 4 * rj[bj]), sn = *(const f32x4*)(sinT + pos * 16 + 4 * rj[bj]);
                        const f32x4 t1 = v0, t2 = v1; v0 = t1 * cs - t2 * sn; v1 = t1 * sn + t2 * cs;
                    }
                    *(u32x4*)(rowp + bj * HALF) = pack8(v0, v1);
                }
            }
    }
};
struct EpiQKV {
    static constexpr bool PERM = true;
    bf16_t* O; int log2S; float qscale;
    __device__ __forceinline__ void operator()(const f32x4 (&acc)[2][2][4][2], const Unit& u, int wr, int wc, int fr, int fq) const {
        const int colt = u.pn * BM, g = colt / 3072, which = (colt - g * 3072) >> 10, sh = 2 * g, log2L = log2S - sh, S = 1 << log2S;
        const float sc = (which == 0) ? qscale : 1.f;
        const int row0 = u.pm * BM + wr * 64 + fr, col0 = colt + wc * 32 + 8 * fq;
#pragma unroll
        for (int ai = 0; ai < 2; ++ai)
#pragma unroll
            for (int m = 0; m < 4; ++m) {
                const int rl = row0 + ai * HALF + m * 16, seq = rl >> log2S, s = rl & (S - 1);
                const int f = ((s & ((1 << sh) - 1)) << log2L) + (s >> sh), drow = (seq << log2S) + f;
                bf16_t* rowp = O + (size_t)drow * NQKV + col0;
#pragma unroll
                for (int bj = 0; bj < 2; ++bj) *(u32x4*)(rowp + bj * HALF) = pack8(acc[ai][bj][m][0] * sc, acc[ai][bj][m][1] * sc);
            }
    }
};
struct EpiRes {
    static constexpr bool PERM = true;
    float* X; float alpha;
    __device__ __forceinline__ void operator()(const f32x4 (&acc)[2][2][4][2], const Unit& u, int wr, int wc, int fr, int fq) const {
        const int row0 = u.pm * BM + wr * 64 + fr, col0 = u.pn * BM + wc * 32 + 8 * fq;
#pragma unroll
        for (int ai = 0; ai < 2; ++ai)
#pragma unroll
            for (int m = 0; m < 4; ++m) {
                float* rowp = X + (size_t)(row0 + ai * HALF + m * 16) * DM + col0;
#pragma unroll
                for (int bj = 0; bj < 2; ++bj) {
                    float* p = rowp + bj * HALF; const f32x4 a = *(const f32x4*)p, b = *(const f32x4*)(p + 4);
                    *(f32x4*)p = a * alpha + acc[ai][bj][m][0]; *(f32x4*)(p + 4) = b * alpha + acc[ai][bj][m][1];
                }
            }
    }
};

template <class Epi, class Sched, bool ALIGN_EPI = true, bool SP2 = true>
__device__ __forceinline__ void gemm_phase(LAS unsigned char* lds, const Gemm g, const Sched& S, const Epi& E) {
    int tid_ = threadIdx.x; asm volatile("" : "+v"(tid_));
    const int tid = tid_, wid = __builtin_amdgcn_readfirstlane(tid >> 6), lane = tid & 63, wr = wid >> 2, wc = wid & 3, fr = lane & 15, fq = lane >> 4;
    const int K = g.K, nt = K / BK, lda = g.lda;
    unsigned voffA[2], voffB[2];
#pragma unroll
    for (int i = 0; i < 2; ++i) { int R, C; stage_rc(tid * 16 + i * 8192, R, C); const int Rb = Epi::PERM ? ((R & ~31) + perm32(R & 31)) : R;
        voffA[i] = (unsigned)(R * lda + C) * 2u; voffB[i] = (unsigned)(Rb * K + C) * 2u; }
    const size_t kstep = (size_t)(BK * 2);
    const size_t hstepA = (size_t)HALF * lda * 2, hstepB = (size_t)HALF * K * 2;
    const size_t tstepA = 2 * hstepA, tstepB = 2 * hstepB;
    const unsigned ldsw = (unsigned)wid * 1024u;
    const int aoff = lds_byte(wr * 64 + fr, fq * 8), boff = lds_byte(wc * 32 + fr, fq * 8);
#define PG8_SA(b, h) (((b) * 2 + (h)) * HTB)
#define PG8_SB(b, h) ((4 + (b) * 2 + (h)) * HTB)
#define PG8_STAGE(bufoff, gbase, voff) do { _Pragma("unroll") for (int _i = 0; _i < 2; ++_i) \
        __builtin_amdgcn_global_load_lds((const unsigned*)((const char*)(gbase) + (voff)[_i]), (LAS unsigned*)(lds + (bufoff) + ldsw + _i * 8192), 16, 0, 0); } while (0)
#define PG8_LDA(dst, b, h) do { _Pragma("unroll") for (int m = 0; m < 4; ++m) _Pragma("unroll") for (int k = 0; k < 2; ++k) dst[m][k] = *(const LAS bf16x8*)(lds + PG8_SA(b, h) + aoff + m * 2048 + k * 1024); } while (0)
#define PG8_LDB(dst, b, h) do { _Pragma("unroll") for (int n = 0; n < 2; ++n) _Pragma("unroll") for (int k = 0; k < 2; ++k) dst[n][k] = *(const LAS bf16x8*)(lds + PG8_SB(b, h) + boff + n * 2048 + k * 1024); } while (0)
#define PG8_MMA(ai, bj, At, Bt) do { __builtin_amdgcn_s_setprio(1); _Pragma("unroll") for (int m = 0; m < 4; ++m) _Pragma("unroll") for (int n = 0; n < 2; ++n) _Pragma("unroll") for (int k = 0; k < 2; ++k) \
        acc[ai][bj][m][n] = __builtin_amdgcn_mfma_f32_16x16x32_bf16(Bt[n][k], At[m][k], acc[ai][bj][m][n], 0, 0, 0); __builtin_amdgcn_s_setprio(0); } while (0)
#define PG8_WAIT_V(n) asm volatile("s_waitcnt vmcnt(" #n ")" ::: "memory")
#define PG8_WAIT_L(n) asm volatile("s_waitcnt lgkmcnt(" #n ")" ::: "memory")
#define PG8_BAR __builtin_amdgcn_s_barrier()
#define PG8_SCHED __builtin_amdgcn_sched_barrier(0)
    Unit cur, nxt; int ui = 0;
    if (!S.next(0, cur)) return;
    f32x4 acc[2][2][4][2];
#pragma unroll
    for (int a = 0; a < 2; ++a)
#pragma unroll
        for (int b = 0; b < 2; ++b)
#pragma unroll
            for (int m = 0; m < 4; ++m)
#pragma unroll
                for (int n = 0; n < 2; ++n) acc[a][b][m][n] = (f32x4){0.f, 0.f, 0.f, 0.f};
    bf16x8 At[4][2], B0[2][2], B1[2][2];
    const char* cA = (const char*)g.A + (size_t)cur.pm * tstepA; const char* cB = (const char*)g.Bt + (size_t)cur.pn * tstepB;
    if constexpr (SP2) {
        PG8_STAGE(PG8_SB(0, 0), cB, voffB); PG8_STAGE(PG8_SB(0, 1), cB + hstepB, voffB); PG8_STAGE(PG8_SA(0, 0), cA, voffA); PG8_STAGE(PG8_SA(0, 1), cA + hstepA, voffA);
        if (wr == 1) PG8_BAR;
        PG8_WAIT_V(2); PG8_BAR;
        PG8_STAGE(PG8_SB(1, 0), cB + kstep, voffB); PG8_STAGE(PG8_SA(1, 0), cA + kstep, voffA); PG8_STAGE(PG8_SB(1, 1), cB + hstepB + kstep, voffB);
        PG8_WAIT_V(6); PG8_BAR;
    }
    for (;;) {
        const bool has_next = S.next(ui + 1, nxt);
        const char* nA = has_next ? (const char*)g.A + (size_t)nxt.pm * tstepA : cA; const char* nB = has_next ? (const char*)g.Bt + (size_t)nxt.pn * tstepB : cB;
        for (int t = 0; t < nt; t += 2) {
            const bool last = (t == nt - 2);
            const char* a1 = cA + (size_t)(t + 1) * kstep;
            const char* a2 = last ? nA : cA + (size_t)(t + 2) * kstep; const char* b2 = last ? nB : cB + (size_t)(t + 2) * kstep;
            const char* a3 = a2 + kstep; const char* b3 = b2 + kstep;
            PG8_LDB(B0, 0, 0); PG8_LDB(B1, 0, 1); PG8_SCHED; PG8_LDA(At, 0, 0); PG8_STAGE(PG8_SA(1, 1), a1 + hstepA, voffA);
            PG8_WAIT_V(8); PG8_WAIT_L(0); PG8_BAR; PG8_MMA(0, 0, At, B0); PG8_MMA(0, 1, At, B1); PG8_BAR; PG8_SCHED;
            PG8_LDA(At, 0, 1); PG8_STAGE(PG8_SB(0, 0), b2, voffB); PG8_STAGE(PG8_SB(0, 1), b2 + hstepB, voffB); PG8_STAGE(PG8_SA(0, 0), a2, voffA);
            PG8_WAIT_V(8); PG8_WAIT_L(0); PG8_BAR; PG8_MMA(1, 0, At, B0); PG8_MMA(1, 1, At, B1); PG8_BAR; PG8_SCHED;
            PG8_LDB(B0, 1, 0); PG8_LDB(B1, 1, 1); PG8_SCHED; PG8_LDA(At, 1, 0); PG8_STAGE(PG8_SA(0, 1), a2 + hstepA, voffA);
            PG8_WAIT_V(8); PG8_WAIT_L(0); PG8_BAR; PG8_MMA(0, 0, At, B0); PG8_MMA(0, 1, At, B1); PG8_BAR; PG8_SCHED;
            PG8_LDA(At, 1, 1); PG8_STAGE(PG8_SB(1, 0), b3, voffB); PG8_STAGE(PG8_SB(1, 1), b3 + hstepB, voffB); PG8_STAGE(PG8_SA(1, 0), a3, voffA);
            PG8_WAIT_V(8); PG8_WAIT_L(0); PG8_BAR; PG8_MMA(1, 0, At, B0); PG8_MMA(1, 1, At, B1); PG8_BAR; PG8_SCHED;
        }
        if constexpr (ALIGN_EPI) { if (wr == 0) PG8_BAR; }
        { int l2 = threadIdx.x; asm volatile("" : "+v"(l2)); l2 &= 63; E(acc, cur, wr, wc, l2 & 15, l2 >> 4); }
        if (!has_next) break;
#pragma unroll
        for (int a = 0; a < 2; ++a)
#pragma unroll
            for (int b = 0; b < 2; ++b)
#pragma unroll
                for (int m = 0; m < 4; ++m)
#pragma unroll
                    for (int n = 0; n < 2; ++n) acc[a][b][m][n] = (f32x4){0.f, 0.f, 0.f, 0.f};
        cur = nxt; cA = nA; cB = nB; ++ui;
        if constexpr (ALIGN_EPI) { if (wr == 1) PG8_BAR; }
    }
    PG8_WAIT_V(0);
    if constexpr (!ALIGN_EPI) { if (wr == 0) PG8_BAR; }
    PG8_BAR;
#undef PG8_SA
#undef PG8_SB
#undef PG8_STAGE
#undef PG8_LDA
#undef PG8_LDB
#undef PG8_MMA
#undef PG8_WAIT_V
#undef PG8_WAIT_L
#undef PG8_BAR
#undef PG8_SCHED
}
}

struct Params {
    const float *x_prompt, *x_sample, *rel_bias, *w_qkv_a, *w_o_a, *w_dkv_b, *g_q_b, *g_kv_b, *w_uq_b, *w_ukv_b, *w_o_b, *ffn_w_in, *ffn_conv_w, *ffn_conv_b, *ffn_w_out, *ln_g, *ln_b;
    float* out; unsigned char* ws;
    int ph_lo, ph_hi;
};

__device__ __forceinline__ int rope_perm32(int i) { const int t = i >> 4, ii = i & 15; return 8 * (ii >> 2) + 4 * t + (ii & 3); }
__device__ __forceinline__ int rowmap(int mode, int n) {
    if (mode == 1) { const int h = n / 96, w = n - h * 96; return w < 64 ? n : h * 96 + 64 + rope_perm32(w - 64); }
    if (mode == 2) { return n < 640 ? n : 640 + rope_perm32(n - 640); }
    return n;
}
__device__ __forceinline__ void transpose_item(const float* W, int K, int N, bf16_t* WT, int mode, const float* kscale, LAS float* scr, int item, int lane) {
    const int nblk = N / 32, kb = item / nblk, nb = item % nblk, k0 = 64 * kb, n0 = 32 * nb;
    const int kr = lane >> 3, c4 = (lane & 7) * 4;
#pragma unroll
    for (int i = 0; i < 8; ++i) { const int kk = kr + 8 * i; f32x4 v = *(const f32x4*)(W + (size_t)(k0 + kk) * N + n0 + c4); if (kscale) v = v * kscale[k0 + kk];
        scr[kk * 33 + c4] = v.x; scr[kk * 33 + c4 + 1] = v.y; scr[kk * 33 + c4 + 2] = v.z; scr[kk * 33 + c4 + 3] = v.w; }
    asm volatile("s_waitcnt lgkmcnt(0)" ::: "memory");
    const int c = lane & 7;
#pragma unroll
    for (int j = 0; j < 4; ++j) { const int n = (lane >> 3) + 8 * j; const LAS float* s = scr + (8 * c) * 33 + n;
        u32x4 o; o.x = cvt_pk_bf16(s[0 * 33], s[1 * 33]); o.y = cvt_pk_bf16(s[2 * 33], s[3 * 33]); o.z = cvt_pk_bf16(s[4 * 33], s[5 * 33]); o.w = cvt_pk_bf16(s[6 * 33], s[7 * 33]);
        *(u32x4*)(WT + (size_t)rowmap(mode, n0 + n) * K + k0 + 8 * c) = o; }
    asm volatile("s_waitcnt lgkmcnt(0)" ::: "memory");
}
__device__ __forceinline__ int t5_bucket(int rel) {
    const int n = rel < 0 ? -rel : rel; const int ret = rel > 0 ? 16 : 0;
    if (n < 8) return ret + n;
    int large = 8 + (int)(__log2f((float)n * 0.125f) * (8.0f / 7.0f));
    if (large > 15) large = 15;
    return ret + large;
}
__device__ __forceinline__ void rope_entry(int pos, int i, float& c, float& s) {
    const double x = -(double)i * (13.287712379549449 / 16.0);
    const double fl = __builtin_floor(x), fr = (x - fl) * 0.6931471805599453;
    double e = 1.0, term = 1.0;
#pragma unroll 1
    for (int k = 1; k < 22; ++k) { term *= fr / (double)k; e += term; }
    const long long bits = (long long)(1023 + (int)fl) << 52;
    const double inv = e * __builtin_bit_cast(double, bits);
    const double ang = (double)pos * inv;
    const double kq = __builtin_rint(ang * 0.6366197723675814);
    double r = __builtin_fma(-kq, 1.5707963267948966, ang); r = __builtin_fma(-kq, 6.123233995736766e-17, r);
    const double r2 = r * r;
    double sp = r * (1.0 + r2 * (-1.0 / 6 + r2 * (1.0 / 120 + r2 * (-1.0 / 5040 + r2 * (1.0 / 362880 + r2 * (-1.0 / 39916800 + r2 * (1.0 / 6227020800.0)))))));
    double cp = 1.0 + r2 * (-0.5 + r2 * (1.0 / 24 + r2 * (-1.0 / 720 + r2 * (1.0 / 40320 + r2 * (-1.0 / 3628800 + r2 * (1.0 / 479001600.0))))));
    const int q = (int)((long long)kq & 3);
    double sv = (q == 0) ? sp : (q == 1) ? cp : (q == 2) ? -sp : -cp;
    double cv = (q == 0) ? cp : (q == 1) ? -sp : (q == 2) ? -cp : sp;
    c = (float)cv; s = (float)sv;
}

__device__ __forceinline__ float gelu_erf(float v) {
    const float av = __builtin_fabsf(v), d = av * 0.2316418882f + 1.0f, t = __builtin_amdgcn_rcpf(d);
    float q = t * 0.5307027145f + (-0.7265760135f); q = q * t + 0.7107068705f; q = q * t + (-0.142248368f); q = q * t + 0.127414796f; q = q * t;
    const float e = __builtin_amdgcn_exp2f((v * v) * (-0.72134752044f));
    const float m = v * (q * e), r = v - m;
    return v < 0.f ? m : r;
}

__device__ __forceinline__ void ln_phase(const float* x0, const float* x1, const bf16_t* Y, float* Xo, bf16_t* XBo, const float* g, const float* b, int gw, int NGW, int lane, bool wb = true) {
    f32x4 gg[4], bb[4];
#pragma unroll
    for (int j = 0; j < 4; ++j) { gg[j] = *((const f32x4*)g + lane + 64 * j); bb[j] = *((const f32x4*)b + lane + 64 * j); }
    f32x4 cx[4]; u32x2 cy[4];
#define LN_LOAD(r, vx, vy) do { const float* src_ = (r) < TP ? x0 + (size_t)(r) * DM : x1 + (size_t)((r) - TP) * DM; \
        _Pragma("unroll") for (int j = 0; j < 4; ++j) { vx[j] = *((const f32x4*)src_ + lane + 64 * j); vy[j] = *((const u32x2*)(Y + (size_t)(r) * DM) + lane + 64 * j); } } while (0)
    if (gw < T) LN_LOAD(gw, cx, cy);
    for (int r = gw; r < T; r += NGW) {
        f32x4 nx[4] = {}; u32x2 ny[4] = {};
        const int rn = r + NGW;
        if (rn < T) LN_LOAD(rn, nx, ny);
        f32x4 v[4]; float s = 0.f;
#pragma unroll
        for (int j = 0; j < 4; ++j) {
            const f32x4 yf = {__uint_as_float(cy[j].x << 16), __uint_as_float(cy[j].x & 0xffff0000u), __uint_as_float(cy[j].y << 16), __uint_as_float(cy[j].y & 0xffff0000u)};
            v[j] = cx[j] * ALPHA + yf; s += (v[j].x + v[j].y) + (v[j].z + v[j].w);
        }
        const float mean = wave_sum(s, lane) * (1.f / DM); float s2 = 0.f;
#pragma unroll
        for (int j = 0; j < 4; ++j) { v[j] = v[j] - mean; s2 += (v[j].x * v[j].x + v[j].y * v[j].y) + (v[j].z * v[j].z + v[j].w * v[j].w); }
        const float rstd = 1.f / sqrtf(wave_sum(s2, lane) * (1.f / DM) + LN_EPS);
#pragma unroll
        for (int j = 0; j < 4; ++j) {
            const f32x4 o = v[j] * rstd * gg[j] + bb[j];
            *((f32x4*)(Xo + (size_t)r * DM) + lane + 64 * j) = o;
            if (wb) { u32x2 w; w.x = cvt_pk_bf16(o.x, o.y); w.y = cvt_pk_bf16(o.z, o.w); *((u32x2*)(XBo + (size_t)r * DM) + lane + 64 * j) = w; }
        }
#pragma unroll
        for (int j = 0; j < 4; ++j) { cx[j] = nx[j]; cy[j] = ny[j]; }
    }
#undef LN_LOAD
}

__device__ __forceinline__ s16x4 tr_read(unsigned addr) { s16x4 r; asm volatile("ds_read_b64_tr_b16 %0, %1" : "=&v"(r) : "v"(addr) : "memory"); return r; }
#define MFMA32(a, b, c) __builtin_amdgcn_mfma_f32_32x32x16_bf16(a, b, c, 0, 0, 0)
__device__ __forceinline__ float xhalf_max(float v) { auto rr = __builtin_amdgcn_permlane32_swap(__float_as_uint(v), __float_as_uint(v), false, false); return fmaxf(__uint_as_float(rr[0]), __uint_as_float(rr[1])); }
__device__ __forceinline__ float xhalf_sum(float v) { auto rr = __builtin_amdgcn_permlane32_swap(__float_as_uint(v), __float_as_uint(v), false, false); return __uint_as_float(rr[0]) + __uint_as_float(rr[1]); }
__device__ __forceinline__ float max3(float a, float b, float c) { float r; asm("v_max3_f32 %0, %1, %2, %3" : "=v"(r) : "v"(a), "v"(b), "v"(c)); return r; }
__device__ __forceinline__ bf16x8 pack_p(const f32x16& p, int j2) {
    u32x4 w; w.x = cvt_pk_bf16(p[8 * j2 + 0], p[8 * j2 + 1]); w.y = cvt_pk_bf16(p[8 * j2 + 2], p[8 * j2 + 3]); w.z = cvt_pk_bf16(p[8 * j2 + 4], p[8 * j2 + 5]); w.w = cvt_pk_bf16(p[8 * j2 + 6], p[8 * j2 + 7]);
    return __builtin_bit_cast(bf16x8, w);
}
__device__ __forceinline__ void pv_tile(f32x16& o, unsigned vaddr, const bf16x8 (&pb)[4]) {
    s16x4 lo[4], hi[4];
#pragma unroll
    for (int k = 0; k < 4; ++k) { lo[k] = tr_read(vaddr + (16 * k) * 64); hi[k] = tr_read(vaddr + (16 * k + 8) * 64); }
    asm volatile("s_waitcnt lgkmcnt(0)" ::: "memory"); __builtin_amdgcn_sched_barrier(0);
#pragma unroll
    for (int k = 0; k < 4; ++k) { const bf16x8 a = (bf16x8){lo[k][0], lo[k][1], lo[k][2], lo[k][3], hi[k][0], hi[k][1], hi[k][2], hi[k][3]}; o = MFMA32(a, pb[k], o); }
}

__device__ __forceinline__ void pv_issue(unsigned vaddr, s16x4 (&lo)[4], s16x4 (&hi)[4]) {
#pragma unroll
    for (int k = 0; k < 4; ++k) { lo[k] = tr_read(vaddr + (16 * k) * 64); hi[k] = tr_read(vaddr + (16 * k + 8) * 64); }
}
__device__ __forceinline__ void pv_mma(f32x16& o, const s16x4 (&lo)[4], const s16x4 (&hi)[4], const bf16x8 (&pb)[4]) {
#pragma unroll
    for (int k = 0; k < 4; ++k) { const bf16x8 a = (bf16x8){lo[k][0], lo[k][1], lo[k][2], lo[k][3], hi[k][0], hi[k][1], hi[k][2], hi[k][3]}; o = MFMA32(a, pb[k], o); }
}
__device__ __forceinline__ void pv_mma2(f32x16& o0, f32x16& o1, const s16x4 (&l0)[4], const s16x4 (&h0)[4], const s16x4 (&l1)[4], const s16x4 (&h1)[4], const bf16x8 (&pb)[4]) {
#pragma unroll
    for (int k = 0; k < 4; ++k) {
        const bf16x8 a0 = (bf16x8){l0[k][0], l0[k][1], l0[k][2], l0[k][3], h0[k][0], h0[k][1], h0[k][2], h0[k][3]};
        const bf16x8 a1 = (bf16x8){l1[k][0], l1[k][1], l1[k][2], l1[k][3], h1[k][0], h1[k][1], h1[k][2], h1[k][3]};
        o0 = MFMA32(a0, pb[k], o0); o1 = MFMA32(a1, pb[k], o1);
    }
}
#define MLA_QK_(cur) { const LAS unsigned char* Kb_ = lds + cur * KBUF; s0 = (f32x16){}; s1 = (f32x16){}; \
            _Pragma("unroll") \
            for (int ks = 0; ks < 6; ++ks) { \
                const bf16x8 a0 = *(const LAS bf16x8*)(Kb_ + r32 * 208 + ks * 32 + hi * 16), a1 = *(const LAS bf16x8*)(Kb_ + (32 + r32) * 208 + ks * 32 + hi * 16); \
                s0 = MFMA32(a0, qf[ks], s0); s1 = MFMA32(a1, qf[ks], s1); \
            } }
#define MLA_ROWMAX_() \
            float pa = max3(s0[0], s0[1], s0[2]), pc = max3(s1[0], s1[1], s1[2]); \
            _Pragma("unroll") \
            for (int r = 3; r < 15; r += 2) { pa = max3(pa, s0[r], s0[r + 1]); pc = max3(pc, s1[r], s1[r + 1]); } \
            float pmax = max3(pa, pc, fmaxf(s0[15], s1[15])); \
            pmax = xhalf_max(pmax)
#define MLA_EXPSUM_() { \
            f32x2 pa2 = {0.f, 0.f}, pb2 = {0.f, 0.f}, pc2 = {0.f, 0.f}, pd2 = {0.f, 0.f};     \
            _Pragma("unroll") \
            for (int r = 0; r < 16; ++r) { s0[r] = __builtin_amdgcn_exp2f(s0[r]); s1[r] = __builtin_amdgcn_exp2f(s1[r]); } \
            _Pragma("unroll") \
            for (int r = 0; r < 16; r += 4) { pa2 += (f32x2){s0[r], s0[r + 1]}; pb2 += (f32x2){s0[r + 2], s0[r + 3]}; pc2 += (f32x2){s1[r], s1[r + 1]}; pd2 += (f32x2){s1[r + 2], s1[r + 3]}; } \
            { const f32x2 t2 = (pa2 + pb2) + (pc2 + pd2); ps = t2.x + t2.y; } }
#define MLA_COMPUTE(cur) { \
            f32x16 s0, s1; float ps; \
            MLA_QK_(cur) \
            const unsigned va = trb + cur * VBUF; \
            s16x4 vl0[4], vh0[4], vl1[4], vh1[4]; \
            pv_issue(va, vl0, vh0); pv_issue(va + 4096, vl1, vh1);    \
            if (slow || j == 0) { \
                MLA_ROWMAX_(); \
                if (__any(pmax - m > (slow ? 8.f : 64.f)) || (j == 0 && __any(pmax < -32.f))) { \
                    const float mn = (j == 0) ? pmax : fmaxf(m, pmax), alpha = (j == 0) ? 1.f : __builtin_amdgcn_exp2f(m - mn); \
                    m = mn; l *= alpha; slow = true; \
                    _Pragma("unroll") \
                    for (int r = 0; r < 16; ++r) { o0[r] *= alpha; o1[r] *= alpha; } \
                } \
                if (slow) { \
                    _Pragma("unroll") \
                    for (int r = 0; r < 16; ++r) { s0[r] -= m; s1[r] -= m; } \
                } \
            } \
            MLA_EXPSUM_() \
            bf16x8 pb[4]; \
            pb[0] = pack_p(s0, 0); pb[1] = pack_p(s0, 1); pb[2] = pack_p(s1, 0); pb[3] = pack_p(s1, 1);     \
            if (!slow && __any(!(ps < 1e30f))) {     \
                MLA_QK_(cur) \
                MLA_ROWMAX_(); \
                const float mn = fmaxf(m, pmax), alpha = __builtin_amdgcn_exp2f(m - mn); \
                m = mn; l *= alpha; slow = true; \
                _Pragma("unroll") \
                for (int r = 0; r < 16; ++r) { o0[r] *= alpha; o1[r] *= alpha; s0[r] -= m; s1[r] -= m; } \
                MLA_EXPSUM_() \
                pb[0] = pack_p(s0, 0); pb[1] = pack_p(s0, 1); pb[2] = pack_p(s1, 0); pb[3] = pack_p(s1, 1); \
            } \
            l += ps; \
            asm volatile("s_waitcnt lgkmcnt(0)" ::: "memory"); __builtin_amdgcn_sched_barrier(0); \
            pv_mma2(o0, o1, vl0, vh0, vl1, vh1, pb); \
            }
__device__ __forceinline__ void attn_mla_phase(LAS unsigned char* lds, const bf16_t* QB, const bf16_t* KV, const bf16_t* KRR, bf16_t* O, int G, int bx) {
    constexpr int KBUF = 64 * 208, VBUF = 8192, VOFF = 2 * KBUF;
    int tid_ = threadIdx.x; asm volatile("" : "+v"(tid_));
    const int tid = tid_, wid = __builtin_amdgcn_readfirstlane(tid >> 6), lane = tid & 63, r32 = lane & 31, hi = lane >> 5;
    const bool xs = (G % 8) == 0;
    const int nslots = xs ? G / 8 : G, slot = xs ? bx / 8 : bx, xcd = xs ? bx % 8 : 0, npx = xs ? 16 : 128;
    const int nent = npx * 40;
    const int skey = tid >> 3, sch = tid & 7, rkey = tid >> 2, rch = tid & 3;
    const int kdst = skey * 208 + sch * 16, rdst = rkey * 208 + 128 + rch * 16, vdst = (sch >> 2) * 4096 + skey * 64 + (sch & 3) * 16;
    const unsigned trb = (unsigned)(size_t)(lds + VOFF) + (unsigned)((4 * hi + ((lane & 15) >> 2)) * 64 + 32 * ((lane >> 4) & 1) + 8 * (lane & 3));
#define MLA_DEC(LI, P) int P##pair, P##qb, P##base, P##S; \
        if ((LI) < npx * 32) { P##pair = xs ? ((LI) >> 5) * 8 + xcd : ((LI) >> 5); P##qb = (LI) & 31; P##base = (P##pair >> 4) * 8192; P##S = 8192; } \
        else { const int l2_ = (LI) - npx * 32; P##pair = xs ? (l2_ >> 3) * 8 + xcd : (l2_ >> 3); P##qb = l2_ & 7; P##base = TP + (P##pair >> 4) * 2048; P##S = 2048; } \
        const int P##h = P##pair & 15; \
        const size_t P##qrow = (size_t)P##base + P##qb * 256 + wid * 32 + r32; \
        const bf16_t* P##qsrc = QB + P##qrow * NQ + P##h * 96 + hi * 8; \
        const bf16_t* P##kn = KV + (size_t)(P##base + skey) * NKV + P##h * 128 + sch * 8; \
        const bf16_t* P##kr = KRR + (size_t)(P##base + rkey) * 32 + rch * 8
    int li = slot;
    if (li >= nent) return;
    bf16x8 qf[6]; bf16x8 ska, sva, sra = {}, skb, svb, srb = {};
    {
        MLA_DEC(li, f_);
#pragma unroll
        for (int ks = 0; ks < 6; ++ks) qf[ks] = *(const bf16x8*)(f_qsrc + ks * 16);
        ska = *(const bf16x8*)f_kn; sva = *(const bf16x8*)(f_kn + 64); if (tid < 256) sra = *(const bf16x8*)f_kr;
        *(LAS bf16x8*)(lds + kdst) = ska; *(LAS bf16x8*)(lds + VOFF + vdst) = sva; if (tid < 256) *(LAS bf16x8*)(lds + rdst) = sra;
        ska = *(const bf16x8*)(f_kn + (size_t)64 * NKV); sva = *(const bf16x8*)(f_kn + (size_t)64 * NKV + 64); if (tid < 256) sra = *(const bf16x8*)(f_kr + 64 * 32);
    }
    __syncthreads();
    for (;;) {
        MLA_DEC(li, c_);
        const int lin = li + nslots; const bool hasn = lin < nent;
        MLA_DEC(hasn ? lin : li, n_);
        const int h = c_h; const size_t qrow = c_qrow;
        f32x16 o0 = {}, o1 = {}; float m = 0.f, l = 0.f; bool slow = false;
        const int NT = c_S / 64;
        const bf16_t* kn_src = c_kn; const bf16_t* kr_src = c_kr;
#define MLA_STEP(cur, SKL, SVL, SRL, SKW, SVW, SRW) { \
            { const bool own_ = j + 2 < NT; const size_t off = (size_t)(own_ ? j + 2 : j + 2 - NT) * 64; const bf16_t* kn_ = own_ ? kn_src : n_kn; const bf16_t* kr_ = own_ ? kr_src : n_kr; \
              SKL = *(const bf16x8*)(kn_ + off * NKV); SVL = *(const bf16x8*)(kn_ + off * NKV + 64); if (tid < 256) SRL = *(const bf16x8*)(kr_ + off * 32); } \
            MLA_COMPUTE(cur) \
            *(LAS bf16x8*)(lds + ((cur) ^ 1) * KBUF + kdst) = SKW; *(LAS bf16x8*)(lds + VOFF + ((cur) ^ 1) * VBUF + vdst) = SVW; if (tid < 256) *(LAS bf16x8*)(lds + ((cur) ^ 1) * KBUF + rdst) = SRW; \
            __syncthreads(); ++j; }
        for (int j = 0; j < NT;) {
            MLA_STEP(0, skb, svb, srb, ska, sva, sra)
            MLA_STEP(1, ska, sva, sra, skb, svb, srb)
        }
#undef MLA_STEP
        if (hasn) {
#pragma unroll
            for (int ks = 0; ks < 6; ++ks) qf[ks] = *(const bf16x8*)(n_qsrc + ks * 16);
        }
        l = xhalf_sum(l);
        const float inv = 1.f / l;
        bf16_t* orow = O + qrow * DM + h * 64 + 4 * hi;
#pragma unroll
        for (int g4 = 0; g4 < 4; ++g4) {
            u32x2 w0, w1;
            w0.x = cvt_pk_bf16(o0[4 * g4] * inv, o0[4 * g4 + 1] * inv); w0.y = cvt_pk_bf16(o0[4 * g4 + 2] * inv, o0[4 * g4 + 3] * inv);
            w1.x = cvt_pk_bf16(o1[4 * g4] * inv, o1[4 * g4 + 1] * inv); w1.y = cvt_pk_bf16(o1[4 * g4 + 2] * inv, o1[4 * g4 + 3] * inv);
            *(u32x2*)(orow + 8 * g4) = w0; *(u32x2*)(orow + 32 + 8 * g4) = w1;
        }
        if (!hasn) break;
        li = lin;
    }
#undef MLA_DEC
}

#undef MLA_COMPUTE
#undef MLA_QK_
#undef MLA_ROWMAX_
#undef MLA_EXPSUM_
__device__ __forceinline__ void attn_dil_phase(LAS unsigned char* lds, const bf16_t* QKV, const float* BT, bf16_t* OG, float* LSE, int nseq, int log2S, int G, int bx) {
    constexpr int KBUF = 64 * 272, VBUF = 16384, VOFF = 2 * KBUF, TOFF = VOFF + 2 * VBUF;
    int tid_ = threadIdx.x; asm volatile("" : "+v"(tid_));
    const int tid = tid_, wid = __builtin_amdgcn_readfirstlane(tid >> 6), lane = tid & 63, r32 = lane & 31, hi = lane >> 5;
    const int S = 1 << log2S, nqb = S >> 8, nunits = nseq * 24 * nqb;
    const int key0 = tid >> 4, ch0 = tid & 15;
    const int kdst = key0 * 272 + ch0 * 16, vdst = (ch0 >> 2) * 4096 + key0 * 64 + (ch0 & 3) * 16;
    const unsigned trb = (unsigned)(size_t)(lds + VOFF) + (unsigned)((4 * hi + ((lane & 15) >> 2)) * 64 + 32 * ((lane >> 4) & 1) + 8 * (lane & 3));
    LAS float* tab = (LAS float*)(lds + TOFF);
#define DIL_DEC(uu, P) const int P##qb = (uu) % nqb; int P##rest = (uu) / nqb; const int P##h = P##rest & 7; P##rest >>= 3; const int P##g = P##rest % 3, P##seq = P##rest / 3; \
        const int P##f0 = P##qb * 256, P##rowbase = P##seq << log2S, P##tlo = (P##f0 == 0) ? 1 : 0; \
        const bf16_t* P##qsrc = QKV + ((size_t)P##rowbase + P##f0 + wid * 32 + r32) * NQKV + P##g * 3072 + P##h * 128 + hi * 8; \
        const bf16_t* P##ksrc = QKV + (long)(P##rowbase + P##f0 - 64 + key0) * NQKV + P##g * 3072 + 1024 + P##h * 128 + ch0 * 8; \
        const float* P##tsrc = BT + (P##g * 8 + P##h) * 384 + (tid < 384 ? tid : 0)
#define DIL_TILE(src, t) do { const bf16_t* p_ = (src) + (size_t)((t) * 64) * NQKV; k0r = *(const bf16x8*)p_; v0r = *(const bf16x8*)(p_ + 1024); k1r = *(const bf16x8*)(p_ + (size_t)32 * NQKV); v1r = *(const bf16x8*)(p_ + (size_t)32 * NQKV + 1024); } while (0)
    bf16x8 qn[8] = {}, k0r = {}, k1r = {}, v0r = {}, v1r = {}; float tabv = 0.f;
    if (bx < nunits) {
        DIL_DEC(bx, a_);
#pragma unroll
        for (int ks = 0; ks < 8; ++ks) qn[ks] = *(const bf16x8*)(a_qsrc + ks * 16);
        DIL_TILE(a_ksrc, a_tlo); tabv = *a_tsrc;
    }
    for (int u = bx; u < nunits; u += G) {
        DIL_DEC(u, c_);
        const int h = c_h, g = c_g, f0 = c_f0, rowbase = c_rowbase, tlo = c_tlo;
        const int sh = 2 * g, log2L = log2S - sh;
        bf16x8 qf[8];
#pragma unroll
        for (int ks = 0; ks < 8; ++ks) qf[ks] = qn[ks];
        if (tid < 384) tab[tid] = tabv;
        f32x16 o[4] = {}; float m = -1e30f, l = 0.f;
        const int thi = (f0 + 256 >= S) ? 4 : 5;
        const int wt0 = wid >> 1, myblk = (f0 + 32 * wid) >> log2L;
        const bf16_t* ksrc = c_ksrc;
        const int tbase = 128 - 32 * wid - r32 + 4 * hi;
        *(LAS bf16x8*)(lds + kdst) = k0r; *(LAS bf16x8*)(lds + kdst + 32 * 272) = k1r; *(LAS bf16x8*)(lds + VOFF + vdst) = v0r; *(LAS bf16x8*)(lds + VOFF + vdst + 32 * 64) = v1r;
        const int un = u + G; const bool hasn = un < nunits;
        DIL_DEC(hasn ? un : u, n_);
        if (hasn) {
#pragma unroll
            for (int ks = 0; ks < 8; ++ks) qn[ks] = *(const bf16x8*)(n_qsrc + ks * 16);
            tabv = *n_tsrc;
        }
        __syncthreads();
        for (int t = tlo; t <= thi; ++t) {
            const int cur = (t - tlo) & 1;
            if (t < thi) DIL_TILE(ksrc, t + 1); else if (hasn) DIL_TILE(n_ksrc, n_tlo);
            const int fk0 = f0 - 64 + 64 * t;
            if (t >= wt0 && t <= wt0 + 2 && (fk0 >> log2L) == myblk) {
                const LAS unsigned char* Kb = lds + cur * KBUF;
                f32x16 s0 = {}, s1 = {};
#pragma unroll
                for (int ks = 0; ks < 8; ++ks) {
                    const bf16x8 a0 = *(const LAS bf16x8*)(Kb + r32 * 272 + ks * 32 + hi * 16), a1 = *(const LAS bf16x8*)(Kb + (32 + r32) * 272 + ks * 32 + hi * 16);
                    s0 = MFMA32(a0, qf[ks], s0); s1 = MFMA32(a1, qf[ks], s1);
                }
                const LAS float* tb = tab + tbase + 64 * t;
#pragma unroll
                for (int r = 0; r < 16; ++r) { s0[r] += tb[(r & 3) + 8 * (r >> 2)]; s1[r] += tb[32 + (r & 3) + 8 * (r >> 2)]; }
                float pmax = s0[0];
#pragma unroll
                for (int r = 1; r < 16; ++r) pmax = fmaxf(pmax, s0[r]);
#pragma unroll
                for (int r = 0; r < 16; ++r) pmax = fmaxf(pmax, s1[r]);
                pmax = xhalf_max(pmax);
                if (__any(pmax > m + 8.f)) {
                    const float mn = fmaxf(m, pmax), alpha = __builtin_amdgcn_exp2f(m - mn);
                    m = mn; l *= alpha;
#pragma unroll
                    for (int d = 0; d < 4; ++d)
#pragma unroll
                        for (int r = 0; r < 16; ++r) o[d][r] *= alpha;
                }
                float ps = 0.f;
#pragma unroll
                for (int r = 0; r < 16; ++r) { s0[r] = __builtin_amdgcn_exp2f(s0[r] - m); s1[r] = __builtin_amdgcn_exp2f(s1[r] - m); ps += s0[r] + s1[r]; }
                l += ps;
                bf16x8 pb[4];
                pb[0] = pack_p(s0, 0); pb[1] = pack_p(s0, 1); pb[2] = pack_p(s1, 0); pb[3] = pack_p(s1, 1);
                const unsigned va = trb + cur * VBUF;
                pv_tile(o[0], va, pb); pv_tile(o[1], va + 4096, pb); pv_tile(o[2], va + 8192, pb); pv_tile(o[3], va + 12288, pb);
            }
            if (t < thi) {
                const int nb = cur ^ 1;
                *(LAS bf16x8*)(lds + nb * KBUF + kdst) = k0r; *(LAS bf16x8*)(lds + nb * KBUF + kdst + 32 * 272) = k1r;
                *(LAS bf16x8*)(lds + VOFF + nb * VBUF + vdst) = v0r; *(LAS bf16x8*)(lds + VOFF + nb * VBUF + vdst + 32 * 64) = v1r;
            }
            __syncthreads();
        }
        l = xhalf_sum(l);
        const float inv = 1.f / l;
        const int f = f0 + wid * 32 + r32, stok = ((f & ((1 << log2L) - 1)) << sh) + (f >> log2L);
        const size_t orow = (size_t)rowbase + stok;
        bf16_t* op = OG + ((size_t)g * CHUNK + orow) * DM + h * 128 + 4 * hi;
#pragma unroll
        for (int d = 0; d < 4; ++d)
#pragma unroll
            for (int g4 = 0; g4 < 4; ++g4) {
                u32x2 w; w.x = cvt_pk_bf16(o[d][4 * g4] * inv, o[d][4 * g4 + 1] * inv); w.y = cvt_pk_bf16(o[d][4 * g4 + 2] * inv, o[d][4 * g4 + 3] * inv);
                *(u32x2*)(op + 32 * d + 8 * g4) = w;
            }
        if (hi == 0) LSE[((size_t)g * CHUNK + orow) * 8 + h] = m + __log2f(l);
    }
}
#undef DIL_DEC
#undef DIL_TILE

#define XB_TMO      128
#define XB_XCNT(j)  (256  + 64 * (j))
#define XB_XSUB(j)  (1280 + 64 * (j))
#define XB_XGEN(j)  (2304 + 64 * (j))
#define XB_TOP      3328
#define XB_TOPGEN   3392
#define XCD_BAR_WORDS 3456
#define XB_SPIN_CAP (1u << 18)

__device__ __forceinline__ unsigned xb_ld(unsigned* p)              { return __hip_atomic_load(p, __ATOMIC_RELAXED, __HIP_MEMORY_SCOPE_AGENT); }
__device__ __forceinline__ unsigned xb_add(unsigned* p, unsigned v) { return __hip_atomic_fetch_add(p, v, __ATOMIC_RELAXED, __HIP_MEMORY_SCOPE_AGENT); }
__device__ __forceinline__ unsigned xb_xcc_id() { return (unsigned)__builtin_amdgcn_s_getreg((3 << 11) | 20) & 0xFu; }
#define XB_SPIN(cond, bar) do { unsigned _sp = 0; while (cond) { __builtin_amdgcn_s_sleep(1); \
    if ((++_sp & 255u) == 0u) { if (xb_ld(&(bar)[XB_TMO])) break; if (_sp > XB_SPIN_CAP) { atomicAdd(&(bar)[XB_TMO], 1u); break; } } } } while (0)

struct XcdBarrier {
    unsigned* bar; unsigned x;
    volatile LAS unsigned* st;
};

__device__ __forceinline__ XcdBarrier xcd_barrier_post(unsigned* bar, volatile LAS unsigned* st) {
    XcdBarrier b; b.bar = bar; b.x = xb_xcc_id(); b.st = st;
    if (threadIdx.x == 0) (void)xb_add(&bar[XB_XCNT(b.x)], 1u);
    return b;
}
__device__ __forceinline__ void xcd_barrier_complete(unsigned* bar, unsigned x, unsigned& nloc, unsigned& nx) {
    const unsigned G = gridDim.x * gridDim.y * gridDim.z;
    unsigned sum, cnt, mine, sp = 0u;
    for (;;) {
        sum = 0u; cnt = 0u; mine = 0u;
#pragma unroll
        for (unsigned j = 0; j < 16; ++j) { const unsigned c = xb_ld(&bar[XB_XCNT(j)]); sum += c; cnt += (c > 0u) ? 1u : 0u; mine = (j == x) ? c : mine; }
        if (sum == G) break;
        __builtin_amdgcn_s_sleep(1);
        if ((++sp & 255u) == 0u) { if (xb_ld(&bar[XB_TMO])) break; if (sp > XB_SPIN_CAP) { atomicAdd(&bar[XB_TMO], 1u); break; } }
    }
    nloc = mine > 0u ? mine : 1u; nx = cnt > 0u ? cnt : 1u;
}

__device__ __forceinline__ void xcd_barrier(const XcdBarrier& b) {
    asm volatile("s_waitcnt vmcnt(0)" ::: "memory");
    __syncthreads();
    if (threadIdx.x == 0) {
        unsigned* bar = b.bar;
        __builtin_amdgcn_s_waitcnt(0);
        unsigned nloc = b.st[0], nx = b.st[1];
        if (nloc == 0u) { xcd_barrier_complete(bar, b.x, nloc, nx); b.st[0] = nloc; b.st[1] = nx; }
        const unsigned old = xb_add(&bar[XB_XSUB(b.x)], 1u);
        const unsigned gen = old / nloc;
        if (old + 1u == (gen + 1u) * nloc) {
            __builtin_amdgcn_fence(__ATOMIC_RELEASE, "agent");
            asm volatile("s_waitcnt vmcnt(0)" ::: "memory");
            const unsigned og = xb_add(&bar[XB_TOP], 1u);
            const unsigned tg = og / nx;
            if (og + 1u == (tg + 1u) * nx) xb_add(&bar[XB_TOPGEN], 1u);
            else XB_SPIN(xb_ld(&bar[XB_TOPGEN]) == tg, bar);
            __builtin_amdgcn_fence(__ATOMIC_ACQUIRE, "agent");
            xb_add(&bar[XB_XGEN(b.x)], 1u);
            asm volatile("s_waitcnt vmcnt(0)" ::: "memory");
        } else {
            XB_SPIN(xb_ld(&bar[XB_XGEN(b.x)]) == gen, bar);
            __builtin_amdgcn_fence(__ATOMIC_ACQUIRE, "agent");
            asm volatile("s_waitcnt vmcnt(0)" ::: "memory");
        }
    }
    __syncthreads();
}

__global__ void __launch_bounds__(512, 2) mega_fwd(Params p) {
    extern __shared__ __attribute__((aligned(16))) unsigned char lds_raw[];
    LAS unsigned char* lds = (LAS unsigned char*)lds_raw;
    const int G0 = gridDim.x, bx0 = blockIdx.x;
#define PH_LOCALS PH_WS; int tid = threadIdx.x; asm volatile("" : "+v"(tid)); const int lane = tid & 63, wave = __builtin_amdgcn_readfirstlane(tid >> 6), gw = bx * 8 + wave; (void)lane; (void)gw
#define PH_WS const __attribute__((address_space(4))) Params* kp = (const __attribute__((address_space(4))) Params*)__builtin_amdgcn_kernarg_segment_ptr(); asm volatile("" : "+s"(kp)); \
        unsigned char* ws = kp->ws; float* X = kp->out; (void)X; int G = G0, bx = bx0; asm volatile("" : "+s"(G), "+s"(bx)); const int NGW = G * 8; (void)NGW
#define XB ((bf16_t*)(ws + WS_XB))
#define OB ((bf16_t*)(ws + WS_O))
#define cosT ((float*)(ws + WS_COS))
#define sinT ((float*)(ws + WS_SIN))
#define BT ((float*)(ws + WS_BT))
#define RQ ((float*)(ws + WS_RQ))
#define RKV ((float*)(ws + WS_RKV))
#define WQKV ((bf16_t*)(ws + WS_WQKV))
#define WOA ((bf16_t*)(ws + WS_WOA))
#define WDKV ((bf16_t*)(ws + WS_WDKV))
#define WUQ ((bf16_t*)(ws + WS_WUQ))
#define WUKV ((bf16_t*)(ws + WS_WUKV))
#define WOB ((bf16_t*)(ws + WS_WOB))
#define WIN ((bf16_t*)(ws + WS_WIN))
#define WOUT ((bf16_t*)(ws + WS_WOUT))
#define QKV ((bf16_t*)(ws + WS_QKV))
#define OG ((bf16_t*)(ws + WS_OG))
#define LSE ((float*)(ws + WS_LSE))
#define CB ((bf16_t*)(ws + WS_C))
#define QB ((bf16_t*)(ws + WS_QB))
#define KVB ((bf16_t*)(ws + WS_KV))
#define KRR ((bf16_t*)(ws + WS_KRR))
#define UB ((bf16_t*)(ws + WS_U))
#define Y1B ((bf16_t*)(ws + WS_S))
#define Y2B ((bf16_t*)(ws + WS_Y2))
#define HB ((bf16_t*)(ws + WS_H))
    cg::grid_group grid = cg::this_grid();
    volatile LAS unsigned* bst = (volatile LAS unsigned*)(lds + LDS_BYTES - 64);
    if (threadIdx.x == 0) { bst[0] = 0u; bst[1] = 0u; }
    __syncthreads();
    const XcdBarrier xbar = xcd_barrier_post((unsigned*)(p.ws + WS_CTL), bst);
    int ph = 0;
    const int lo = p.ph_lo, hi = p.ph_hi;
#define PH_ON (ph >= lo && ph < hi)
#ifndef MK_EN
#define MK_EN 0xffffffffu
#endif
#define EN(k) (((MK_EN) >> (k)) & 1u)
#ifndef MK_REP
#define MK_REP 0u
#endif
#define REPN(k) ((((MK_REP) >> (k)) & 1u) != 0)
#define REPN(k) ((((MK_REP) >> (k)) & 1u) != 0)
#define REP(k) for (int rep_ = 0; rep_ < ((((MK_REP) >> (k)) & 1u) ? 2 : 1); ++rep_)
#define PH_END do { if (ph >= lo && ph + 1 < hi) { if (lo < 0) grid.sync(); else xcd_barrier(xbar); } ++ph; } while (0)

    if (EN(0) && PH_ON) REP(0) {
        PH_LOCALS;
        LAS float* scr = (LAS float*)(lds + wave * 16384);
        constexpr int I_QKV = (DM / 64) * (NQKV / 32), I_O = (DM / 64) * (DM / 32), I_DKV = (DM / 64) * (672 / 32), I_UQ = (NCQ / 64) * (NQ / 32), I_UKV = (NCKV / 64) * (NKV / 32);
        constexpr int I_IN = (DM / 64) * (NFF / 32), I_OUT = (DFF / 64) * (DM / 32);
        constexpr int NITEMS = I_QKV + 2 * I_O + I_DKV + I_UQ + I_UKV + 2 * I_IN + 2 * I_OUT;
        for (int it = gw; it < NITEMS; it += NGW) {
            int r = it;
            if (r < I_QKV) { transpose_item(kp->w_qkv_a, DM, NQKV, WQKV, 0, nullptr, scr, r, lane); continue; } r -= I_QKV;
            if (r < I_O) { transpose_item(kp->w_o_a, DM, DM, WOA, 0, nullptr, scr, r, lane); continue; } r -= I_O;
            if (r < I_O) { transpose_item(kp->w_o_b, DM, DM, WOB, 0, nullptr, scr, r, lane); continue; } r -= I_O;
            if (r < I_DKV) { transpose_item(kp->w_dkv_b, DM, 672, WDKV, 2, nullptr, scr, r, lane); continue; } r -= I_DKV;
            if (r < I_UQ) { transpose_item(kp->w_uq_b, NCQ, NQ, WUQ, 1, kp->g_q_b, scr, r, lane); continue; } r -= I_UQ;
            if (r < I_UKV) { transpose_item(kp->w_ukv_b, NCKV, NKV, WUKV, 0, kp->g_kv_b, scr, r, lane); continue; } r -= I_UKV;
            if (r < 2 * I_IN) { const int ly = r / I_IN; transpose_item(kp->ffn_w_in + (size_t)ly * DM * NFF, DM, NFF, WIN + (size_t)ly * NFF * DM, 0, nullptr, scr, r - ly * I_IN, lane); continue; } r -= 2 * I_IN;
            { const int ly = r / I_OUT; transpose_item(kp->ffn_w_out + (size_t)ly * DFF * DM, DFF, DM, WOUT + (size_t)ly * DM * DFF, 0, nullptr, scr, r - ly * I_OUT, lane); }
        }
        for (int i = bx * 512 + tid; i < 96 * DM / 8; i += G * 512) *((u32x4*)(WDKV + (size_t)672 * DM) + i) = (u32x4){0u, 0u, 0u, 0u};
        for (int r = gw; r < T; r += 2 * NGW) {
            const int r2 = r + NGW; const bool h2 = r2 < T;
            const float* src = r < TP ? kp->x_prompt + (size_t)r * DM : kp->x_sample + (size_t)(r - TP) * DM;
            const float* src2 = r2 < TP ? kp->x_prompt + (size_t)r2 * DM : kp->x_sample + (size_t)((h2 ? r2 : r) - TP) * DM;
            f32x4 va[4], vb[4] = {};
#pragma unroll
            for (int j = 0; j < 4; ++j) { va[j] = *((const f32x4*)src + lane + 64 * j); if (h2) vb[j] = *((const f32x4*)src2 + lane + 64 * j); }
#pragma unroll
            for (int j = 0; j < 4; ++j) {
                u32x2 w; w.x = cvt_pk_bf16(va[j].x, va[j].y); w.y = cvt_pk_bf16(va[j].z, va[j].w);
                *((u32x2*)(XB + (size_t)r * DM) + lane + 64 * j) = w;
                if (h2) { u32x2 w2; w2.x = cvt_pk_bf16(vb[j].x, vb[j].y); w2.y = cvt_pk_bf16(vb[j].z, vb[j].w); *((u32x2*)(XB + (size_t)r2 * DM) + lane + 64 * j) = w2; }
            }
        }
        for (int i = bx * 512 + tid; i < 8192 * 16; i += G * 512) { float c, s; rope_entry(i >> 4, i & 15, c, s); cosT[i] = c; sinT[i] = s; }
        for (int i = bx * 512 + tid; i < 24 * 384; i += G * 512) {
            const int gh = i / 384, d = i % 384 - 192, g = gh >> 3;
            float v = -1e30f;
            if (d >= -64 && d <= 64) v = kp->rel_bias[t5_bucket(d * (1 << (2 * g))) * 24 + gh] * LOG2E;
            BT[i] = v;
        }
    }
    PH_END;

    {
        for (int c = 0; c < NCHUNK; ++c) {
            const int row0 = c * CHUNK, log2S = c < 4 ? 13 : 11, nseq = c < 4 ? 2 : 8;
            if (EN(1) && PH_ON) REP(1) {
                PH_WS;
                pg8::Gemm g{XB + (size_t)row0 * DM, WQKV, CHUNK, NQKV, DM, DM}; pg8::StaticOrder S; S.init(CHUNK, NQKV, G, bx);
                pg8::EpiQKV E{QKV, log2S, 0.08838834764831845f * LOG2E};
                pg8::gemm_phase<pg8::EpiQKV, pg8::StaticOrder>(lds, g, S, E);
            }
            PH_END;
            if (EN(2) && PH_ON) REP(2) { PH_WS; attn_dil_phase(lds, QKV, BT, OG, LSE, nseq, log2S, G, bx); }
            PH_END;
            if (EN(3) && PH_ON) REP(3) {   PH_LOCALS;
                for (int r = gw; r < CHUNK; r += NGW) {
                    const int h = lane >> 3;
                    const float l0 = LSE[((size_t)0 * CHUNK + r) * 8 + h], l1 = LSE[((size_t)1 * CHUNK + r) * 8 + h], l2 = LSE[((size_t)2 * CHUNK + r) * 8 + h];
                    const float mx = fmaxf(l0, fmaxf(l1, l2));
                    float w0 = __builtin_amdgcn_exp2f(l0 - mx), w1 = __builtin_amdgcn_exp2f(l1 - mx), w2 = __builtin_amdgcn_exp2f(l2 - mx);
                    const float inv = 1.f / (w0 + w1 + w2); w0 *= inv; w1 *= inv; w2 *= inv;
#pragma unroll
                    for (int j = 0; j < 2; ++j) {
                        const bf16x8 a = *((const bf16x8*)(OG + ((size_t)0 * CHUNK + r) * DM) + lane * 2 + j), b = *((const bf16x8*)(OG + ((size_t)1 * CHUNK + r) * DM) + lane * 2 + j),
                                     cc = *((const bf16x8*)(OG + ((size_t)2 * CHUNK + r) * DM) + lane * 2 + j);
                        float v[8];
#pragma unroll
                        for (int e = 0; e < 8; ++e) v[e] = w0 * bf2f((unsigned short)a[e]) + w1 * bf2f((unsigned short)b[e]) + w2 * bf2f((unsigned short)cc[e]);
                        u32x4 w; w.x = cvt_pk_bf16(v[0], v[1]); w.y = cvt_pk_bf16(v[2], v[3]); w.z = cvt_pk_bf16(v[4], v[5]); w.w = cvt_pk_bf16(v[6], v[7]);
                        *((u32x4*)(OB + (size_t)(row0 + r) * DM) + lane * 2 + j) = w;
                    }
                }
            }
            if (c + 1 < NCHUNK && MK_MULTI == 0) ++ph; else PH_END;
        }
    }
    for (int layer = 0; layer < 2; ++layer) {
        if (layer == 1) {
            if (EN(4) && PH_ON) REP(4) {
                PH_WS;
                pg8::Gemm g{XB, WDKV, T, CW, DM, DM}; pg8::StaticOrder S; S.init(T, CW, G, bx);
                pg8::EpiStore E{CB, CW, nullptr, 1.f};
                pg8::gemm_phase<pg8::EpiStore, pg8::StaticOrder>(lds, g, S, E);
            }
            PH_END;
            if (EN(5) && PH_ON) REP(5) {   PH_LOCALS;
                for (int r = gw; r < T; r += NGW) {
                    const bf16_t* crow = CB + (size_t)r * CW;
                    const bf16x8 a = *((const bf16x8*)crow + lane);
                    bf16x8 b = {}; if (lane < 20) b = *((const bf16x8*)crow + 64 + lane);
                    float fa[8], fb[8], sa = 0.f, sb = 0.f;
#pragma unroll
                    for (int e = 0; e < 8; ++e) { fa[e] = bf2f((unsigned short)a[e]); fb[e] = bf2f((unsigned short)b[e]); sa += fa[e] * fa[e]; sb += fb[e] * fb[e]; }
                    const float sq = wave_sum(lane < 48 ? sa : 0.f, lane), skv = wave_sum((lane >= 48 ? sa : 0.f) + (lane < 16 ? sb : 0.f), lane);
                    if (lane == 0) { RQ[r] = 1.f / sqrtf(sq * (1.f / NCQ) + RMS_EPS); RKV[r] = 1.f / sqrtf(skv * (1.f / NCKV) + RMS_EPS); }
                    if (lane >= 16 && lane < 20) {
                        const int j = lane - 16, pos = r < TP ? (r & 8191) : (r & 2047);
                        const f32x4 cs = *(const f32x4*)(cosT + pos * 16 + 4 * j), sn = *(const f32x4*)(sinT + pos * 16 + 4 * j);
                        float o1[4], o2[4];
#pragma unroll
                        for (int e = 0; e < 4; ++e) { o1[e] = fb[e] * cs[e] - fb[4 + e] * sn[e]; o2[e] = fb[e] * sn[e] + fb[4 + e] * cs[e]; }
                        u32x4 w; w.x = cvt_pk_bf16(o1[0], o1[1]); w.y = cvt_pk_bf16(o1[2], o1[3]); w.z = cvt_pk_bf16(o2[0], o2[1]); w.w = cvt_pk_bf16(o2[2], o2[3]);
                        *((u32x4*)(KRR + (size_t)r * 32) + j) = w;
                    }
                }
            }
            PH_END;
            if (EN(6) && PH_ON) REP(6) {
                PH_WS;
                { pg8::Gemm g{CB, WUQ, T, NQ, NCQ, CW}; pg8::StaticOrder S; S.init(T, NQ, G, bx);
                  pg8::EpiQRope E{QB, RQ, 0.10206207261596575f * LOG2E, cosT, sinT};
                  pg8::gemm_phase<pg8::EpiQRope, pg8::StaticOrder>(lds, g, S, E); }
                { pg8::Gemm g{CB + NCQ, WUKV, T, NKV, NCKV, CW}; pg8::StaticOrder S; S.init(T, NKV, G, bx);
                  pg8::EpiStore E{KVB, NKV, RKV, 1.f};
                  pg8::gemm_phase<pg8::EpiStore, pg8::StaticOrder>(lds, g, S, E); }
            }
            PH_END;
            if (EN(7) && PH_ON) REP(7) { PH_WS; attn_mla_phase(lds, QB, KVB, KRR, OB, G, bx); }
            PH_END;
        }
        if (EN(8) && PH_ON) REP(8) {
                PH_WS;
            pg8::Gemm g{OB, layer == 0 ? WOA : WOB, T, DM, DM, DM}; pg8::StaticOrder S; S.init(T, DM, G, bx);
            pg8::EpiStore E{Y1B, DM, nullptr, 1.f};
            pg8::gemm_phase<pg8::EpiStore, pg8::StaticOrder>(lds, g, S, E);
        }
        PH_END;
        if (EN(9) && PH_ON) REP(9) { PH_LOCALS; ln_phase(layer == 0 ? kp->x_prompt : X, layer == 0 ? kp->x_sample : X + (size_t)TP * DM, Y1B, (REPN(9) && rep_ == 0) ? (float*)(ws + 560 * MiB) : X, (REPN(9) && rep_ == 0) ? OB : XB, kp->ln_g + (layer * 2 + 0) * DM, kp->ln_b + (layer * 2 + 0) * DM, gw, NGW, lane); }
        PH_END;
        {
            for (int c = 0; c < 3; ++c) {
                const int row0 = c * 32768, crows = c < 2 ? 32768 : 16384, log2S = c < 2 ? 13 : 11;
                if (EN(10) && PH_ON) REP(10) {
                PH_WS;
                    pg8::Gemm g{XB + (size_t)row0 * DM, WIN + (size_t)layer * NFF * DM, crows, NFF, DM, DM}; pg8::StaticOrder S; S.init(crows, NFF, G, bx);
                    pg8::EpiStore E{HB, NFF, nullptr, 1.f};
                    pg8::gemm_phase<pg8::EpiStore, pg8::StaticOrder>(lds, g, S, E);
                }
                PH_END;
                if (EN(11) && PH_ON) REP(11) {   PH_LOCALS;
                    const float* cw = kp->ffn_conv_w + (size_t)layer * 3 * NFF; const float* cb = kp->ffn_conv_b + (size_t)layer * NFF; const bf16_t* H = HB; bf16_t* U = UB;
                    const int nitems = (crows / 8) * 11, smask = (1 << log2S) - 1;
                    for (int it = gw; it < nitems; it += NGW) {
                        const int rr = it / 11, cgp = it - rr * 11, col = (cgp * 64 + lane) * 4, r0 = rr * 8;
                        u32x2 ra[10], rg[10];
                        const bool hp = (r0 & smask) != 0, hn = ((r0 + 8) & smask) != 0;
#pragma unroll
                        for (int i = 0; i < 10; ++i) {
                            const bool ok = (i == 0) ? hp : (i == 9) ? hn : true;
                            if (ok) { ra[i] = *(const u32x2*)(H + (size_t)(r0 - 1 + i) * NFF + col); rg[i] = *(const u32x2*)(H + (size_t)(r0 - 1 + i) * NFF + DFF + col); }
                            else { ra[i] = (u32x2){0u, 0u}; rg[i] = (u32x2){0u, 0u}; }
                        }
                        f32x4 wa[3], wg[3];
#pragma unroll
                        for (int k = 0; k < 3; ++k) { wa[k] = *(const f32x4*)(cw + k * NFF + col); wg[k] = *(const f32x4*)(cw + k * NFF + DFF + col); }
                        const f32x4 ba = *(const f32x4*)(cb + col), bg = *(const f32x4*)(cb + DFF + col);
#define BF4(u) ((f32x4){__uint_as_float((u).x << 16), __uint_as_float((u).x & 0xffff0000u), __uint_as_float((u).y << 16), __uint_as_float((u).y & 0xffff0000u)})
#pragma unroll
                        for (int i = 0; i < 8; ++i) {
                            const f32x4 av = wa[0] * BF4(ra[i]) + wa[1] * BF4(ra[i + 1]) + wa[2] * BF4(ra[i + 2]) + ba;
                            const f32x4 gv = wg[0] * BF4(rg[i]) + wg[1] * BF4(rg[i + 1]) + wg[2] * BF4(rg[i + 2]) + bg;
                            u32x2 w; w.x = cvt_pk_bf16(av[0] * gelu_erf(gv[0]), av[1] * gelu_erf(gv[1])); w.y = cvt_pk_bf16(av[2] * gelu_erf(gv[2]), av[3] * gelu_erf(gv[3]));
                            *(u32x2*)(U + (size_t)(row0 + r0 + i) * DFF + col) = w;
                        }
#undef BF4
                    }
                }
                PH_END;
            }
            if (EN(12) && PH_ON) REP(12) {
                PH_WS;
                pg8::Gemm g{UB, WOUT + (size_t)layer * DM * DFF, T, DM, DFF, DFF}; pg8::StaticOrder S; S.init(T, DM, G, bx);
                pg8::EpiStore E{Y2B, DM, nullptr, 1.f};
                pg8::gemm_phase<pg8::EpiStore, pg8::StaticOrder>(lds, g, S, E);
            }
            PH_END;
            if (EN(13) && PH_ON) REP(13) { PH_LOCALS; ln_phase(X, X + (size_t)TP * DM, Y2B, (REPN(13) && rep_ == 0) ? (float*)(ws + 222 * MiB) : X, (REPN(13) && rep_ == 0) ? (bf16_t*)(ws + 822 * MiB) : XB, kp->ln_g + (layer * 2 + 1) * DM, kp->ln_b + (layer * 2 + 1) * DM, gw, NGW, lane, layer == 0); }
            PH_END;
        }
    }
#undef PH_ON
#undef PH_END
}
constexpr int N_PHASES = 1 + 15 + 2 * (2 + 8) + 4;

extern "C" void kernel_launch(void* const* d_in, const int* in_sizes, int n_in, void* d_out, int out_size, void* d_ws, size_t ws_size, hipStream_t stream) {
    static int grid = 0;
    if (grid == 0) {
        if (n_in != 17 || out_size != T * DM || ws_size < WS_END) { fprintf(stderr, "kernel_launch: unexpected shapes (n_in %d out %d ws %zu)\n", n_in, out_size, ws_size); grid = -1; return; }
        int dev = 0, cus = 0, per_cu = 0;
        if (hipGetDevice(&dev) != hipSuccess || hipDeviceGetAttribute(&cus, hipDeviceAttributeMultiprocessorCount, dev) != hipSuccess) { grid = -1; return; }
        if (hipFuncSetAttribute((const void*)mega_fwd, hipFuncAttributeMaxDynamicSharedMemorySize, LDS_BYTES) != hipSuccess) { fprintf(stderr, "kernel_launch: hipFuncSetAttribute failed\n"); grid = -1; return; }
        if (hipOccupancyMaxActiveBlocksPerMultiprocessor(&per_cu, (const void*)mega_fwd, 512, LDS_BYTES) != hipSuccess || per_cu < 1) { fprintf(stderr, "kernel_launch: occupancy query says %d\n", per_cu); per_cu = 1; }
        (void)hipGetLastError();
        grid = cus * 1;
    }
    if (grid < 0) return;
    if (hipMemsetAsync((char*)d_ws + WS_CTL, 0, CTL_BYTES, stream) != hipSuccess) { fprintf(stderr, "kernel_launch: memset failed\n"); return; }
    Params p{};
    const float** pp = (const float**)&p;
    for (int i = 0; i < 17; ++i) pp[i] = (const float*)d_in[i];
    p.out = (float*)d_out; p.ws = (unsigned char*)d_ws;
#if MK_MULTI
    for (int k = 0; k < N_PHASES; ++k) { p.ph_lo = k; p.ph_hi = k + 1; hipLaunchKernelGGL(mega_fwd, dim3(grid), dim3(512), LDS_BYTES, stream, p); }
#else
    p.ph_lo = 0; p.ph_hi = N_PHASES;
    void* args[] = {&p};
    hipError_t e = hipLaunchCooperativeKernel((const void*)mega_fwd, dim3(grid), dim3(512), args, LDS_BYTES, stream);
    if (e != hipSuccess) fprintf(stderr, "cooperative launch failed: %s (grid %d)\n", hipGetErrorString(e), grid);
#endif
}
```

```cpp
#include <hip/hip_runtime.h>
#include <hip/hip_cooperative_groups.h>
#include <cstdio>
#include <cstdint>
namespace cg = cooperative_groups;

#ifndef MK_MULTI
#define MK_MULTI 0
#endif

#define LAS __attribute__((address_space(3)))
typedef unsigned short bf16_t;
typedef short bf16x8 __attribute__((ext_vector_type(8)));
typedef short s16x4 __attribute__((ext_vector_type(4)));
typedef float f32x4 __attribute__((ext_vector_type(4)));
typedef float f32x2 __attribute__((ext_vector_type(2)));
typedef float f32x16 __attribute__((ext_vector_type(16)));
typedef unsigned u32x4 __attribute__((ext_vector_type(4)));
typedef unsigned u32x2 __attribute__((ext_vector_type(2)));

constexpr int DM = 1024, TP = 65536, TS = 16384, T = TP + TS;
constexpr int NQKV = 9216, DFF = 2816, NFF = 2 * DFF;
constexpr int CW = 768, NCQ = 384, NCKV = 256, NQ = 1536, NKV = 2048;
constexpr int CHUNK = 16384, NCHUNK = 5;
constexpr float ALPHA = 1.4142135623730951f;
constexpr float LOG2E = 1.4426950408889634f;
constexpr float LN_EPS = 1e-5f, RMS_EPS = 1e-6f;

constexpr size_t MiB = 1u << 20;
constexpr size_t WS_COS = 0, WS_SIN = 512 * 1024, WS_BT = 1 * MiB, WS_RQ = 1 * MiB + 256 * 1024, WS_RKV = 1 * MiB + 640 * 1024;
constexpr size_t WS_WQKV = 2 * MiB, WS_WOA = 20 * MiB, WS_WDKV = 22 * MiB, WS_WUQ = 24 * MiB, WS_WUKV = 25 * MiB + 512 * 1024, WS_WOB = 27 * MiB;
constexpr size_t WS_WIN = 29 * MiB, WS_WOUT = 51 * MiB;
constexpr size_t WS_XB = 62 * MiB, WS_O = 222 * MiB, WS_C = 222 * MiB, WS_S = 382 * MiB;
constexpr size_t WS_QKV = WS_S, WS_OG = WS_S + 288 * MiB, WS_LSE = WS_S + 384 * MiB;
constexpr size_t WS_U = WS_O, WS_H = WS_O + 440 * MiB, WS_Y2 = WS_H;
constexpr size_t WS_QB = WS_S, WS_KV = WS_S + 240 * MiB, WS_KRR = WS_S + 560 * MiB;
constexpr size_t WS_CTL = 1016 * MiB, CTL_BYTES = 65536;
constexpr size_t WS_END = WS_CTL + CTL_BYTES;
constexpr int LDS_BYTES = 147456;

__device__ __forceinline__ unsigned cvt_pk_bf16(float lo, float hi) { unsigned r; asm("v_cvt_pk_bf16_f32 %0, %1, %2" : "=v"(r) : "v"(lo), "v"(hi)); return r; }
__device__ __forceinline__ u32x4 pack8(f32x4 v0, f32x4 v1) { u32x4 w; w.x = cvt_pk_bf16(v0[0], v0[1]); w.y = cvt_pk_bf16(v0[2], v0[3]); w.z = cvt_pk_bf16(v1[0], v1[1]); w.w = cvt_pk_bf16(v1[2], v1[3]); return w; }
__device__ __forceinline__ float bf2f(unsigned short b) { return __uint_as_float((unsigned)b << 16); }
__device__ __forceinline__ float wave_sum(float v, int lane) {
#pragma unroll
    for (int o = 1; o < 32; o <<= 1) v += __int_as_float(__builtin_amdgcn_ds_bpermute((lane ^ o) << 2, __float_as_int(v)));
    auto rr = __builtin_amdgcn_permlane32_swap(__float_as_uint(v), __float_as_uint(v), false, false);
    return __uint_as_float(rr[0]) + __uint_as_float(rr[1]);
}

namespace pg8 {
constexpr int BM = 256, BK = 64, HALF = 128, HTB = HALF * BK * 2, STAGE_BYTES = 8 * HTB, NXCD = 8, WGM = 8;
__host__ __device__ __forceinline__ int lds_byte(int r, int c) { const int st = (r >> 4) * 2 + (c >> 5), rr = r & 15, cc = c & 31, ob = rr * 64 + cc * 2; return st * 1024 + (ob ^ (((ob >> 9) & 1) << 5)); }
__host__ __device__ __forceinline__ void stage_rc(int b, int& R, int& C) { const int st = b / 1024, sb = b % 1024, swz = sb ^ (((sb >> 9) & 1) << 5); R = (st >> 1) * 16 + swz / 64; C = (st & 1) * 32 + (swz % 64) / 2; }
__host__ __device__ __forceinline__ int perm32(int rho) { const int n = rho >> 4, i = rho & 15; return 8 * (i >> 2) + 4 * n + (i & 3); }

struct Unit { int pm, pn; };
struct Gemm { const bf16_t* A; const bf16_t* Bt; int M, N, K, lda; };

struct StaticOrder {
    int nM, nN, nwg, G, c;
    __device__ void init(int M, int N, int G_, int c_) { nM = M / BM; nN = N / BM; nwg = nM * nN; G = G_; c = c_; }
    __device__ bool next(int i, Unit& u) const {
        const long L = (long)i * G + c; if (L >= nwg) return false;
        int wgid = (int)L; { const int q = nwg / NXCD, r = nwg % NXCD, xcd = wgid % NXCD, off = wgid / NXCD; wgid = (xcd < r ? xcd * (q + 1) : r * (q + 1) + (xcd - r) * q) + off; }
        const int nig = WGM * nN, gid = wgid / nig, fm = gid * WGM, gsz = (nM - fm) < WGM ? (nM - fm) : WGM;
        u.pm = fm + ((wgid % nig) % gsz); u.pn = (wgid % nig) / gsz; return true;
    }
};

struct EpiStore {
    static constexpr bool PERM = true;
    bf16_t* O; int ldc; const float* rscale; float cscale;
    __device__ __forceinline__ void operator()(const f32x4 (&acc)[2][2][4][2], const Unit& u, int wr, int wc, int fr, int fq) const {
        const int row0 = u.pm * BM + wr * 64 + fr, col0 = u.pn * BM + wc * 32 + 8 * fq;
#pragma unroll
        for (int ai = 0; ai < 2; ++ai)
#pragma unroll
            for (int m = 0; m < 4; ++m) {
                const int row = row0 + ai * HALF + m * 16;
                const float s = rscale ? rscale[row] * cscale : cscale;
                bf16_t* rowp = O + (size_t)row * ldc + col0;
#pragma unroll
                for (int bj = 0; bj < 2; ++bj) *(u32x4*)(rowp + bj * HALF) = pack8(acc[ai][bj][m][0] * s, acc[ai][bj][m][1] * s);
            }
    }
};
struct EpiQRope {
    static constexpr bool PERM = true;
    bf16_t* O; const float* rscale; float cscale; const float* cosT; const float* sinT;
    __device__ __forceinline__ void operator()(const f32x4 (&acc)[2][2][4][2], const Unit& u, int wr, int wc, int fr, int fq) const {
        const int row0 = u.pm * BM + wr * 64 + fr, col0 = u.pn * BM + wc * 32 + 8 * fq;
        int rj[2];
#pragma unroll
        for (int bj = 0; bj < 2; ++bj) { const int w = (col0 + bj * HALF) % 96; rj[bj] = (w >= 64) ? ((w - 64) >> 3) : -1; }
#pragma unroll
        for (int ai = 0; ai < 2; ++ai)
#pragma unroll
            for (int m = 0; m < 4; ++m) {
                const int row = row0 + ai * HALF + m * 16;
                const float s = rscale[row] * cscale;
                const int pos = row < TP ? (row & 8191) : (row & 2047);
                bf16_t* rowp = O + (size_t)row * NQ + col0;
#pragma unroll
                for (int bj = 0; bj < 2; ++bj) {
                    f32x4 v0 = acc[ai][bj][m][0] * s, v1 = acc[ai][bj][m][1] * s;
                    if (rj[bj] >= 0) {
                        const f32x4 cs = *(const f32x4*)(cosT + pos * 16 + 4 * rj[bj]), sn = *(const f32x4*)(sinT + pos * 16 + 4 * rj[bj]);
                        const f32x4 t1 = v0, t2 = v1; v0 = t1 * cs - t2 * sn; v1 = t1 * sn + t2 * cs;
                    }
                    *(u32x4*)(rowp + bj * HALF) = pack8(v0, v1);
                }
            }
    }
};
struct EpiQKV {
    static constexpr bool PERM = true;
    bf16_t* O; int log2S; float qscale;
    __device__ __forceinline__ void operator()(const f32x4 (&acc)[2][2][4][2], const Unit& u, int wr, int wc, int fr, int fq) const {
        const int colt = u.pn * BM, g = colt / 3072, which = (colt - g * 3072) >> 10, sh = 2 * g, log2L = log2S - sh, S = 1 << log2S;
        const float sc = (which == 0) ? qscale : 1.f;
        const int row0 = u.pm * BM + wr * 64 + fr, col0 = colt + wc * 32 + 8 * fq;
#pragma unroll
        for (int ai = 0; ai < 2; ++ai)
#pragma unroll
            for (int m = 0; m < 4; ++m) {
                const int rl = row0 + ai * HALF + m * 16, seq = rl >> log2S, s = rl & (S - 1);
                const int f = ((s & ((1 << sh) - 1)) << log2L) + (s >> sh), drow = (seq << log2S) + f;
                bf16_t* rowp = O + (size_t)drow * NQKV + col0;
#pragma unroll
                for (int bj = 0; bj < 2; ++bj) *(u32x4*)(rowp + bj * HALF) = pack8(acc[ai][bj][m][0] * sc, acc[ai][bj][m][1] * sc);
            }
    }
};
struct EpiRes {
    static constexpr bool PERM = true;
    float* X; float alpha;
    __device__ __forceinline__ void operator()(const f32x4 (&acc)[2][2][4][2], const Unit& u, int wr, int wc, int fr, int fq) const {
        const int row0 = u.pm * BM + wr * 64 + fr, col0 = u.pn * BM + wc * 32 + 8 * fq;
#pragma unroll
        for (int ai = 0; ai < 2; ++ai)
#pragma unroll
            for (int m = 0; m < 4; ++m) {
                float* rowp = X + (size_t)(row0 + ai * HALF + m * 16) * DM + col0;
#pragma unroll
                for (int bj = 0; bj < 2; ++bj) {
                    float* p = rowp + bj * HALF; const f32x4 a = *(const f32x4*)p, b = *(const f32x4*)(p + 4);
                    *(f32x4*)p = a * alpha + acc[ai][bj][m][0]; *(f32x4*)(p + 4) = b * alpha + acc[ai][bj][m][1];
                }
            }
    }
};

template <class Epi, class Sched, bool ALIGN_EPI = true, bool SP2 = true>
__device__ __forceinline__ void gemm_phase(LAS unsigned char* lds, const Gemm g, const Sched& S, const Epi& E) {
    int tid_ = threadIdx.x; asm volatile("" : "+v"(tid_));
    const int tid = tid_, wid = __builtin_amdgcn_readfirstlane(tid >> 6), lane = tid & 63, wr = wid >> 2, wc = wid & 3, fr = lane & 15, fq = lane >> 4;
    const int K = g.K, nt = K / BK, lda = g.lda;
    unsigned voffA[2], voffB[2];
#pragma unroll
    for (int i = 0; i < 2; ++i) { int R, C; stage_rc(tid * 16 + i * 8192, R, C); const int Rb = Epi::PERM ? ((R & ~31) + perm32(R & 31)) : R;
        voffA[i] = (unsigned)(R * lda + C) * 2u; voffB[i] = (unsigned)(Rb * K + C) * 2u; }
    const size_t kstep = (size_t)(BK * 2);
    const size_t hstepA = (size_t)HALF * lda * 2, hstepB = (size_t)HALF * K * 2;
    const size_t tstepA = 2 * hstepA, tstepB = 2 * hstepB;
    const unsigned ldsw = (unsigned)wid * 1024u;
    const int aoff = lds_byte(wr * 64 + fr, fq * 8), boff = lds_byte(wc * 32 + fr, fq * 8);
#define PG8_SA(b, h) (((b) * 2 + (h)) * HTB)
#define PG8_SB(b, h) ((4 + (b) * 2 + (h)) * HTB)
#define PG8_STAGE(bufoff, gbase, voff) do { _Pragma("unroll") for (int _i = 0; _i < 2; ++_i) \
        __builtin_amdgcn_global_load_lds((const unsigned*)((const char*)(gbase) + (voff)[_i]), (LAS unsigned*)(lds + (bufoff) + ldsw + _i * 8192), 16, 0, 0); } while (0)
#define PG8_LDA(dst, b, h) do { _Pragma("unroll") for (int m = 0; m < 4; ++m) _Pragma("unroll") for (int k = 0; k < 2; ++k) dst[m][k] = *(const LAS bf16x8*)(lds + PG8_SA(b, h) + aoff + m * 2048 + k * 1024); } while (0)
#define PG8_LDB(dst, b, h) do { _Pragma("unroll") for (int n = 0; n < 2; ++n) _Pragma("unroll") for (int k = 0; k < 2; ++k) dst[n][k] = *(const LAS bf16x8*)(lds + PG8_SB(b, h) + boff + n * 2048 + k * 1024); } while (0)
#define PG8_MMA(ai, bj, At, Bt) do { __builtin_amdgcn_s_setprio(1); _Pragma("unroll") for (int m = 0; m < 4; ++m) _Pragma("unroll") for (int n = 0; n < 2; ++n) _Pragma("unroll") for (int k = 0; k < 2; ++k) \
        acc[ai][bj][m][n] = __builtin_amdgcn_mfma_f32_16x16x32_bf16(Bt[n][k], At[m][k], acc[ai][bj][m][n], 0, 0, 0); __builtin_amdgcn_s_setprio(0); } while (0)
#define PG8_WAIT_V(n) asm volatile("s_waitcnt vmcnt(" #n ")" ::: "memory")
#define PG8_WAIT_L(n) asm volatile("s_waitcnt lgkmcnt(" #n ")" ::: "memory")
#define PG8_BAR __builtin_amdgcn_s_barrier()
#define PG8_SCHED __builtin_amdgcn_sched_barrier(0)
    Unit cur, nxt; int ui = 0;
    if (!S.next(0, cur)) return;
    f32x4 acc[2][2][4][2];
#pragma unroll
    for (int a = 0; a < 2; ++a)
#pragma unroll
        for (int b = 0; b < 2; ++b)
#pragma unroll
            for (int m = 0; m < 4; ++m)
#pragma unroll
                for (int n = 0; n < 2; ++n) acc[a][b][m][n] = (f32x4){0.f, 0.f, 0.f, 0.f};
    bf16x8 At[4][2], B0[2][2], B1[2][2];
    const char* cA = (const char*)g.A + (size_t)cur.pm * tstepA; const char* cB = (const char*)g.Bt + (size_t)cur.pn * tstepB;
    if constexpr (SP2) {
        PG8_STAGE(PG8_SB(0, 0), cB, voffB); PG8_STAGE(PG8_SB(0, 1), cB + hstepB, voffB); PG8_STAGE(PG8_SA(0, 0), cA, voffA); PG8_STAGE(PG8_SA(0, 1), cA + hstepA, voffA);
        if (wr == 1) PG8_BAR;
        PG8_WAIT_V(2); PG8_BAR;
        PG8_STAGE(PG8_SB(1, 0), cB + kstep, voffB); PG8_STAGE(PG8_SA(1, 0), cA + kstep, voffA); PG8_STAGE(PG8_SB(1, 1), cB + hstepB + kstep, voffB);
        PG8_WAIT_V(6); PG8_BAR;
    }
    for (;;) {
        const bool has_next = S.next(ui + 1, nxt);
        const char* nA = has_next ? (const char*)g.A + (size_t)nxt.pm * tstepA : cA; const char* nB = has_next ? (const char*)g.Bt + (size_t)nxt.pn * tstepB : cB;
        for (int t = 0; t < nt; t += 2) {
            const bool last = (t == nt - 2);
            const char* a1 = cA + (size_t)(t + 1) * kstep;
            const char* a2 = last ? nA : cA + (size_t)(t + 2) * kstep; const char* b2 = last ? nB : cB + (size_t)(t + 2) * kstep;
            const char* a3 = a2 + kstep; const char* b3 = b2 + kstep;
            PG8_LDB(B0, 0, 0); PG8_LDB(B1, 0, 1); PG8_SCHED; PG8_LDA(At, 0, 0); PG8_STAGE(PG8_SA(1, 1), a1 + hstepA, voffA);
            PG8_WAIT_V(8); PG8_WAIT_L(0); PG8_BAR; PG8_MMA(0, 0, At, B0); PG8_MMA(0, 1, At, B1); PG8_BAR; PG8_SCHED;
            PG8_LDA(At, 0, 1); PG8_STAGE(PG8_SB(0, 0), b2, voffB); PG8_STAGE(PG8_SB(0, 1), b2 + hstepB, voffB); PG8_STAGE(PG8_SA(0, 0), a2, voffA);
            PG8_WAIT_V(8); PG8_WAIT_L(0); PG8_BAR; PG8_MMA(1, 0, At, B0); PG8_MMA(1, 1, At, B1); PG8_BAR; PG8_SCHED;
            PG8_LDB(B0, 1, 0); PG8_LDB(B1, 1, 1); PG8_SCHED; PG8_LDA(At, 1, 0); PG8_STAGE(PG8_SA(0, 1), a2 + hstepA, voffA);
            PG8_WAIT_V(8); PG8_WAIT_L(0); PG8_BAR; PG8_MMA(0, 0, At, B0); PG8_MMA(0, 1, At, B1); PG8_BAR; PG8_SCHED;
            PG8_LDA(At, 1, 1); PG8_STAGE(PG8_SB(1, 0), b3, voffB); PG8_STAGE(PG8_SB(1, 1), b3 + hstepB, voffB); PG8_STAGE(PG8_SA(1, 0), a3, voffA);
            PG8_WAIT_V(8); PG8_WAIT_L(0); PG8_BAR; PG8_MMA(1, 0, At, B0); PG8_MMA(1, 1, At, B1); PG8_BAR; PG8_SCHED;
        }
        if constexpr (ALIGN_EPI) { if (wr == 0) PG8_BAR; }
        { int l2 = threadIdx.x; asm volatile("" : "+v"(l2)); l2 &= 63; E(acc, cur, wr, wc, l2 & 15, l2 >> 4); }
        if (!has_next) break;
#pragma unroll
        for (int a = 0; a < 2; ++a)
#pragma unroll
            for (int b = 0; b < 2; ++b)
#pragma unroll
                for (int m = 0; m < 4; ++m)
#pragma unroll
                    for (int n = 0; n < 2; ++n) acc[a][b][m][n] = (f32x4){0.f, 0.f, 0.f, 0.f};
        cur = nxt; cA = nA; cB = nB; ++ui;
        if constexpr (ALIGN_EPI) { if (wr == 1) PG8_BAR; }
    }
    PG8_WAIT_V(0);
    if constexpr (!ALIGN_EPI) { if (wr == 0) PG8_BAR; }
    PG8_BAR;
#undef PG8_SA
#undef PG8_SB
#undef PG8_STAGE
#undef PG8_LDA
#undef PG8_LDB
#undef PG8_MMA
#undef PG8_WAIT_V
#undef PG8_WAIT_L
#undef PG8_BAR
#undef PG8_SCHED
}
}

struct Params {
    const float *x_prompt, *x_sample, *rel_bias, *w_qkv_a, *w_o_a, *w_dkv_b, *g_q_b, *g_kv_b, *w_uq_b, *w_ukv_b, *w_o_b, *ffn_w_in, *ffn_conv_w, *ffn_conv_b, *ffn_w_out, *ln_g, *ln_b;
    float* out; unsigned char* ws;
    int ph_lo, ph_hi;
};

__device__ __forceinline__ int rope_perm32(int i) { const int t = i >> 4, ii = i & 15; return 8 * (ii >> 2) + 4 * t + (ii & 3); }
__device__ __forceinline__ int rowmap(int mode, int n) {
    if (mode == 1) { const int h = n / 96, w = n - h * 96; return w < 64 ? n : h * 96 + 64 + rope_perm32(w - 64); }
    if (mode == 2) { return n < 640 ? n : 640 + rope_perm32(n - 640); }
    return n;
}
__device__ __forceinline__ void transpose_item(const float* W, int K, int N, bf16_t* WT, int mode, const float* kscale, LAS float* scr, int item, int lane) {
    const int nblk = N / 32, kb = item / nblk, nb = item % nblk, k0 = 64 * kb, n0 = 32 * nb;
    const int kr = lane >> 3, c4 = (lane & 7) * 4;
#pragma unroll
    for (int i = 0; i < 8; ++i) { const int kk = kr + 8 * i; f32x4 v = *(const f32x4*)(W + (size_t)(k0 + kk) * N + n0 + c4); if (kscale) v = v * kscale[k0 + kk];
        scr[kk * 33 + c4] = v.x; scr[kk * 33 + c4 + 1] = v.y; scr[kk * 33 + c4 + 2] = v.z; scr[kk * 33 + c4 + 3] = v.w; }
    asm volatile("s_waitcnt lgkmcnt(0)" ::: "memory");
    const int c = lane & 7;
#pragma unroll
    for (int j = 0; j < 4; ++j) { const int n = (lane >> 3) + 8 * j; const LAS float* s = scr + (8 * c) * 33 + n;
        u32x4 o; o.x = cvt_pk_bf16(s[0 * 33], s[1 * 33]); o.y = cvt_pk_bf16(s[2 * 33], s[3 * 33]); o.z = cvt_pk_bf16(s[4 * 33], s[5 * 33]); o.w = cvt_pk_bf16(s[6 * 33], s[7 * 33]);
        *(u32x4*)(WT + (size_t)rowmap(mode, n0 + n) * K + k0 + 8 * c) = o; }
    asm volatile("s_waitcnt lgkmcnt(0)" ::: "memory");
}
__device__ __forceinline__ int t5_bucket(int rel) {
    const int n = rel < 0 ? -rel : rel; const int ret = rel > 0 ? 16 : 0;
    if (n < 8) return ret + n;
    int large = 8 + (int)(__log2f((float)n * 0.125f) * (8.0f / 7.0f));
    if (large > 15) large = 15;
    return ret + large;
}
__device__ __forceinline__ void rope_entry(int pos, int i, float& c, float& s) {
    const double x = -(double)i * (13.287712379549449 / 16.0);
    const double fl = __builtin_floor(x), fr = (x - fl) * 0.6931471805599453;
    double e = 1.0, term = 1.0;
#pragma unroll 1
    for (int k = 1; k < 22; ++k) { term *= fr / (double)k; e += term; }
    const long long bits = (long long)(1023 + (int)fl) << 52;
    const double inv = e * __builtin_bit_cast(double, bits);
    const double ang = (double)pos * inv;
    const double kq = __builtin_rint(ang * 0.6366197723675814);
    double r = __builtin_fma(-kq, 1.5707963267948966, ang); r = __builtin_fma(-kq, 6.123233995736766e-17, r);
    const double r2 = r * r;
    double sp = r * (1.0 + r2 * (-1.0 / 6 + r2 * (1.0 / 120 + r2 * (-1.0 / 5040 + r2 * (1.0 / 362880 + r2 * (-1.0 / 39916800 + r2 * (1.0 / 6227020800.0)))))));
    double cp = 1.0 + r2 * (-0.5 + r2 * (1.0 / 24 + r2 * (-1.0 / 720 + r2 * (1.0 / 40320 + r2 * (-1.0 / 3628800 + r2 * (1.0 / 479001600.0))))));
    const int q = (int)((long long)kq & 3);
    double sv = (q == 0) ? sp : (q == 1) ? cp : (q == 2) ? -sp : -cp;
    double cv = (q == 0) ? cp : (q == 1) ? -sp : (q == 2) ? -cp : sp;
    c = (float)cv; s = (float)sv;
}

__device__ __forceinline__ float gelu_erf(float v) {
    const float av = __builtin_fabsf(v), d = av * 0.2316418882f + 1.0f, t = __builtin_amdgcn_rcpf(d);
    float q = t * 0.5307027145f + (-0.7265760135f); q = q * t + 0.7107068705f; q = q * t + (-0.142248368f); q = q * t + 0.127414796f; q = q * t;
    const float e = __builtin_amdgcn_exp2f((v * v) * (-0.72134752044f));
    const float m = v * (q * e), r = v - m;
    return v < 0.f ? m : r;
}

__device__ __forceinline__ void ln_phase(const float* x0, const float* x1, const bf16_t* Y, float* Xo, bf16_t* XBo, const float* g, const float* b, int gw, int NGW, int lane, bool wb = true) {
    f32x4 gg[4], bb[4];
#pragma unroll
    for (int j = 0; j < 4; ++j) { gg[j] = *((const f32x4*)g + lane + 64 * j); bb[j] = *((const f32x4*)b + lane + 64 * j); }
    f32x4 cx[4]; u32x2 cy[4];
#define LN_LOAD(r, vx, vy) do { const float* src_ = (r) < TP ? x0 + (size_t)(r) * DM : x1 + (size_t)((r) - TP) * DM; \
        _Pragma("unroll") for (int j = 0; j < 4; ++j) { vx[j] = *((const f32x4*)src_ + lane + 64 * j); vy[j] = *((const u32x2*)(Y + (size_t)(r) * DM) + lane + 64 * j); } } while (0)
    if (gw < T) LN_LOAD(gw, cx, cy);
    for (int r = gw; r < T; r += NGW) {
        f32x4 nx[4] = {}; u32x2 ny[4] = {};
        const int rn = r + NGW;
        if (rn < T) LN_LOAD(rn, nx, ny);
        f32x4 v[4]; float s = 0.f;
#pragma unroll
        for (int j = 0; j < 4; ++j) {
            const f32x4 yf = {__uint_as_float(cy[j].x << 16), __uint_as_float(cy[j].x & 0xffff0000u), __uint_as_float(cy[j].y << 16), __uint_as_float(cy[j].y & 0xffff0000u)};
            v[j] = cx[j] * ALPHA + yf; s += (v[j].x + v[j].y) + (v[j].z + v[j].w);
        }
        const float mean = wave_sum(s, lane) * (1.f / DM); float s2 = 0.f;
#pragma unroll
        for (int j = 0; j < 4; ++j) { v[j] = v[j] - mean; s2 += (v[j].x * v[j].x + v[j].y * v[j].y) + (v[j].z * v[j].z + v[j].w * v[j].w); }
        const float rstd = 1.f / sqrtf(wave_sum(s2, lane) * (1.f / DM) + LN_EPS);
#pragma unroll
        for (int j = 0; j < 4; ++j) {
            const f32x4 o = v[j] * rstd * gg[j] + bb[j];
            *((f32x4*)(Xo + (size_t)r * DM) + lane + 64 * j) = o;
            if (wb) { u32x2 w; w.x = cvt_pk_bf16(o.x, o.y); w.y = cvt_pk_bf16(o.z, o.w); *((u32x2*)(XBo + (size_t)r * DM) + lane + 64 * j) = w; }
        }
#pragma unroll
        for (int j = 0; j < 4; ++j) { cx[j] = nx[j]; cy[j] = ny[j]; }
    }
#undef LN_LOAD
}

__device__ __forceinline__ s16x4 tr_read(unsigned addr) { s16x4 r; asm volatile("ds_read_b64_tr_b16 %0, %1" : "=&v"(r) : "v"(addr) : "memory"); return r; }
#define MFMA32(a, b, c) __builtin_amdgcn_mfma_f32_32x32x16_bf16(a, b, c, 0, 0, 0)
__device__ __forceinline__ float xhalf_max(float v) { auto rr = __builtin_amdgcn_permlane32_swap(__float_as_uint(v), __float_as_uint(v), false, false); return fmaxf(__uint_as_float(rr[0]), __uint_as_float(rr[1])); }
__device__ __forceinline__ float xhalf_sum(float v) { auto rr = __builtin_amdgcn_permlane32_swap(__float_as_uint(v), __float_as_uint(v), false, false); return __uint_as_float(rr[0]) + __uint_as_float(rr[1]); }
__device__ __forceinline__ float max3(float a, float b, float c) { float r; asm("v_max3_f32 %0, %1, %2, %3" : "=v"(r) : "v"(a), "v"(b), "v"(c)); return r; }
__device__ __forceinline__ bf16x8 pack_p(const f32x16& p, int j2) {
    u32x4 w; w.x = cvt_pk_bf16(p[8 * j2 + 0], p[8 * j2 + 1]); w.y = cvt_pk_bf16(p[8 * j2 + 2], p[8 * j2 + 3]); w.z = cvt_pk_bf16(p[8 * j2 + 4], p[8 * j2 + 5]); w.w = cvt_pk_bf16(p[8 * j2 + 6], p[8 * j2 + 7]);
    return __builtin_bit_cast(bf16x8, w);
}
__device__ __forceinline__ void pv_tile(f32x16& o, unsigned vaddr, const bf16x8 (&pb)[4]) {
    s16x4 lo[4], hi[4];
#pragma unroll
    for (int k = 0; k < 4; ++k) { lo[k] = tr_read(vaddr + (16 * k) * 64); hi[k] = tr_read(vaddr + (16 * k + 8) * 64); }
    asm volatile("s_waitcnt lgkmcnt(0)" ::: "memory"); __builtin_amdgcn_sched_barrier(0);
#pragma unroll
    for (int k = 0; k < 4; ++k) { const bf16x8 a = (bf16x8){lo[k][0], lo[k][1], lo[k][2], lo[k][3], hi[k][0], hi[k][1], hi[k][2], hi[k][3]}; o = MFMA32(a, pb[k], o); }
}

__device__ __forceinline__ void pv_issue(unsigned vaddr, s16x4 (&lo)[4], s16x4 (&hi)[4]) {
#pragma unroll
    for (int k = 0; k < 4; ++k) { lo[k] = tr_read(vaddr + (16 * k) * 64); hi[k] = tr_read(vaddr + (16 * k + 8) * 64); }
}
__device__ __forceinline__ void pv_mma(f32x16& o, const s16x4 (&lo)[4], const s16x4 (&hi)[4], const bf16x8 (&pb)[4]) {
#pragma unroll
    for (int k = 0; k < 4; ++k) { const bf16x8 a = (bf16x8){lo[k][0], lo[k][1], lo[k][2], lo[k][3], hi[k][0], hi[k][1], hi[k][2], hi[k][3]}; o = MFMA32(a, pb[k], o); }
}
__device__ __forceinline__ void pv_mma2(f32x16& o0, f32x16& o1, const s16x4 (&l0)[4], const s16x4 (&h0)[4], const s16x4 (&l1)[4], const s16x4 (&h1)[4], const bf16x8 (&pb)[4]) {
#pragma unroll
    for (int k = 0; k < 4; ++k) {
        const bf16x8 a0 = (bf16x8){l0[k][0], l0[k][1], l0[k][2], l0[k][3], h0[k][0], h0[k][1], h0[k][2], h0[k][3]};
        const bf16x8 a1 = (bf16x8){l1[k][0], l1[k][1], l1[k][2], l1[k][3], h1[k][0], h1[k][1], h1[k][2], h1[k][3]};
        o0 = MFMA32(a0, pb[k], o0); o1 = MFMA32(a1, pb[k], o1);
    }
}
#define MLA_QK_(cur) { const LAS unsigned char* Kb_ = lds + cur * KBUF; s0 = (f32x16){}; s1 = (f32x16){}; \
            _Pragma("unroll") \
            for (int ks = 0; ks < 6; ++ks) { \
                const bf16x8 a0 = *(const LAS bf16x8*)(Kb_ + r32 * 208 + ks * 32 + hi * 16), a1 = *(const LAS bf16x8*)(Kb_ + (32 + r32) * 208 + ks * 32 + hi * 16); \
                s0 = MFMA32(a0, qf[ks], s0); s1 = MFMA32(a1, qf[ks], s1); \
            } }
#define MLA_ROWMAX_() \
            float pa = max3(s0[0], s0[1], s0[2]), pc = max3(s1[0], s1[1], s1[2]); \
            _Pragma("unroll") \
            for (int r = 3; r < 15; r += 2) { pa = max3(pa, s0[r], s0[r + 1]); pc = max3(pc, s1[r], s1[r + 1]); } \
            float pmax = max3(pa, pc, fmaxf(s0[15], s1[15])); \
            pmax = xhalf_max(pmax)
#define MLA_EXPSUM_() { \
            f32x2 pa2 = {0.f, 0.f}, pb2 = {0.f, 0.f}, pc2 = {0.f, 0.f}, pd2 = {0.f, 0.f};     \
            _Pragma("unroll") \
            for (int r = 0; r < 16; ++r) { s0[r] = __builtin_amdgcn_exp2f(s0[r]); s1[r] = __builtin_amdgcn_exp2f(s1[r]); } \
            _Pragma("unroll") \
            for (int r = 0; r < 16; r += 4) { pa2 += (f32x2){s0[r], s0[r + 1]}; pb2 += (f32x2){s0[r + 2], s0[r + 3]}; pc2 += (f32x2){s1[r], s1[r + 1]}; pd2 += (f32x2){s1[r + 2], s1[r + 3]}; } \
            { const f32x2 t2 = (pa2 + pb2) + (pc2 + pd2); ps = t2.x + t2.y; } }
#define MLA_COMPUTE(cur) { \
            f32x16 s0, s1; float ps; \
            MLA_QK_(cur) \
            const unsigned va = trb + cur * VBUF; \
            s16x4 vl0[4], vh0[4], vl1[4], vh1[4]; \
            pv_issue(va, vl0, vh0); pv_issue(va + 4096, vl1, vh1);    \
            if (slow || j == 0) { \
                MLA_ROWMAX_(); \
                if (__any(pmax - m > (slow ? 8.f : 64.f)) || (j == 0 && __any(pmax < -32.f))) { \
                    const float mn = (j == 0) ? pmax : fmaxf(m, pmax), alpha = (j == 0) ? 1.f : __builtin_amdgcn_exp2f(m - mn); \
                    m = mn; l *= alpha; slow = true; \
                    _Pragma("unroll") \
                    for (int r = 0; r < 16; ++r) { o0[r] *= alpha; o1[r] *= alpha; } \
                } \
                if (slow) { \
                    _Pragma("unroll") \
                    for (int r = 0; r < 16; ++r) { s0[r] -= m; s1[r] -= m; } \
                } \
            } \
            MLA_EXPSUM_() \
            bf16x8 pb[4]; \
            pb[0] = pack_p(s0, 0); pb[1] = pack_p(s0, 1); pb[2] = pack_p(s1, 0); pb[3] = pack_p(s1, 1);     \
            if (!slow && __any(!(ps < 1e30f))) {     \
                MLA_QK_(cur) \
                MLA_ROWMAX_(); \
                const float mn = fmaxf(m, pmax), alpha = __builtin_amdgcn_exp2f(m - mn); \
                m = mn; l *= alpha; slow = true; \
                _Pragma("unroll") \
                for (int r = 0; r < 16; ++r) { o0[r] *= alpha; o1[r] *= alpha; s0[r] -= m; s1[r] -= m; } \
                MLA_EXPSUM_() \
                pb[0] = pack_p(s0, 0); pb[1] = pack_p(s0, 1); pb[2] = pack_p(s1, 0); pb[3] = pack_p(s1, 1); \
            } \
            l += ps; \
            asm volatile("s_waitcnt lgkmcnt(0)" ::: "memory"); __builtin_amdgcn_sched_barrier(0); \
            pv_mma2(o0, o1, vl0, vh0, vl1, vh1, pb); \
            }
__device__ __forceinline__ void attn_mla_phase(LAS unsigned char* lds, const bf16_t* QB, const bf16_t* KV, const bf16_t* KRR, bf16_t* O, int G, int bx) {
    constexpr int KBUF = 64 * 208, VBUF = 8192, VOFF = 2 * KBUF;
    int tid_ = threadIdx.x; asm volatile("" : "+v"(tid_));
    const int tid = tid_, wid = __builtin_amdgcn_readfirstlane(tid >> 6), lane = tid & 63, r32 = lane & 31, hi = lane >> 5;
    const bool xs = (G % 8) == 0;
    const int nslots = xs ? G / 8 : G, slot = xs ? bx / 8 : bx, xcd = xs ? bx % 8 : 0, npx = xs ? 16 : 128;
    const int nent = npx * 40;
    const int skey = tid >> 3, sch = tid & 7, rkey = tid >> 2, rch = tid & 3;
    const int kdst = skey * 208 + sch * 16, rdst = rkey * 208 + 128 + rch * 16, vdst = (sch >> 2) * 4096 + skey * 64 + (sch & 3) * 16;
    const unsigned trb = (unsigned)(size_t)(lds + VOFF) + (unsigned)((4 * hi + ((lane & 15) >> 2)) * 64 + 32 * ((lane >> 4) & 1) + 8 * (lane & 3));
#define MLA_DEC(LI, P) int P##pair, P##qb, P##base, P##S; \
        if ((LI) < npx * 32) { P##pair = xs ? ((LI) >> 5) * 8 + xcd : ((LI) >> 5); P##qb = (LI) & 31; P##base = (P##pair >> 4) * 8192; P##S = 8192; } \
        else { const int l2_ = (LI) - npx * 32; P##pair = xs ? (l2_ >> 3) * 8 + xcd : (l2_ >> 3); P##qb = l2_ & 7; P##base = TP + (P##pair >> 4) * 2048; P##S = 2048; } \
        const int P##h = P##pair & 15; \
        const size_t P##qrow = (size_t)P##base + P##qb * 256 + wid * 32 + r32; \
        const bf16_t* P##qsrc = QB + P##qrow * NQ + P##h * 96 + hi * 8; \
        const bf16_t* P##kn = KV + (size_t)(P##base + skey) * NKV + P##h * 128 + sch * 8; \
        const bf16_t* P##kr = KRR + (size_t)(P##base + rkey) * 32 + rch * 8
    int li = slot;
    if (li >= nent) return;
    bf16x8 qf[6]; bf16x8 ska, sva, sra = {}, skb, svb, srb = {};
    {
        MLA_DEC(li, f_);
#pragma unroll
        for (int ks = 0; ks < 6; ++ks) qf[ks] = *(const bf16x8*)(f_qsrc + ks * 16);
        ska = *(const bf16x8*)f_kn; sva = *(const bf16x8*)(f_kn + 64); if (tid < 256) sra = *(const bf16x8*)f_kr;
        *(LAS bf16x8*)(lds + kdst) = ska; *(LAS bf16x8*)(lds + VOFF + vdst) = sva; if (tid < 256) *(LAS bf16x8*)(lds + rdst) = sra;
        ska = *(const bf16x8*)(f_kn + (size_t)64 * NKV); sva = *(const bf16x8*)(f_kn + (size_t)64 * NKV + 64); if (tid < 256) sra = *(const bf16x8*)(f_kr + 64 * 32);
    }
    __syncthreads();
    for (;;) {
        MLA_DEC(li, c_);
        const int lin = li + nslots; const bool hasn = lin < nent;
        MLA_DEC(hasn ? lin : li, n_);
        const int h = c_h; const size_t qrow = c_qrow;
        f32x16 o0 = {}, o1 = {}; float m = 0.f, l = 0.f; bool slow = false;
        const int NT = c_S / 64;
        const bf16_t* kn_src = c_kn; const bf16_t* kr_src = c_kr;
#define MLA_STEP(cur, SKL, SVL, SRL, SKW, SVW, SRW) { \
            { const bool own_ = j + 2 < NT; const size_t off = (size_t)(own_ ? j + 2 : j + 2 - NT) * 64; const bf16_t* kn_ = own_ ? kn_src : n_kn; const bf16_t* kr_ = own_ ? kr_src : n_kr; \
              SKL = *(const bf16x8*)(kn_ + off * NKV); SVL = *(const bf16x8*)(kn_ + off * NKV + 64); if (tid < 256) SRL = *(const bf16x8*)(kr_ + off * 32); } \
            MLA_COMPUTE(cur) \
            *(LAS bf16x8*)(lds + ((cur) ^ 1) * KBUF + kdst) = SKW; *(LAS bf16x8*)(lds + VOFF + ((cur) ^ 1) * VBUF + vdst) = SVW; if (tid < 256) *(LAS bf16x8*)(lds + ((cur) ^ 1) * KBUF + rdst) = SRW; \
            __syncthreads(); ++j; }
        for (int j = 0; j < NT;) {
            MLA_STEP(0, skb, svb, srb, ska, sva, sra)
            MLA_STEP(1, ska, sva, sra, skb, svb, srb)
        }
#undef MLA_STEP
        if (hasn) {
#pragma unroll
            for (int ks = 0; ks < 6; ++ks) qf[ks] = *(const bf16x8*)(n_qsrc + ks * 16);
        }
        l = xhalf_sum(l);
        const float inv = 1.f / l;
        bf16_t* orow = O + qrow * DM + h * 64 + 4 * hi;
#pragma unroll
        for (int g4 = 0; g4 < 4; ++g4) {
            u32x2 w0, w1;
            w0.x = cvt_pk_bf16(o0[4 * g4] * inv, o0[4 * g4 + 1] * inv); w0.y = cvt_pk_bf16(o0[4 * g4 + 2] * inv, o0[4 * g4 + 3] * inv);
            w1.x = cvt_pk_bf16(o1[4 * g4] * inv, o1[4 * g4 + 1] * inv); w1.y = cvt_pk_bf16(o1[4 * g4 + 2] * inv, o1[4 * g4 + 3] * inv);
            *(u32x2*)(orow + 8 * g4) = w0; *(u32x2*)(orow + 32 + 8 * g4) = w1;
        }
        if (!hasn) break;
        li = lin;
    }
#undef MLA_DEC
}

#undef MLA_COMPUTE
#undef MLA_QK_
#undef MLA_ROWMAX_
#undef MLA_EXPSUM_
__device__ __forceinline__ void attn_dil_phase(LAS unsigned char* lds, const bf16_t* QKV, const float* BT, bf16_t* OG, float* LSE, int nseq, int log2S, int G, int bx) {
    constexpr int KBUF = 64 * 272, VBUF = 16384, VOFF = 2 * KBUF, TOFF = VOFF + 2 * VBUF;
    int tid_ = threadIdx.x; asm volatile("" : "+v"(tid_));
    const int tid = tid_, wid = __builtin_amdgcn_readfirstlane(tid >> 6), lane = tid & 63, r32 = lane & 31, hi = lane >> 5;
    const int S = 1 << log2S, nqb = S >> 8, nunits = nseq * 24 * nqb;
    const int key0 = tid >> 4, ch0 = tid & 15;
    const int kdst = key0 * 272 + ch0 * 16, vdst = (ch0 >> 2) * 4096 + key0 * 64 + (ch0 & 3) * 16;
    const unsigned trb = (unsigned)(size_t)(lds + VOFF) + (unsigned)((4 * hi + ((lane & 15) >> 2)) * 64 + 32 * ((lane >> 4) & 1) + 8 * (lane & 3));
    LAS float* tab = (LAS float*)(lds + TOFF);
#define DIL_DEC(uu, P) const int P##qb = (uu) % nqb; int P##rest = (uu) / nqb; const int P##h = P##rest & 7; P##rest >>= 3; const int P##g = P##rest % 3, P##seq = P##rest / 3; \
        const int P##f0 = P##qb * 256, P##rowbase = P##seq << log2S, P##tlo = (P##f0 == 0) ? 1 : 0; \
        const bf16_t* P##qsrc = QKV + ((size_t)P##rowbase + P##f0 + wid * 32 + r32) * NQKV + P##g * 3072 + P##h * 128 + hi * 8; \
        const bf16_t* P##ksrc = QKV + (long)(P##rowbase + P##f0 - 64 + key0) * NQKV + P##g * 3072 + 1024 + P##h * 128 + ch0 * 8; \
        const float* P##tsrc = BT + (P##g * 8 + P##h) * 384 + (tid < 384 ? tid : 0)
#define DIL_TILE(src, t) do { const bf16_t* p_ = (src) + (size_t)((t) * 64) * NQKV; k0r = *(const bf16x8*)p_; v0r = *(const bf16x8*)(p_ + 1024); k1r = *(const bf16x8*)(p_ + (size_t)32 * NQKV); v1r = *(const bf16x8*)(p_ + (size_t)32 * NQKV + 1024); } while (0)
    bf16x8 qn[8] = {}, k0r = {}, k1r = {}, v0r = {}, v1r = {}; float tabv = 0.f;
    if (bx < nunits) {
        DIL_DEC(bx, a_);
#pragma unroll
        for (int ks = 0; ks < 8; ++ks) qn[ks] = *(const bf16x8*)(a_qsrc + ks * 16);
        DIL_TILE(a_ksrc, a_tlo); tabv = *a_tsrc;
    }
    for (int u = bx; u < nunits; u += G) {
        DIL_DEC(u, c_);
        const int h = c_h, g = c_g, f0 = c_f0, rowbase = c_rowbase, tlo = c_tlo;
        const int sh = 2 * g, log2L = log2S - sh;
        bf16x8 qf[8];
#pragma unroll
        for (int ks = 0; ks < 8; ++ks) qf[ks] = qn[ks];
        if (tid < 384) tab[tid] = tabv;
        f32x16 o[4] = {}; float m = -1e30f, l = 0.f;
        const int thi = (f0 + 256 >= S) ? 4 : 5;
        const int wt0 = wid >> 1, myblk = (f0 + 32 * wid) >> log2L;
        const bf16_t* ksrc = c_ksrc;
        const int tbase = 128 - 32 * wid - r32 + 4 * hi;
        *(LAS bf16x8*)(lds + kdst) = k0r; *(LAS bf16x8*)(lds + kdst + 32 * 272) = k1r; *(LAS bf16x8*)(lds + VOFF + vdst) = v0r; *(LAS bf16x8*)(lds + VOFF + vdst + 32 * 64) = v1r;
        const int un = u + G; const bool hasn = un < nunits;
        DIL_DEC(hasn ? un : u, n_);
        if (hasn) {
#pragma unroll
            for (int ks = 0; ks < 8; ++ks) qn[ks] = *(const bf16x8*)(n_qsrc + ks * 16);
            tabv = *n_tsrc;
        }
        __syncthreads();
        for (int t = tlo; t <= thi; ++t) {
            const int cur = (t - tlo) & 1;
            if (t < thi) DIL_TILE(ksrc, t + 1); else if (hasn) DIL_TILE(n_ksrc, n_tlo);
            const int fk0 = f0 - 64 + 64 * t;
            if (t >= wt0 && t <= wt0 + 2 && (fk0 >> log2L) == myblk) {
                const LAS unsigned char* Kb = lds + cur * KBUF;
                f32x16 s0 = {}, s1 = {};
#pragma unroll
                for (int ks = 0; ks < 8; ++ks) {
                    const bf16x8 a0 = *(const LAS bf16x8*)(Kb + r32 * 272 + ks * 32 + hi * 16), a1 = *(const LAS bf16x8*)(Kb + (32 + r32) * 272 + ks * 32 + hi * 16);
                    s0 = MFMA32(a0, qf[ks], s0); s1 = MFMA32(a1, qf[ks], s1);
                }
                const LAS float* tb = tab + tbase + 64 * t;
#pragma unroll
                for (int r = 0; r < 16; ++r) { s0[r] += tb[(r & 3) + 8 * (r >> 2)]; s1[r] += tb[32 + (r & 3) + 8 * (r >> 2)]; }
                float pmax = s0[0];
#pragma unroll
                for (int r = 1; r < 16; ++r) pmax = fmaxf(pmax, s0[r]);
#pragma unroll
                for (int r = 0; r < 16; ++r) pmax = fmaxf(pmax, s1[r]);
                pmax = xhalf_max(pmax);
                if (__any(pmax > m + 8.f)) {
                    const float mn = fmaxf(m, pmax), alpha = __builtin_amdgcn_exp2f(m - mn);
                    m = mn; l *= alpha;
#pragma unroll
                    for (int d = 0; d < 4; ++d)
#pragma unroll
                        for (int r = 0; r < 16; ++r) o[d][r] *= alpha;
                }
                float ps = 0.f;
#pragma unroll
                for (int r = 0; r < 16; ++r) { s0[r] = __builtin_amdgcn_exp2f(s0[r] - m); s1[r] = __builtin_amdgcn_exp2f(s1[r] - m); ps += s0[r] + s1[r]; }
                l += ps;
                bf16x8 pb[4];
                pb[0] = pack_p(s0, 0); pb[1] = pack_p(s0, 1); pb[2] = pack_p(s1, 0); pb[3] = pack_p(s1, 1);
                const unsigned va = trb + cur * VBUF;
                pv_tile(o[0], va, pb); pv_tile(o[1], va + 4096, pb); pv_tile(o[2], va + 8192, pb); pv_tile(o[3], va + 12288, pb);
            }
            if (t < thi) {
                const int nb = cur ^ 1;
                *(LAS bf16x8*)(lds + nb * KBUF + kdst) = k0r; *(LAS bf16x8*)(lds + nb * KBUF + kdst + 32 * 272) = k1r;
                *(LAS bf16x8*)(lds + VOFF + nb * VBUF + vdst) = v0r; *(LAS bf16x8*)(lds + VOFF + nb * VBUF + vdst + 32 * 64) = v1r;
            }
            __syncthreads();
        }
        l = xhalf_sum(l);
        const float inv = 1.f / l;
        const int f = f0 + wid * 32 + r32, stok = ((f & ((1 << log2L) - 1)) << sh) + (f >> log2L);
        const size_t orow = (size_t)rowbase + stok;
        bf16_t* op = OG + ((size_t)g * CHUNK + orow) * DM + h * 128 + 4 * hi;
#pragma unroll
        for (int d = 0; d < 4; ++d)
#pragma unroll
            for (int g4 = 0; g4 < 4; ++g4) {
                u32x2 w; w.x = cvt_pk_bf16(o[d][4 * g4] * inv, o[d][4 * g4 + 1] * inv); w.y = cvt_pk_bf16(o[d][4 * g4 + 2] * inv, o[d][4 * g4 + 3] * inv);
                *(u32x2*)(op + 32 * d + 8 * g4) = w;
            }
        if (hi == 0) LSE[((size_t)g * CHUNK + orow) * 8 + h] = m + __log2f(l);
    }
}
#undef DIL_DEC
#undef DIL_TILE

#define XB_TMO      128
#define XB_XCNT(j)  (256  + 64 * (j))
#define XB_XSUB(j)  (1280 + 64 * (j))
#define XB_XGEN(j)  (2304 + 64 * (j))
#define XB_TOP      3328
#define XB_TOPGEN   3392
#define XCD_BAR_WORDS 3456
#define XB_SPIN_CAP (1u << 18)

__device__ __forceinline__ unsigned xb_ld(unsigned* p)              { return __hip_atomic_load(p, __ATOMIC_RELAXED, __HIP_MEMORY_SCOPE_AGENT); }
__device__ __forceinline__ unsigned xb_add(unsigned* p, unsigned v) { return __hip_atomic_fetch_add(p, v, __ATOMIC_RELAXED, __HIP_MEMORY_SCOPE_AGENT); }
__device__ __forceinline__ unsigned xb_xcc_id() { return (unsigned)__builtin_amdgcn_s_getreg((3 << 11) | 20) & 0xFu; }
#define XB_SPIN(cond, bar) do { unsigned _sp = 0; while (cond) { __builtin_amdgcn_s_sleep(1); \
    if ((++_sp & 255u) == 0u) { if (xb_ld(&(bar)[XB_TMO])) break; if (_sp > XB_SPIN_CAP) { atomicAdd(&(bar)[XB_TMO], 1u); break; } } } } while (0)

struct XcdBarrier {
    unsigned* bar; unsigned x;
    volatile LAS unsigned* st;
};

__device__ __forceinline__ XcdBarrier xcd_barrier_post(unsigned* bar, volatile LAS unsigned* st) {
    XcdBarrier b; b.bar = bar; b.x = xb_xcc_id(); b.st = st;
    if (threadIdx.x == 0) (void)xb_add(&bar[XB_XCNT(b.x)], 1u);
    return b;
}
__device__ __forceinline__ void xcd_barrier_complete(unsigned* bar, unsigned x, unsigned& nloc, unsigned& nx) {
    const unsigned G = gridDim.x * gridDim.y * gridDim.z;
    unsigned sum, cnt, mine, sp = 0u;
    for (;;) {
        sum = 0u; cnt = 0u; mine = 0u;
#pragma unroll
        for (unsigned j = 0; j < 16; ++j) { const unsigned c = xb_ld(&bar[XB_XCNT(j)]); sum += c; cnt += (c > 0u) ? 1u : 0u; mine = (j == x) ? c : mine; }
        if (sum == G) break;
        __builtin_amdgcn_s_sleep(1);
        if ((++sp & 255u) == 0u) { if (xb_ld(&bar[XB_TMO])) break; if (sp > XB_SPIN_CAP) { atomicAdd(&bar[XB_TMO], 1u); break; } }
    }
    nloc = mine > 0u ? mine : 1u; nx = cnt > 0u ? cnt : 1u;
}

__device__ __forceinline__ void xcd_barrier(const XcdBarrier& b) {
    asm volatile("s_waitcnt vmcnt(0)" ::: "memory");
    __syncthreads();
    if (threadIdx.x == 0) {
        unsigned* bar = b.bar;
        __builtin_amdgcn_s_waitcnt(0);
        unsigned nloc = b.st[0], nx = b.st[1];
        if (nloc == 0u) { xcd_barrier_complete(bar, b.x, nloc, nx); b.st[0] = nloc; b.st[1] = nx; }
        const unsigned old = xb_add(&bar[XB_XSUB(b.x)], 1u);
        const unsigned gen = old / nloc;
        if (old + 1u == (gen + 1u) * nloc) {
            __builtin_amdgcn_fence(__ATOMIC_RELEASE, "agent");
            asm volatile("s_waitcnt vmcnt(0)" ::: "memory");
            const unsigned og = xb_add(&bar[XB_TOP], 1u);
            const unsigned tg = og / nx;
            if (og + 1u == (tg + 1u) * nx) xb_add(&bar[XB_TOPGEN], 1u);
            else XB_SPIN(xb_ld(&bar[XB_TOPGEN]) == tg, bar);
            __builtin_amdgcn_fence(__ATOMIC_ACQUIRE, "agent");
            xb_add(&bar[XB_XGEN(b.x)], 1u);
            asm volatile("s_waitcnt vmcnt(0)" ::: "memory");
        } else {
            XB_SPIN(xb_ld(&bar[XB_XGEN(b.x)]) == gen, bar);
            __builtin_amdgcn_fence(__ATOMIC_ACQUIRE, "agent");
            asm volatile("s_waitcnt vmcnt(0)" ::: "memory");
        }
    }
    __syncthreads();
}

__global__ void __launch_bounds__(512, 2) mega_fwd(Params p) {
    extern __shared__ __attribute__((aligned(16))) unsigned char lds_raw[];
    LAS unsigned char* lds = (LAS unsigned char*)lds_raw;
    const int G0 = gridDim.x, bx0 = blockIdx.x;
#define PH_LOCALS PH_WS; int tid = threadIdx.x; asm volatile("" : "+v"(tid)); const int lane = tid & 63, wave = __builtin_amdgcn_readfirstlane(tid >> 6), gw = bx * 8 + wave; (void)lane; (void)gw
#define PH_WS const __attribute__((address_space(4))) Params* kp = (const __attribute__((address_space(4))) Params*)__builtin_amdgcn_kernarg_segment_ptr(); asm volatile("" : "+s"(kp)); \
        unsigned char* ws = kp->ws; float* X = kp->out; (void)X; int G = G0, bx = bx0; asm volatile("" : "+s"(G), "+s"(bx)); const int NGW = G * 8; (void)NGW
#define XB ((bf16_t*)(ws + WS_XB))
#define OB ((bf16_t*)(ws + WS_O))
#define cosT ((float*)(ws + WS_COS))
#define sinT ((float*)(ws + WS_SIN))
#define BT ((float*)(ws + WS_BT))
#define RQ ((float*)(ws + WS_RQ))
#define RKV ((float*)(ws + WS_RKV))
#define WQKV ((bf16_t*)(ws + WS_WQKV))
#define WOA ((bf16_t*)(ws + WS_WOA))
#define WDKV ((bf16_t*)(ws + WS_WDKV))
#define WUQ ((bf16_t*)(ws + WS_WUQ))
#define WUKV ((bf16_t*)(ws + WS_WUKV))
#define WOB ((bf16_t*)(ws + WS_WOB))
#define WIN ((bf16_t*)(ws + WS_WIN))
#define WOUT ((bf16_t*)(ws + WS_WOUT))
#define QKV ((bf16_t*)(ws + WS_QKV))
#define OG ((bf16_t*)(ws + WS_OG))
#define LSE ((float*)(ws + WS_LSE))
#define CB ((bf16_t*)(ws + WS_C))
#define QB ((bf16_t*)(ws + WS_QB))
#define KVB ((bf16_t*)(ws + WS_KV))
#define KRR ((bf16_t*)(ws + WS_KRR))
#define UB ((bf16_t*)(ws + WS_U))
#define Y1B ((bf16_t*)(ws + WS_S))
#define Y2B ((bf16_t*)(ws + WS_Y2))
#define HB ((bf16_t*)(ws + WS_H))
    cg::grid_group grid = cg::this_grid();
    volatile LAS unsigned* bst = (volatile LAS unsigned*)(lds + LDS_BYTES - 64);
    if (threadIdx.x == 0) { bst[0] = 0u; bst[1] = 0u; }
    __syncthreads();
    const XcdBarrier xbar = xcd_barrier_post((unsigned*)(p.ws + WS_CTL), bst);
    int ph = 0;
    const int lo = p.ph_lo, hi = p.ph_hi;
#define PH_ON (ph >= lo && ph < hi)
#ifndef MK_EN
#define MK_EN 0xffffffffu
#endif
#define EN(k) (((MK_EN) >> (k)) & 1u)
#ifndef MK_REP
#define MK_REP 0u
#endif
#define REPN(k) ((((MK_REP) >> (k)) & 1u) != 0)
#define REPN(k) ((((MK_REP) >> (k)) & 1u) != 0)
#define REP(k) for (int rep_ = 0; rep_ < ((((MK_REP) >> (k)) & 1u) ? 2 : 1); ++rep_)
#define PH_END do { if (ph >= lo && ph + 1 < hi) { if (lo < 0) grid.sync(); else xcd_barrier(xbar); } ++ph; } while (0)

    if (EN(0) && PH_ON) REP(0) {
        PH_LOCALS;
        LAS float* scr = (LAS float*)(lds + wave * 16384);
        constexpr int I_QKV = (DM / 64) * (NQKV / 32), I_O = (DM / 64) * (DM / 32), I_DKV = (DM / 64) * (672 / 32), I_UQ = (NCQ / 64) * (NQ / 32), I_UKV = (NCKV / 64) * (NKV / 32);
        constexpr int I_IN = (DM / 64) * (NFF / 32), I_OUT = (DFF / 64) * (DM / 32);
        constexpr int NITEMS = I_QKV + 2 * I_O + I_DKV + I_UQ + I_UKV + 2 * I_IN + 2 * I_OUT;
        for (int it = gw; it < NITEMS; it += NGW) {
            int r = it;
            if (r < I_QKV) { transpose_item(kp->w_qkv_a, DM, NQKV, WQKV, 0, nullptr, scr, r, lane); continue; } r -= I_QKV;
            if (r < I_O) { transpose_item(kp->w_o_a, DM, DM, WOA, 0, nullptr, scr, r, lane); continue; } r -= I_O;
            if (r < I_O) { transpose_item(kp->w_o_b, DM, DM, WOB, 0, nullptr, scr, r, lane); continue; } r -= I_O;
            if (r < I_DKV) { transpose_item(kp->w_dkv_b, DM, 672, WDKV, 2, nullptr, scr, r, lane); continue; } r -= I_DKV;
            if (r < I_UQ) { transpose_item(kp->w_uq_b, NCQ, NQ, WUQ, 1, kp->g_q_b, scr, r, lane); continue; } r -= I_UQ;
            if (r < I_UKV) { transpose_item(kp->w_ukv_b, NCKV, NKV, WUKV, 0, kp->g_kv_b, scr, r, lane); continue; } r -= I_UKV;
            if (r < 2 * I_IN) { const int ly = r / I_IN; transpose_item(kp->ffn_w_in + (size_t)ly * DM * NFF, DM, NFF, WIN + (size_t)ly * NFF * DM, 0, nullptr, scr, r - ly * I_IN, lane); continue; } r -= 2 * I_IN;
            { const int ly = r / I_OUT; transpose_item(kp->ffn_w_out + (size_t)ly * DFF * DM, DFF, DM, WOUT + (size_t)ly * DM * DFF, 0, nullptr, scr, r - ly * I_OUT, lane); }
        }
        for (int i = bx * 512 + tid; i < 96 * DM / 8; i += G * 512) *((u32x4*)(WDKV + (size_t)672 * DM) + i) = (u32x4){0u, 0u, 0u, 0u};
        for (int r = gw; r < T; r += 2 * NGW) {
            const int r2 = r + NGW; const bool h2 = r2 < T;
            const float* src = r < TP ? kp->x_prompt + (size_t)r * DM : kp->x_sample + (size_t)(r - TP) * DM;
            const float* src2 = r2 < TP ? kp->x_prompt + (size_t)r2 * DM : kp->x_sample + (size_t)((h2 ? r2 : r) - TP) * DM;
            f32x4 va[4], vb[4] = {};
#pragma unroll
            for (int j = 0; j < 4; ++j) { va[j] = *((const f32x4*)src + lane + 64 * j); if (h2) vb[j] = *((const f32x4*)src2 + lane + 64 * j); }
#pragma unroll
            for (int j = 0; j < 4; ++j) {
                u32x2 w; w.x = cvt_pk_bf16(va[j].x, va[j].y); w.y = cvt_pk_bf16(va[j].z, va[j].w);
                *((u32x2*)(XB + (size_t)r * DM) + lane + 64 * j) = w;
                if (h2) { u32x2 w2; w2.x = cvt_pk_bf16(vb[j].x, vb[j].y); w2.y = cvt_pk_bf16(vb[j].z, vb[j].w); *((u32x2*)(XB + (size_t)r2 * DM) + lane + 64 * j) = w2; }
            }
        }
        for (int i = bx * 512 + tid; i < 8192 * 16; i += G * 512) { float c, s; rope_entry(i >> 4, i & 15, c, s); cosT[i] = c; sinT[i] = s; }
        for (int i = bx * 512 + tid; i < 24 * 384; i += G * 512) {
            const int gh = i / 384, d = i % 384 - 192, g = gh >> 3;
            float v = -1e30f;
            if (d >= -64 && d <= 64) v = kp->rel_bias[t5_bucket(d * (1 << (2 * g))) * 24 + gh] * LOG2E;
            BT[i] = v;
        }
    }
    PH_END;

    {
        for (int c = 0; c < NCHUNK; ++c) {
            const int row0 = c * CHUNK, log2S = c < 4 ? 13 : 11, nseq = c < 4 ? 2 : 8;
            if (EN(1) && PH_ON) REP(1) {
                PH_WS;
                pg8::Gemm g{XB + (size_t)row0 * DM, WQKV, CHUNK, NQKV, DM, DM}; pg8::StaticOrder S; S.init(CHUNK, NQKV, G, bx);
                pg8::EpiQKV E{QKV, log2S, 0.08838834764831845f * LOG2E};
                pg8::gemm_phase<pg8::EpiQKV, pg8::StaticOrder>(lds, g, S, E);
            }
            PH_END;
            if (EN(2) && PH_ON) REP(2) { PH_WS; attn_dil_phase(lds, QKV, BT, OG, LSE, nseq, log2S, G, bx); }
            PH_END;
            if (EN(3) && PH_ON) REP(3) {   PH_LOCALS;
                for (int r = gw; r < CHUNK; r += NGW) {
                    const int h = lane >> 3;
                    const float l0 = LSE[((size_t)0 * CHUNK + r) * 8 + h], l1 = LSE[((size_t)1 * CHUNK + r) * 8 + h], l2 = LSE[((size_t)2 * CHUNK + r) * 8 + h];
                    const float mx = fmaxf(l0, fmaxf(l1, l2));
                    float w0 = __builtin_amdgcn_exp2f(l0 - mx), w1 = __builtin_amdgcn_exp2f(l1 - mx), w2 = __builtin_amdgcn_exp2f(l2 - mx);
                    const float inv = 1.f / (w0 + w1 + w2); w0 *= inv; w1 *= inv; w2 *= inv;
#pragma unroll
                    for (int j = 0; j < 2; ++j) {
                        const bf16x8 a = *((const bf16x8*)(OG + ((size_t)0 * CHUNK + r) * DM) + lane * 2 + j), b = *((const bf16x8*)(OG + ((size_t)1 * CHUNK + r) * DM) + lane * 2 + j),
                                     cc = *((const bf16x8*)(OG + ((size_t)2 * CHUNK + r) * DM) + lane * 2 + j);
                        float v[8];
#pragma unroll
                        for (int e = 0; e < 8; ++e) v[e] = w0 * bf2f((unsigned short)a[e]) + w1 * bf2f((unsigned short)b[e]) + w2 * bf2f((unsigned short)cc[e]);
                        u32x4 w; w.x = cvt_pk_bf16(v[0], v[1]); w.y = cvt_pk_bf16(v[2], v[3]); w.z = cvt_pk_bf16(v[4], v[5]); w.w = cvt_pk_bf16(v[6], v[7]);
                        *((u32x4*)(OB + (size_t)(row0 + r) * DM) + lane * 2 + j) = w;
                    }
                }
            }
            if (c + 1 < NCHUNK && MK_MULTI == 0) ++ph; else PH_END;
        }
    }
    for (int layer = 0; layer < 2; ++layer) {
        if (layer == 1) {
            if (EN(4) && PH_ON) REP(4) {
                PH_WS;
                pg8::Gemm g{XB, WDKV, T, CW, DM, DM}; pg8::StaticOrder S; S.init(T, CW, G, bx);
                pg8::EpiStore E{CB, CW, nullptr, 1.f};
                pg8::gemm_phase<pg8::EpiStore, pg8::StaticOrder>(lds, g, S, E);
            }
            PH_END;
            if (EN(5) && PH_ON) REP(5) {   PH_LOCALS;
                for (int r = gw; r < T; r += NGW) {
                    const bf16_t* crow = CB + (size_t)r * CW;
                    const bf16x8 a = *((const bf16x8*)crow + lane);
                    bf16x8 b = {}; if (lane < 20) b = *((const bf16x8*)crow + 64 + lane);
                    float fa[8], fb[8], sa = 0.f, sb = 0.f;
#pragma unroll
                    for (int e = 0; e < 8; ++e) { fa[e] = bf2f((unsigned short)a[e]); fb[e] = bf2f((unsigned short)b[e]); sa += fa[e] * fa[e]; sb += fb[e] * fb[e]; }
                    const float sq = wave_sum(lane < 48 ? sa : 0.f, lane), skv = wave_sum((lane >= 48 ? sa : 0.f) + (lane < 16 ? sb : 0.f), lane);
                    if (lane == 0) { RQ[r] = 1.f / sqrtf(sq * (1.f / NCQ) + RMS_EPS); RKV[r] = 1.f / sqrtf(skv * (1.f / NCKV) + RMS_EPS); }
                    if (lane >= 16 && lane < 20) {
                        const int j = lane - 16, pos = r < TP ? (r & 8191) : (r & 2047);
                        const f32x4 cs = *(const f32x4*)(cosT + pos * 16 + 4 * j), sn = *(const f32x4*)(sinT + pos * 16 + 4 * j);
                        float o1[4], o2[4];
#pragma unroll
                        for (int e = 0; e < 4; ++e) { o1[e] = fb[e] * cs[e] - fb[4 + e] * sn[e]; o2[e] = fb[e] * sn[e] + fb[4 + e] * cs[e]; }
                        u32x4 w; w.x = cvt_pk_bf16(o1[0], o1[1]); w.y = cvt_pk_bf16(o1[2], o1[3]); w.z = cvt_pk_bf16(o2[0], o2[1]); w.w = cvt_pk_bf16(o2[2], o2[3]);
                        *((u32x4*)(KRR + (size_t)r * 32) + j) = w;
                    }
                }
            }
            PH_END;
            if (EN(6) && PH_ON) REP(6) {
                PH_WS;
                { pg8::Gemm g{CB, WUQ, T, NQ, NCQ, CW}; pg8::StaticOrder S; S.init(T, NQ, G, bx);
                  pg8::EpiQRope E{QB, RQ, 0.10206207261596575f * LOG2E, cosT, sinT};
                  pg8::gemm_phase<pg8::EpiQRope, pg8::StaticOrder>(lds, g, S, E); }
                { pg8::Gemm g{CB + NCQ, WUKV, T, NKV, NCKV, CW}; pg8::StaticOrder S; S.init(T, NKV, G, bx);
                  pg8::EpiStore E{KVB, NKV, RKV, 1.f};
                  pg8::gemm_phase<pg8::EpiStore, pg8::StaticOrder>(lds, g, S, E); }
            }
            PH_END;
            if (EN(7) && PH_ON) REP(7) { PH_WS; attn_mla_phase(lds, QB, KVB, KRR, OB, G, bx); }
            PH_END;
        }
        if (EN(8) && PH_ON) REP(8) {
                PH_WS;
            pg8::Gemm g{OB, layer == 0 ? WOA : WOB, T, DM, DM, DM}; pg8::StaticOrder S; S.init(T, DM, G, bx);
            pg8::EpiStore E{Y1B, DM, nullptr, 1.f};
            pg8::gemm_phase<pg8::EpiStore, pg8::StaticOrder>(lds, g, S, E);
        }
        PH_END;
        if (EN(9) && PH_ON) REP(9) { PH_LOCALS; ln_phase(layer == 0 ? kp->x_prompt : X, layer == 0 ? kp->x_sample : X + (size_t)TP * DM, Y1B, (REPN(9) && rep_ == 0) ? (float*)(ws + 560 * MiB) : X, (REPN(9) && rep_ == 0) ? OB : XB, kp->ln_g + (layer * 2 + 0) * DM, kp->ln_b + (layer * 2 + 0) * DM, gw, NGW, lane); }
        PH_END;
        {
            for (int c = 0; c < 3; ++c) {
                const int row0 = c * 32768, crows = c < 2 ? 32768 : 16384, log2S = c < 2 ? 13 : 11;
                if (EN(10) && PH_ON) REP(10) {
                PH_WS;
                    pg8::Gemm g{XB + (size_t)row0 * DM, WIN + (size_t)layer * NFF * DM, crows, NFF, DM, DM}; pg8::StaticOrder S; S.init(crows, NFF, G, bx);
                    pg8::EpiStore E{HB, NFF, nullptr, 1.f};
                    pg8::gemm_phase<pg8::EpiStore, pg8::StaticOrder>(lds, g, S, E);
                }
                PH_END;
                if (EN(11) && PH_ON) REP(11) {   PH_LOCALS;
                    const float* cw = kp->ffn_conv_w + (size_t)layer * 3 * NFF; const float* cb = kp->ffn_conv_b + (size_t)layer * NFF; const bf16_t* H = HB; bf16_t* U = UB;
                    const int nitems = (crows / 8) * 11, smask = (1 << log2S) - 1;
                    for (int it = gw; it < nitems; it += NGW) {
                        const int rr = it / 11, cgp = it - rr * 11, col = (cgp * 64 + lane) * 4, r0 = rr * 8;
                        u32x2 ra[10], rg[10];
                        const bool hp = (r0 & smask) != 0, hn = ((r0 + 8) & smask) != 0;
#pragma unroll
                        for (int i = 0; i < 10; ++i) {
                            const bool ok = (i == 0) ? hp : (i == 9) ? hn : true;
                            if (ok) { ra[i] = *(const u32x2*)(H + (size_t)(r0 - 1 + i) * NFF + col); rg[i] = *(const u32x2*)(H + (size_t)(r0 - 1 + i) * NFF + DFF + col); }
                            else { ra[i] = (u32x2){0u, 0u}; rg[i] = (u32x2){0u, 0u}; }
                        }
                        f32x4 wa[3], wg[3];
#pragma unroll
                        for (int k = 0; k < 3; ++k) { wa[k] = *(const f32x4*)(cw + k * NFF + col); wg[k] = *(const f32x4*)(cw + k * NFF + DFF + col); }
                        const f32x4 ba = *(const f32x4*)(cb + col), bg = *(const f32x4*)(cb + DFF + col);
#define BF4(u) ((f32x4){__uint_as_float((u).x << 16), __uint_as_float((u).x & 0xffff0000u), __uint_as_float((u).y << 16), __uint_as_float((u).y & 0xffff0000u)})
#pragma unroll
                        for (int i = 0; i < 8; ++i) {
                            const f32x4 av = wa[0] * BF4(ra[i]) + wa[1] * BF4(ra[i + 1]) + wa[2] * BF4(ra[i + 2]) + ba;
                            const f32x4 gv = wg[0] * BF4(rg[i]) + wg[1] * BF4(rg[i + 1]) + wg[2] * BF4(rg[i + 2]) + bg;
                            u32x2 w; w.x = cvt_pk_bf16(av[0] * gelu_erf(gv[0]), av[1] * gelu_erf(gv[1])); w.y = cvt_pk_bf16(av[2] * gelu_erf(gv[2]), av[3] * gelu_erf(gv[3]));
                            *(u32x2*)(U + (size_t)(row0 + r0 + i) * DFF + col) = w;
                        }
#undef BF4
                    }
                }
                PH_END;
            }
            if (EN(12) && PH_ON) REP(12) {
                PH_WS;
                pg8::Gemm g{UB, WOUT + (size_t)layer * DM * DFF, T, DM, DFF, DFF}; pg8::StaticOrder S; S.init(T, DM, G, bx);
                pg8::EpiStore E{Y2B, DM, nullptr, 1.f};
                pg8::gemm_phase<pg8::EpiStore, pg8::StaticOrder>(lds, g, S, E);
            }
            PH_END;
            if (EN(13) && PH_ON) REP(13) { PH_LOCALS; ln_phase(X, X + (size_t)TP * DM, Y2B, (REPN(13) && rep_ == 0) ? (float*)(ws + 222 * MiB) : X, (REPN(13) && rep_ == 0) ? (bf16_t*)(ws + 822 * MiB) : XB, kp->ln_g + (layer * 2 + 1) * DM, kp->ln_b + (layer * 2 + 1) * DM, gw, NGW, lane, layer == 0); }
            PH_END;
        }
    }
#undef PH_ON
#undef PH_END
}
constexpr int N_PHASES = 1 + 15 + 2 * (2 + 8) + 4;

extern "C" void kernel_launch(void* const* d_in, const int* in_sizes, int n_in, void* d_out, int out_size, void* d_ws, size_t ws_size, hipStream_t stream) {
    static int grid = 0;
    if (grid == 0) {
        if (n_in != 17 || out_size != T * DM || ws_size < WS_END) { fprintf(stderr, "kernel_launch: unexpected shapes (n_in %d out %d ws %zu)\n", n_in, out_size, ws_size); grid = -1; return; }
        int dev = 0, cus = 0, per_cu = 0;
        if (hipGetDevice(&dev) != hipSuccess || hipDeviceGetAttribute(&cus, hipDeviceAttributeMultiprocessorCount, dev) != hipSuccess) { grid = -1; return; }
        if (hipFuncSetAttribute((const void*)mega_fwd, hipFuncAttributeMaxDynamicSharedMemorySize, LDS_BYTES) != hipSuccess) { fprintf(stderr, "kernel_launch: hipFuncSetAttribute failed\n"); grid = -1; return; }
        if (hipOccupancyMaxActiveBlocksPerMultiprocessor(&per_cu, (const void*)mega_fwd, 512, LDS_BYTES) != hipSuccess || per_cu < 1) { fprintf(stderr, "kernel_launch: occupancy query says %d\n", per_cu); per_cu = 1; }
        (void)hipGetLastError();
        grid = cus * 1;
    }
    if (grid < 0) return;
    if (hipMemsetAsync((char*)d_ws + WS_CTL, 0, CTL_BYTES, stream) != hipSuccess) { fprintf(stderr, "kernel_launch: memset failed\n"); return; }
    Params p{};
    const float** pp = (const float**)&p;
    for (int i = 0; i < 17; ++i) pp[i] = (const float*)d_in[i];
    p.out = (float*)d_out; p.ws = (unsigned char*)d_ws;
#if MK_MULTI
    for (int k = 0; k < N_PHASES; ++k) { p.ph_lo = k; p.ph_hi = k + 1; hipLaunchKernelGGL(mega_fwd, dim3(grid), dim3(512), LDS_BYTES, stream, p); }
#else
    p.ph_lo = 0; p.ph_hi = N_PHASES;
    void* args[] = {&p};
    hipError_t e = hipLaunchCooperativeKernel((const void*)mega_fwd, dim3(grid), dim3(512), args, LDS_BYTES, stream);
    if (e != hipSuccess) fprintf(stderr, "cooperative launch failed: %s (grid %d)\n", hipGetErrorString(e), grid);
#endif
}
```
